# Optimizing an MI355X kernel written in HIP

```python
import jax
import jax.numpy as jnp
from jax import lax
import numpy as np

D_MODEL = 1024
BATCH = 16
SEQ = 256
DEPTH = 2
DEC_BATCH = 8
DEC_SEQ = 2048
PAST_LEN = 256

EPS = 1e-6
NEG_INF = -1e30
GRID_W = 64
N_A_LAYERS = (DEPTH + 1) // 2
N_C_LAYERS = DEPTH // 2
H_A = 4
DK_A = 128
DV_A = 128
A_KEY = H_A * DK_A
A_WIDTH = H_A * DV_A
HGRN_CHUNK = 32
H_B = 8
DH_B = 64
B_WIDTH = H_B * DH_B
NA_KH = 8
NA_KW = 16
NA_COL_BLOCK = 16
NA_BAND = NA_COL_BLOCK + NA_KW
NA_N_COL_BLOCKS = GRID_W // NA_COL_BLOCK
CTX_Q_BLOCK = 128
EVEN_SPLITS = (A_KEY, A_KEY, A_KEY, A_WIDTH, A_WIDTH, B_WIDTH, B_WIDTH, B_WIDTH, B_WIDTH)
EVEN_IN = 3 * A_KEY + 2 * A_WIDTH + 4 * B_WIDTH
W_C = 1024
H_C = 8
BW_C = W_C // H_C
CONV_W = 4
RG_C = 8.0

kernel_name = 'bidir_hgrn2_natten_rglru_prefix_dit_step'


def rmsnorm(x, g):
    x32 = x.astype(jnp.float32)
    y = x32 * lax.rsqrt(jnp.mean(x32 * x32, axis=-1, keepdims=True) + EPS)
    return (y * g.astype(jnp.float32)).astype(x.dtype)


def adaln(cond, w_mod, b_mod):
    m = (jax.nn.silu(cond) @ w_mod + b_mod)[:, None, :]
    return jnp.split(m, 3, axis=-1)


def split_heads(t, n_heads):
    B, T, _ = t.shape
    return t.reshape(B, T, n_heads, -1).transpose(0, 2, 1, 3)


def merge_heads(t):
    B, H, T, d = t.shape
    return t.transpose(0, 2, 1, 3).reshape(B, T, H * d)


def hgrn2_chunkwise(q, k, log_f, v, s0):
    B, H, T, DK = q.shape
    DV = v.shape[-1]
    n = T // HGRN_CHUNK
    shp = (B, H, n, HGRN_CHUNK)
    q, k, log_f = (t.reshape(shp + (DK,)) for t in (q, k, log_f))
    v = v.reshape(shp + (DV,))
    b = jnp.cumsum(log_f, axis=3)
    b_end = b[:, :, :, -1:, :]
    q_dec = q * jnp.exp(b)
    k_inv = k * jnp.exp(-b)
    lower = jnp.tril(jnp.ones((HGRN_CHUNK, HGRN_CHUNK), dtype=bool))
    att = jnp.where(lower, jnp.einsum('bhntd,bhnsd->bhnts', q_dec, k_inv), 0.0)
    o_intra = jnp.einsum('bhnts,bhnsv->bhntv', att, v)
    chunk_kv = jnp.einsum('bhnsd,bhnsv->nbhdv', k * jnp.exp(b_end - b), v)
    chunk_decay = jnp.moveaxis(jnp.exp(b_end[:, :, :, 0, :]), 2, 0)

    def step(S, inp):
        dec, kv = inp
        return dec[..., None] * S + kv, S

    s_fin, s_prev = lax.scan(step, s0, (chunk_decay, chunk_kv))
    o_inter = jnp.einsum('bhntd,nbhdv->bhntv', q_dec, s_prev)
    return (o_intra + o_inter).reshape(B, H, T, DV), s_fin


def hgrn2_bidirectional(q, z_fwd, z_bwd, v, lb, s0):
    qh = split_heads(q.astype(jnp.float32), H_A)
    vh = split_heads(v.astype(jnp.float32), H_A)
    outs, finals = [], []
    for d, z in enumerate((z_fwd, z_bwd)):
        z32 = z.astype(jnp.float32)
        f = lb[d] + (1.0 - lb[d]) * jax.nn.sigmoid(z32)
        k = (1.0 - lb[d]) * jax.nn.sigmoid(-z32)
        args = [qh, split_heads(k, H_A), split_heads(jnp.log(f), H_A), vh]
        if d == 1:
            args = [jnp.flip(t, axis=2) for t in args]
        o, s_fin = hgrn2_chunkwise(*args, s0[:, d].astype(jnp.float32))
        outs.append(jnp.flip(o, axis=2) if d == 1 else o)
        finals.append(s_fin)
    return outs[0] + outs[1], jnp.stack(finals, axis=1)


def context_attention(q, k, v):
    B, H, Tc, dh = q.shape
    scale = dh ** -0.5
    qb = jnp.moveaxis(q.reshape(B, H, Tc // CTX_Q_BLOCK, CTX_Q_BLOCK, dh), 2, 0)

    def block(qi):
        s = jnp.einsum('bhqd,bhkd->bhqk', qi, k).astype(jnp.float32) * scale
        p = jax.nn.softmax(s, axis=-1).astype(v.dtype)
        return jnp.einsum('bhqk,bhkd->bhqd', p, v)

    o = lax.map(block, qb)
    return jnp.moveaxis(o, 0, 2).reshape(B, H, Tc, dh)


def neighbourhood_attention(q, k, v, k_ctx, v_ctx, rel_bias):
    B, H, T, dh = q.shape
    rows = T // GRID_W
    kh = min(NA_KH, rows)
    scale = dh ** -0.5
    cols = np.arange(GRID_W).reshape(NA_N_COL_BLOCKS, NA_COL_BLOCK)
    band_start = np.clip(np.arange(NA_N_COL_BLOCKS) * NA_COL_BLOCK - NA_KW // 2, 0, GRID_W - NA_BAND)
    col_idx = (band_start[:, None] + np.arange(NA_BAND)).astype(np.int32)
    win_start = np.clip(cols - NA_KW // 2, 0, GRID_W - NA_KW)[..., None]
    key_col = col_idx[:, None, :]
    valid = jnp.asarray((key_col >= win_start) & (key_col < win_start + NA_KW))[:, :, None, :]
    dc_idx = np.clip(key_col - cols[..., None] + NA_KW - 1, 0, 2 * NA_KW - 2).astype(np.int32)[:, :, None, :]
    bias_tab = rel_bias.astype(jnp.float32)
    k_grid = k.reshape(B, H, rows, GRID_W, dh)
    v_grid = v.reshape(B, H, rows, GRID_W, dh)
    k_ctx = k_ctx.astype(q.dtype)
    v_ctx = v_ctx.astype(q.dtype)
    n_loc = kh * NA_BAND

    def row_block(args):
        r, q_r = args
        rs = jnp.clip(r - kh // 2, 0, rows - kh)
        k_blk = lax.dynamic_slice_in_dim(k_grid, rs, kh, axis=2)[:, :, :, col_idx]
        v_blk = lax.dynamic_slice_in_dim(v_grid, rs, kh, axis=2)[:, :, :, col_idx]
        qb = q_r.reshape(B, H, NA_N_COL_BLOCKS, NA_COL_BLOCK, dh)
        dr_idx = rs + jnp.arange(kh) - r + NA_KH - 1
        bias = bias_tab[:, dr_idx[None, None, :, None], dc_idx]
        s_loc = jnp.einsum('bhjqd,bhkjnd->bhjqkn', qb, k_blk).astype(jnp.float32) * scale + bias
        s_loc = jnp.where(valid, s_loc, NEG_INF)
        s_ctx = jnp.einsum('bhjqd,bhcd->bhjqc', qb, k_ctx).astype(jnp.float32) * scale
        s = jnp.concatenate([s_loc.reshape(B, H, NA_N_COL_BLOCKS, NA_COL_BLOCK, n_loc), s_ctx], axis=-1)
        p = jax.nn.softmax(s, axis=-1).astype(v.dtype)
        p_loc = p[..., :n_loc].reshape(B, H, NA_N_COL_BLOCKS, NA_COL_BLOCK, kh, NA_BAND)
        o = (jnp.einsum('bhjqkn,bhkjnd->bhjqd', p_loc, v_blk)
             + jnp.einsum('bhjqc,bhcd->bhjqd', p[..., n_loc:], v_ctx))
        return o.reshape(B, H, GRID_W, dh)

    q_rows = jnp.moveaxis(q.reshape(B, H, rows, GRID_W, dh), 2, 0)
    o = lax.map(row_block, (jnp.arange(rows), q_rows))
    return jnp.moveaxis(o, 0, 2).reshape(B, H, T, dh)


def even_mixer(h, w_in, w_out, lb, out_gain, rel_bias, s0, ctx_kv):
    parts = jnp.split(h @ w_in, np.cumsum(EVEN_SPLITS)[:-1].tolist(), axis=-1)
    q_a, z_f, z_b, v_a, g_a, q_b, k_b, v_b, g_b = parts
    o_a, s_fin = hgrn2_bidirectional(q_a, z_f, z_b, v_a, lb, s0)
    o_a = merge_heads(rmsnorm(o_a, out_gain[None, :, None, :])).astype(h.dtype)
    qh, kh, vh = (split_heads(t, H_B) for t in (q_b, k_b, v_b))
    if ctx_kv is None:
        o_b = context_attention(qh, kh, vh)
    else:
        o_b = neighbourhood_attention(qh, kh, vh, ctx_kv[0], ctx_kv[1], rel_bias)
    y = jnp.concatenate([o_a * jax.nn.silu(g_a), merge_heads(o_b) * jax.nn.silu(g_b)], axis=-1)
    return y @ w_out, s_fin, kh, vh


def centred_dwconv(x, w, b):
    left = CONV_W // 2
    T = x.shape[1]
    xp = jnp.pad(x, ((0, 0), (left, CONV_W - 1 - left), (0, 0)))
    return sum(xp[:, j:j + T] * w[j] for j in range(CONV_W)) + b


def linear_recurrence(a, u, h0):
    u = u.at[:, 0].add(a[:, 0] * h0)

    def combine(left, right):
        a_l, u_l = left
        a_r, u_r = right
        return a_l * a_r, a_r * u_l + u_r

    _, hs = lax.associative_scan(combine, (a, u), axis=1)
    return hs, hs[:, -1]


def odd_mixer(h, w_in, w_out, conv_w, conv_b, gate_w, gate_b, lam, s0):
    xb, g = jnp.split(h @ w_in, 2, axis=-1)
    xc = centred_dwconv(xb, conv_w, conv_b).astype(jnp.float32)
    B, T, _ = xc.shape
    xblk = xc.reshape(B, T, H_C, BW_C)
    outs, finals = [], []
    for d in range(2):
        gates = jnp.einsum('bthi,ghij->gbthj', xblk, gate_w[d].astype(jnp.float32)).reshape(2, B, T, W_C)
        gates = gates + gate_b[d].astype(jnp.float32)[:, None, None, :]
        r = jax.nn.sigmoid(gates[0])
        i = jax.nn.sigmoid(gates[1])
        log_a = -RG_C * r * jax.nn.softplus(-lam[d].astype(jnp.float32))
        a = jnp.exp(log_a)
        u = jnp.sqrt(-jnp.expm1(2.0 * log_a)) * (i * xc)
        if d == 1:
            a, u = jnp.flip(a, axis=1), jnp.flip(u, axis=1)
        hs, h_fin = linear_recurrence(a, u, s0[:, d].astype(jnp.float32))
        outs.append(jnp.flip(hs, axis=1) if d == 1 else hs)
        finals.append(h_fin)
    y = ((outs[0] + outs[1]) * jax.nn.silu(g.astype(jnp.float32))).astype(h.dtype)
    return y @ w_out, jnp.stack(finals, axis=1)


def setup_inputs(seed: int = 0) -> dict:
    key = jax.random.key(seed)
    ks = jax.random.split(key, 24)

    def nrm(k, shape, s):
        return jax.random.normal(k, shape, jnp.float32) * s

    x_prompt = nrm(ks[0], (BATCH, SEQ, D_MODEL), 1.0)
    x_sample = nrm(ks[1], (DEC_BATCH, DEC_SEQ, D_MODEL), 1.0)
    state_hgrn = nrm(ks[2], (DEC_BATCH, N_A_LAYERS, 2, H_A, DK_A, DV_A), 0.5)
    cache_na_k = nrm(ks[3], (DEC_BATCH, N_A_LAYERS, H_B, PAST_LEN, DH_B), 1.0)
    cache_na_v = nrm(ks[4], (DEC_BATCH, N_A_LAYERS, H_B, PAST_LEN, DH_B), 1.0)
    state_rglru = nrm(ks[5], (DEC_BATCH, N_C_LAYERS, 2, W_C), 0.5)
    c = nrm(ks[6], (DEC_BATCH, D_MODEL), 1.0)
    c_ctx = nrm(ks[7], (D_MODEL,), 1.0)
    norm_gain = 1.0 + nrm(ks[8], (DEPTH, D_MODEL), 0.02)
    w_mod = nrm(ks[9], (DEPTH, D_MODEL, 3 * D_MODEL), D_MODEL ** -0.5)
    b_mod = nrm(ks[10], (DEPTH, 3 * D_MODEL), 0.02)
    w_in_even = nrm(ks[11], (N_A_LAYERS, D_MODEL, EVEN_IN), D_MODEL ** -0.5)
    w_out_even = nrm(ks[12], (N_A_LAYERS, A_WIDTH + B_WIDTH, D_MODEL), (A_WIDTH + B_WIDTH) ** -0.5)
    hgrn_lb_logits = nrm(ks[13], (2, N_A_LAYERS + 1, A_KEY), 0.5)
    hgrn_out_gain = 1.0 + nrm(ks[14], (N_A_LAYERS, H_A, DV_A), 0.02)
    na_rel_bias = nrm(ks[15], (N_A_LAYERS, H_B, 2 * NA_KH - 1, 2 * NA_KW - 1), 0.1)
    w_in_odd = nrm(ks[16], (N_C_LAYERS, D_MODEL, 2 * W_C), D_MODEL ** -0.5)
    w_out_odd = nrm(ks[17], (N_C_LAYERS, W_C, D_MODEL), W_C ** -0.5)
    conv_w = nrm(ks[18], (N_C_LAYERS, CONV_W, W_C), CONV_W ** -0.5)
    conv_b = nrm(ks[19], (N_C_LAYERS, W_C), 0.02)
    rg_gate_w = nrm(ks[20], (N_C_LAYERS, 2, 2, H_C, BW_C, BW_C), BW_C ** -0.5)
    rg_gate_b = nrm(ks[21], (N_C_LAYERS, 2, 2, W_C), 0.02)
    a_pow = jax.random.uniform(ks[22], (N_C_LAYERS, 2, W_C), jnp.float32, 0.9, 0.999)
    a_base = a_pow ** (1.0 / RG_C)
    rg_lambda = jnp.log(a_base) - jnp.log1p(-a_base)
    final_gain = 1.0 + nrm(ks[23], (D_MODEL,), 0.02)
    return {'x_prompt': x_prompt, 'x_sample': x_sample, 'state_hgrn': state_hgrn,
            'cache_na_k': cache_na_k, 'cache_na_v': cache_na_v, 'state_rglru': state_rglru,
            'c': c, 'c_ctx': c_ctx, 'norm_gain': norm_gain, 'w_mod': w_mod, 'b_mod': b_mod,
            'w_in_even': w_in_even, 'w_out_even': w_out_even, 'hgrn_lb_logits': hgrn_lb_logits,
            'hgrn_out_gain': hgrn_out_gain, 'na_rel_bias': na_rel_bias,
            'w_in_odd': w_in_odd, 'w_out_odd': w_out_odd, 'conv_w': conv_w, 'conv_b': conv_b,
            'rg_gate_w': rg_gate_w, 'rg_gate_b': rg_gate_b, 'rg_lambda': rg_lambda,
            'final_gain': final_gain}


def reference(x_prompt, x_sample, state_hgrn, cache_na_k, cache_na_v, state_rglru, c,
              c_ctx, norm_gain, w_mod, b_mod, w_in_even, w_out_even, hgrn_lb_logits,
              hgrn_out_gain, na_rel_bias, w_in_odd, w_out_odd, conv_w, conv_b,
              rg_gate_w, rg_gate_b, rg_lambda, final_gain):
    lb_all = jnp.cumsum(jax.nn.softmax(hgrn_lb_logits.astype(jnp.float32), axis=1), axis=1)
    xc, xs = x_prompt, x_sample
    cond_ctx = c_ctx[None, :]
    new_hgrn, new_k, new_v, new_rg = [], [], [], []
    for l in range(DEPTH):
        sh_c, sc_c, gt_c = adaln(cond_ctx, w_mod[l], b_mod[l])
        sh_s, sc_s, gt_s = adaln(c, w_mod[l], b_mod[l])
        h_c = rmsnorm(xc, norm_gain[l]) * (1 + sc_c) + sh_c
        h_s = rmsnorm(xs, norm_gain[l]) * (1 + sc_s) + sh_s
        j = l // 2
        if l % 2 == 0:
            s_zero = jnp.zeros((xc.shape[0], 2, H_A, DK_A, DV_A), jnp.float32)
            m_c, s_fin, k_c, v_c = even_mixer(h_c, w_in_even[j], w_out_even[j], lb_all[:, j],
                                              hgrn_out_gain[j], na_rel_bias[j], s_zero, None)
            m_s, _, _, _ = even_mixer(h_s, w_in_even[j], w_out_even[j], lb_all[:, j],
                                      hgrn_out_gain[j], na_rel_bias[j], state_hgrn[:, j],
                                      (cache_na_k[:, j], cache_na_v[:, j]))
            new_hgrn.append(s_fin)
            new_k.append(k_c)
            new_v.append(v_c)
        else:
            s_zero = jnp.zeros((xc.shape[0], 2, W_C), jnp.float32)
            m_c, s_fin = odd_mixer(h_c, w_in_odd[j], w_out_odd[j], conv_w[j], conv_b[j],
                                   rg_gate_w[j], rg_gate_b[j], rg_lambda[j], s_zero)
            m_s, _ = odd_mixer(h_s, w_in_odd[j], w_out_odd[j], conv_w[j], conv_b[j],
                               rg_gate_w[j], rg_gate_b[j], rg_lambda[j], state_rglru[:, j])
            new_rg.append(s_fin)
        xc = xc + gt_c * m_c
        xs = xs + gt_s * m_s
    y_prompt = rmsnorm(xc, final_gain)
    y_sample = rmsnorm(xs, final_gain)
    return (y_prompt, y_sample, jnp.stack(new_hgrn, axis=1), jnp.stack(new_k, axis=1),
            jnp.stack(new_v, axis=1), jnp.stack(new_rg, axis=1))
```

```cpp
#include <hip/hip_runtime.h>
#include <cstdio>
#include <cstdint>
namespace pg8 {
#define PG8_LAS __attribute__((address_space(3)))
typedef unsigned short bf16_t;
typedef short bf16x8 __attribute__((ext_vector_type(8)));
typedef float f32x4 __attribute__((ext_vector_type(4)));
typedef unsigned u32x4 __attribute__((ext_vector_type(4)));
constexpr int BM = 256, BK = 64, HALF = 128, HTB = HALF * BK * 2  , STAGE_BYTES = 8 * HTB, NXCD = 8, WGM = 8;

__host__ __device__ __forceinline__ int lds_byte(int r, int c) { const int st = (r >> 4) * 2 + (c >> 5), rr = r & 15, cc = c & 31, ob = rr * 64 + cc * 2; return st * 1024 + (ob ^ (((ob >> 9) & 1) << 5)); }
__host__ __device__ __forceinline__ void stage_rc(int b, int& R, int& C) { const int st = b / 1024, sb = b % 1024, swz = sb ^ (((sb >> 9) & 1) << 5); R = (st >> 1) * 16 + swz / 64; C = (st & 1) * 32 + (swz % 64) / 2; }
__host__ __device__ __forceinline__ int perm32(int rho) { const int n = rho >> 4, i = rho & 15; return 8 * (i >> 2) + 4 * n + (i & 3); }

struct Unit { int pm, pn; };
struct Gemm { const bf16_t* A; const bf16_t* Bt; int M, N, K; };

struct StaticOrder {
    int nM, nN, nwg, G, c;
    __host__ __device__ void init(int M, int N, int G_, int c_) { nM = M / BM; nN = N / BM; nwg = nM * nN; G = G_; c = c_; }
    __host__ __device__ bool next(int i, Unit& u) const {
        const long L = (long)i * G + c; if (L >= nwg) return false;
        int wgid = (int)L; { const int q = nwg / NXCD, r = nwg % NXCD, xcd = wgid % NXCD, off = wgid / NXCD; wgid = (xcd < r ? xcd * (q + 1) : r * (q + 1) + (xcd - r) * q) + off; }
        const int nig = WGM * nN, gid = wgid / nig, fm = gid * WGM, gsz = (nM - fm) < WGM ? (nM - fm) : WGM;
        u.pm = fm + ((wgid % nig) % gsz); u.pn = (wgid % nig) / gsz; return true;
    }
    __device__ __forceinline__ void a_ready(const Unit&) const {}
    __device__ __forceinline__ void done(const Unit&) const {}
};

__device__ __forceinline__ unsigned cvt_pk_bf16(float lo, float hi) { unsigned r; asm volatile("v_cvt_pk_bf16_f32 %0, %1, %2" : "=v"(r) : "v"(lo), "v"(hi)); return r; }
typedef float f32x2 __attribute__((ext_vector_type(2)));
struct EpiProj {
    static constexpr bool PERM = true, AFTER_DRAIN = false;
    bf16_t* O; int ldc; float* kv;
    __device__ __forceinline__ void operator()(const f32x4 (&acc)[2][2][4][2], const Unit& u, int wr, int wc, int fr, int fq) const {
        const int row0 = u.pm * BM + wr * 64 + fr; const int col0 = u.pn * BM + wc * 32 + 8 * fq;
        const bool dokv = (kv != nullptr) && u.pm < 16 && u.pn >= 12 && u.pn < 16;
#pragma unroll
        for (int ai = 0; ai < 2; ++ai)
#pragma unroll
            for (int m = 0; m < 4; ++m) { bf16_t* rowp = O + (size_t)(row0 + ai * HALF + m * 16) * ldc + col0;
#pragma unroll
                for (int bj = 0; bj < 2; ++bj) { const f32x4 v0 = acc[ai][bj][m][0], v1 = acc[ai][bj][m][1];
                    u32x4 w; w.x = cvt_pk_bf16(v0[0], v0[1]); w.y = cvt_pk_bf16(v0[2], v0[3]); w.z = cvt_pk_bf16(v1[0], v1[1]); w.w = cvt_pk_bf16(v1[2], v1[3]);
                    *(u32x4*)(rowp + bj * HALF) = w;
                    if (dokv) { const int cc = col0 + bj * HALF - 3072, which = cc >> 9, c2 = cc & 511, head = c2 >> 6, d = c2 & 63, t = wr * 64 + fr + ai * HALF + m * 16;
                        float* p = kv + (size_t)which * 2097152 + ((size_t)(u.pm * 8 + head) * 256 + t) * 64 + d; *(f32x4*)p = v0; *(f32x4*)(p + 4) = v1; } } }
    }
};
struct EpiRes {
    static constexpr bool PERM = false, AFTER_DRAIN = false;
    const float* base0; const float* base1; float* out; const float* gate;
    __device__ __forceinline__ void operator()(const f32x4 (&acc)[2][2][4][2], const Unit& u, int wr, int wc, int fr, int fq) const {
        const int nidx = u.pm < 16 ? 0 : 1 + ((u.pm - 16) >> 3);
        const float* gp = gate + (size_t)nidx * 3072;
        const int col0 = u.pn * BM + wc * 32 + 4 * fq;
        f32x4 gv[2][2];
#pragma unroll
        for (int bj = 0; bj < 2; ++bj)
#pragma unroll
            for (int n = 0; n < 2; ++n) gv[bj][n] = *(const f32x4*)(gp + col0 + bj * HALF + n * 16);
#pragma unroll
        for (int ai = 0; ai < 2; ++ai)
#pragma unroll
            for (int m = 0; m < 4; ++m) { const int row = u.pm * BM + ai * HALF + wr * 64 + m * 16 + fr;
                const float* bp = (row < 4096 ? base0 + (size_t)row * 1024 : base1 + (size_t)(row - 4096) * 1024) + col0;
                float* op = out + (size_t)row * 1024 + col0;
#pragma unroll
                for (int bj = 0; bj < 2; ++bj)
#pragma unroll
                    for (int n = 0; n < 2; ++n) { const f32x4 b = *(const f32x4*)(bp + bj * HALF + n * 16); *(f32x4*)(op + bj * HALF + n * 16) = b + gv[bj][n] * acc[ai][bj][m][n]; } }
    }
};
template <class Epi, class Sched, bool ALIGN_EPI = false, bool SP2 = false>
__device__ __forceinline__ void gemm_phase(PG8_LAS unsigned char* lds, const Gemm g, const Sched& S, const Epi& E) {
    const int tid = threadIdx.x, wid = __builtin_amdgcn_readfirstlane(tid >> 6), lane = tid & 63, wr = wid >> 2, wc = wid & 3, fr = lane & 15, fq = lane >> 4;
    const int K = g.K, nt = K / BK;
    unsigned voffA[2], voffB[2];
#pragma unroll
    for (int i = 0; i < 2; ++i) { int R, C; stage_rc(tid * 16 + i * 8192, R, C); const int Rb = Epi::PERM ? ((R & ~31) + perm32(R & 31)) : R;
        voffA[i] = (unsigned)(R * K + C) * 2u; voffB[i] = (unsigned)(Rb * K + C) * 2u; }
    const size_t kstep = (size_t)(BK * 2);
    const size_t hstep = (size_t)HALF * K * 2;
    const size_t tstep = 2 * hstep;
    const unsigned ldsw = (unsigned)wid * 1024u;
    const int aoff = lds_byte(wr * 64 + fr, fq * 8), boff = lds_byte(wc * 32 + fr, fq * 8);
#define PG8_SA(b, h) (((b) * 2 + (h)) * HTB)
#define PG8_SB(b, h) ((4 + (b) * 2 + (h)) * HTB)
#define PG8_STAGE(bufoff, gbase, voff) do { _Pragma("unroll") for (int _i = 0; _i < 2; ++_i) \
        __builtin_amdgcn_global_load_lds((const unsigned*)((const char*)(gbase) + (voff)[_i]), (PG8_LAS unsigned*)(lds + (bufoff) + ldsw + _i * 8192), 16, 0, 0); } while (0)
#define PG8_LDA(dst, b, h) do { _Pragma("unroll") for (int m = 0; m < 4; ++m) _Pragma("unroll") for (int k = 0; k < 2; ++k) dst[m][k] = *(const PG8_LAS bf16x8*)(lds + PG8_SA(b, h) + aoff + m * 2048 + k * 1024); } while (0)
#define PG8_LDB(dst, b, h) do { _Pragma("unroll") for (int n = 0; n < 2; ++n) _Pragma("unroll") for (int k = 0; k < 2; ++k) dst[n][k] = *(const PG8_LAS bf16x8*)(lds + PG8_SB(b, h) + boff + n * 2048 + k * 1024); } while (0)
#define PG8_MMA(ai, bj, At, Bt) do { __builtin_amdgcn_s_setprio(1); _Pragma("unroll") for (int m = 0; m < 4; ++m) _Pragma("unroll") for (int n = 0; n < 2; ++n) _Pragma("unroll") for (int k = 0; k < 2; ++k) \
        acc[ai][bj][m][n] = __builtin_amdgcn_mfma_f32_16x16x32_bf16(Bt[n][k], At[m][k], acc[ai][bj][m][n], 0, 0, 0); __builtin_amdgcn_s_setprio(0); } while (0)
#define PG8_WAIT_V(n) asm volatile("s_waitcnt vmcnt(" #n ")" ::: "memory")
#define PG8_WAIT_L(n) asm volatile("s_waitcnt lgkmcnt(" #n ")" ::: "memory")
#define PG8_BAR __builtin_amdgcn_s_barrier()
#define PG8_SCHED __builtin_amdgcn_sched_barrier(0)
    Unit cur, nxt; int ui = 0;
    if (!S.next(0, cur)) return;
    f32x4 acc[2][2][4][2];
#pragma unroll
    for (int a = 0; a < 2; ++a)
#pragma unroll
        for (int b = 0; b < 2; ++b)
#pragma unroll
            for (int m = 0; m < 4; ++m)
#pragma unroll
                for (int n = 0; n < 2; ++n) acc[a][b][m][n] = (f32x4){0.f, 0.f, 0.f, 0.f};
    bf16x8 At[4][2], B0[2][2], B1[2][2];
    const char* cA = (const char*)g.A + (size_t)cur.pm * tstep; const char* cB = (const char*)g.Bt + (size_t)cur.pn * tstep;
    S.a_ready(cur);
    if constexpr (SP2) {
        PG8_STAGE(PG8_SB(0, 0), cB, voffB); PG8_STAGE(PG8_SB(0, 1), cB + hstep, voffB); PG8_STAGE(PG8_SA(0, 0), cA, voffA); PG8_STAGE(PG8_SA(0, 1), cA + hstep, voffA);
        if (wr == 1) PG8_BAR;
        PG8_WAIT_V(2); PG8_BAR;
        PG8_STAGE(PG8_SB(1, 0), cB + kstep, voffB); PG8_STAGE(PG8_SA(1, 0), cA + kstep, voffA); PG8_STAGE(PG8_SB(1, 1), cB + hstep + kstep, voffB);
        PG8_WAIT_V(6); PG8_BAR;
    } else {
        PG8_STAGE(PG8_SB(0, 0), cB, voffB); PG8_STAGE(PG8_SA(0, 0), cA, voffA); PG8_STAGE(PG8_SB(0, 1), cB + hstep, voffB); PG8_STAGE(PG8_SA(0, 1), cA + hstep, voffA);
        if (wr == 1) PG8_BAR;
        PG8_WAIT_V(4); PG8_BAR;
        PG8_STAGE(PG8_SB(1, 0), cB + kstep, voffB); PG8_STAGE(PG8_SA(1, 0), cA + kstep, voffA); PG8_STAGE(PG8_SB(1, 1), cB + hstep + kstep, voffB);
        PG8_WAIT_V(6); PG8_BAR;
    }
    for (;;) {
        const bool has_next = S.next(ui + 1, nxt);
        const char* nA = has_next ? (const char*)g.A + (size_t)nxt.pm * tstep : cA; const char* nB = has_next ? (const char*)g.Bt + (size_t)nxt.pn * tstep : cB;
        for (int t = 0; t < nt; t += 2) {
            const bool last = (t == nt - 2);
            const char* a1 = cA + (size_t)(t + 1) * kstep;
            const char* a2 = last ? nA : cA + (size_t)(t + 2) * kstep; const char* b2 = last ? nB : cB + (size_t)(t + 2) * kstep;
            const char* a3 = a2 + kstep; const char* b3 = b2 + kstep;
            if (last && has_next) S.a_ready(nxt);
            if constexpr (SP2) {
            PG8_LDB(B0, 0, 0); PG8_LDB(B1, 0, 1); PG8_SCHED; PG8_LDA(At, 0, 0); PG8_STAGE(PG8_SA(1, 1), a1 + hstep, voffA);
            PG8_WAIT_V(8); PG8_WAIT_L(0); PG8_BAR; PG8_MMA(0, 0, At, B0); PG8_MMA(0, 1, At, B1); PG8_BAR; PG8_SCHED;
            PG8_LDA(At, 0, 1); PG8_STAGE(PG8_SB(0, 0), b2, voffB); PG8_STAGE(PG8_SB(0, 1), b2 + hstep, voffB); PG8_STAGE(PG8_SA(0, 0), a2, voffA);
            PG8_WAIT_V(8); PG8_WAIT_L(0); PG8_BAR; PG8_MMA(1, 0, At, B0); PG8_MMA(1, 1, At, B1); PG8_BAR; PG8_SCHED;
            PG8_LDB(B0, 1, 0); PG8_LDB(B1, 1, 1); PG8_SCHED; PG8_LDA(At, 1, 0); PG8_STAGE(PG8_SA(0, 1), a2 + hstep, voffA);
            PG8_WAIT_V(8); PG8_WAIT_L(0); PG8_BAR; PG8_MMA(0, 0, At, B0); PG8_MMA(0, 1, At, B1); PG8_BAR; PG8_SCHED;
            PG8_LDA(At, 1, 1); PG8_STAGE(PG8_SB(1, 0), b3, voffB); PG8_STAGE(PG8_SB(1, 1), b3 + hstep, voffB); PG8_STAGE(PG8_SA(1, 0), a3, voffA);
            PG8_WAIT_V(8); PG8_WAIT_L(0); PG8_BAR; PG8_MMA(1, 0, At, B0); PG8_MMA(1, 1, At, B1); PG8_BAR; PG8_SCHED;
            } else {
            PG8_LDB(B0, 0, 0); PG8_SCHED; PG8_LDA(At, 0, 0); PG8_STAGE(PG8_SA(1, 1), a1 + hstep, voffA);
            PG8_WAIT_L(8); PG8_BAR; PG8_WAIT_L(0); PG8_MMA(0, 0, At, B0); PG8_BAR; PG8_SCHED;
            PG8_LDB(B1, 0, 1); PG8_STAGE(PG8_SB(0, 0), b2, voffB);
            PG8_BAR; PG8_WAIT_L(0); PG8_MMA(0, 1, At, B1); PG8_BAR;
            PG8_LDA(At, 0, 1); PG8_STAGE(PG8_SA(0, 0), a2, voffA);
            PG8_BAR; PG8_WAIT_L(0); PG8_MMA(1, 0, At, B0); PG8_BAR; PG8_SCHED;
            PG8_STAGE(PG8_SB(0, 1), b2 + hstep, voffB);
            PG8_WAIT_V(6); PG8_BAR; PG8_MMA(1, 1, At, B1); PG8_BAR;
            PG8_LDB(B0, 1, 0); PG8_SCHED; PG8_LDA(At, 1, 0); PG8_STAGE(PG8_SA(0, 1), a2 + hstep, voffA);
            PG8_WAIT_L(8); PG8_BAR; PG8_WAIT_L(0); PG8_MMA(0, 0, At, B0); PG8_BAR; PG8_SCHED;
            PG8_LDB(B1, 1, 1); PG8_STAGE(PG8_SB(1, 0), b3, voffB);
            PG8_BAR; PG8_WAIT_L(0); PG8_MMA(0, 1, At, B1); PG8_BAR;
            PG8_LDA(At, 1, 1); PG8_STAGE(PG8_SA(1, 0), a3, voffA);
            PG8_BAR; PG8_WAIT_L(0); PG8_MMA(1, 0, At, B0); PG8_BAR; PG8_SCHED;
            PG8_STAGE(PG8_SB(1, 1), b3 + hstep, voffB);
            PG8_WAIT_V(6); PG8_BAR; PG8_MMA(1, 1, At, B1); PG8_BAR;
            }
        }
        if constexpr (ALIGN_EPI) { if (wr == 0) PG8_BAR; }
        if constexpr (!Epi::AFTER_DRAIN) { E(acc, cur, wr, wc, fr, fq); S.done(cur); }
        if (!has_next) break;
#pragma unroll
        for (int a = 0; a < 2; ++a)
#pragma unroll
            for (int b = 0; b < 2; ++b)
#pragma unroll
                for (int m = 0; m < 4; ++m)
#pragma unroll
                    for (int n = 0; n < 2; ++n) acc[a][b][m][n] = (f32x4){0.f, 0.f, 0.f, 0.f};
        cur = nxt; cA = nA; cB = nB; ++ui;
        if constexpr (ALIGN_EPI) { if (wr == 1) PG8_BAR; }
    }
    PG8_WAIT_V(0);
    if constexpr (!ALIGN_EPI) { if (wr == 0) PG8_BAR; }
    PG8_BAR;
    if constexpr (Epi::AFTER_DRAIN) { E.fused(acc, cur, wr, wc, fr, fq, lds, wid, lane); S.done(cur); }
#undef PG8_SA
#undef PG8_SB
#undef PG8_STAGE
#undef PG8_LDA
#undef PG8_LDB
#undef PG8_MMA
#undef PG8_WAIT_V
#undef PG8_WAIT_L
#undef PG8_BAR
#undef PG8_SCHED
}
}
constexpr int NWAVES = 8;
constexpr int DM = 1024, M_CTX = 4096, M_LAT = 16384, M_ALL = 20480, EVEN_IN = 4608, ODD_IN = 2048;
constexpr size_t MiB = 1u << 20;
constexpr size_t WS_CTL = 0, CTL_ZERO_BYTES = 1 * MiB;
constexpr size_t WS_MODS = 1 * MiB;
constexpr size_t WS_WIE = 2 * MiB, WS_WOE = 11 * MiB, WS_WIO = 13 * MiB, WS_WOO = 17 * MiB, WS_GW = 19 * MiB;
constexpr size_t WS_AGG = 20 * MiB;
constexpr size_t WS_H = 26 * MiB;
constexpr size_t WS_PROJ = 66 * MiB;
constexpr size_t WS_END = 246 * MiB;
constexpr size_t OUT_Y = 0, OUT_HG = 20971520, OUT_K = 23068672, OUT_V = 25165824, OUT_RG = 27262976, OUT_TOTAL = 27295744;
constexpr int CW_TMO = 0, CW_CODE = 1, CW_BAR = 4096, CW_QUEUE = 16384;
constexpr int RING_BYTES = 131072;
constexpr int LDS_BYTES = 162816, MISC_OFF = LDS_BYTES - 512;
constexpr int NPHASE = 12;

#define GAS __attribute__((address_space(1)))
#define LAS __attribute__((address_space(3)))
typedef unsigned short bf16;
typedef unsigned v4u __attribute__((ext_vector_type(4)));
typedef unsigned v2u __attribute__((ext_vector_type(2)));
typedef float f32x4 __attribute__((ext_vector_type(4)));
typedef float f32x16 __attribute__((ext_vector_type(16)));
typedef short bf16x8 __attribute__((ext_vector_type(8)));
typedef short s16x4 __attribute__((ext_vector_type(4)));
typedef GAS unsigned gu32;
#define RLX_AGENT __ATOMIC_RELAXED, __HIP_MEMORY_SCOPE_AGENT
#define LDS_WAIT() asm volatile("s_waitcnt lgkmcnt(0)" ::: "memory")
#define VM_WAIT() asm volatile("s_waitcnt vmcnt(0)" ::: "memory")
__device__ __forceinline__ unsigned f2bf(float f) { unsigned u = __builtin_bit_cast(unsigned, f); return (u + 0x7fffu + ((u >> 16) & 1u)) >> 16; }
__device__ __forceinline__ unsigned pk2(float lo, float hi) { return f2bf(lo) | (f2bf(hi) << 16); }
__device__ __forceinline__ float bf2f(unsigned b) { return __builtin_bit_cast(float, b << 16); }
__device__ __forceinline__ float bflo(unsigned w) { return __builtin_bit_cast(float, w << 16); }
__device__ __forceinline__ float bfhi(unsigned w) { return __builtin_bit_cast(float, w & 0xffff0000u); }
__device__ __forceinline__ float sigmoidf(float x) { return 1.0f / (1.0f + __expf(-x)); }
__device__ __forceinline__ float siluf(float x) { return x / (1.0f + __expf(-x)); }
#define XB_TMO      128
#define XB_XCNT(j)  (256  + 64 * (j))
#define XB_XSUB(j)  (1280 + 64 * (j))
#define XB_XGEN(j)  (2304 + 64 * (j))
#define XB_TOP      3328
#define XB_TOPGEN   3392
#define XCD_BAR_WORDS 3456
#define XB_SPIN_CAP (1u << 18)

__device__ __forceinline__ unsigned xb_ld(unsigned* p)              { return __hip_atomic_load(p, __ATOMIC_RELAXED, __HIP_MEMORY_SCOPE_AGENT); }
__device__ __forceinline__ unsigned xb_add(unsigned* p, unsigned v) { return __hip_atomic_fetch_add(p, v, __ATOMIC_RELAXED, __HIP_MEMORY_SCOPE_AGENT); }
__device__ __forceinline__ unsigned xb_xcc_id() { return (unsigned)__builtin_amdgcn_s_getreg((3 << 11) | 20) & 0xFu; }
#define XB_SPIN(cond, bar) do { unsigned _sp = 0; while (cond) { __builtin_amdgcn_s_sleep(1); \
    if ((++_sp & 255u) == 0u) { if (xb_ld(&(bar)[XB_TMO])) break; if (_sp > XB_SPIN_CAP) { atomicAdd(&(bar)[XB_TMO], 1u); break; } } } } while (0)

struct XcdBarrier {
    unsigned* bar; unsigned x;
    volatile LAS unsigned* st;
};

__device__ __forceinline__ XcdBarrier xcd_barrier_post(unsigned* bar, volatile LAS unsigned* st) {
    XcdBarrier b; b.bar = bar; b.x = xb_xcc_id(); b.st = st;
    if (threadIdx.x == 0) (void)xb_add(&bar[XB_XCNT(b.x)], 1u);
    return b;
}
__device__ __forceinline__ void xcd_barrier_complete(unsigned* bar, unsigned x, unsigned& nloc, unsigned& nx) {
    const unsigned G = gridDim.x * gridDim.y * gridDim.z;
    unsigned sum, cnt, mine, sp = 0u;
    for (;;) {
        sum = 0u; cnt = 0u; mine = 0u;
#pragma unroll
        for (unsigned j = 0; j < 16; ++j) { const unsigned c = xb_ld(&bar[XB_XCNT(j)]); sum += c; cnt += (c > 0u) ? 1u : 0u; mine = (j == x) ? c : mine; }
        if (sum == G) break;
        __builtin_amdgcn_s_sleep(1);
        if ((++sp & 255u) == 0u) { if (xb_ld(&bar[XB_TMO])) break; if (sp > XB_SPIN_CAP) { atomicAdd(&bar[XB_TMO], 1u); break; } }
    }
    nloc = mine > 0u ? mine : 1u; nx = cnt > 0u ? cnt : 1u;
}

__device__ __forceinline__ void xcd_barrier(const XcdBarrier& b) {
    asm volatile("s_waitcnt vmcnt(0)" ::: "memory");
    __syncthreads();
    if (threadIdx.x == 0) {
        unsigned* bar = b.bar;
        __builtin_amdgcn_s_waitcnt(0);
        unsigned nloc = b.st[0], nx = b.st[1];
        if (nloc == 0u) { xcd_barrier_complete(bar, b.x, nloc, nx); b.st[0] = nloc; b.st[1] = nx; }
        const unsigned old = xb_add(&bar[XB_XSUB(b.x)], 1u);
        const unsigned gen = old / nloc;
        if (old + 1u == (gen + 1u) * nloc) {
            __builtin_amdgcn_fence(__ATOMIC_RELEASE, "agent");
            asm volatile("s_waitcnt vmcnt(0)" ::: "memory");
            const unsigned og = xb_add(&bar[XB_TOP], 1u);
            const unsigned tg = og / nx;
            if (og + 1u == (tg + 1u) * nx) xb_add(&bar[XB_TOPGEN], 1u);
            else XB_SPIN(xb_ld(&bar[XB_TOPGEN]) == tg, bar);
            __builtin_amdgcn_fence(__ATOMIC_ACQUIRE, "agent");
            xb_add(&bar[XB_XGEN(b.x)], 1u);
            asm volatile("s_waitcnt vmcnt(0)" ::: "memory");
        } else {
            XB_SPIN(xb_ld(&bar[XB_XGEN(b.x)]) == gen, bar);
            __builtin_amdgcn_fence(__ATOMIC_ACQUIRE, "agent");
            asm volatile("s_waitcnt vmcnt(0)" ::: "memory");
        }
    }
    __syncthreads();
}
struct Frame {
    unsigned char* lds;
    volatile LAS unsigned* MISC;
    gu32* ctl;
    int tid, lane, wave, vcu, G;
    const float* in[24];
    float* out; unsigned char* ws;
};
__device__ __forceinline__ float wave_sum(float v) {
#pragma unroll
    for (int o = 1; o < 64; o <<= 1) v += __shfl_xor(v, o);
    return v;
}
__device__ __forceinline__ void p0_transpose_item(const float* W, int K, int N, bf16* WT, float* scr, int item, int lane) {
    const int nblk = N / 32, kb = item / nblk, nb = item % nblk, k0 = 64 * kb, n0 = 32 * nb;
#pragma unroll 8
    for (int i = 0; i < 32; ++i) { const int kk = 2 * i + (lane >> 5); scr[kk * 33 + (lane & 31)] = W[(size_t)(k0 + kk) * N + n0 + (lane & 31)]; }
    LDS_WAIT(); asm volatile("" ::: "memory");
    const int c = lane & 7;
#pragma unroll
    for (int j = 0; j < 4; ++j) { const int n = (lane >> 3) + 8 * j; const float* s = scr + (8 * c) * 33 + n;
        v4u o; o.x = pk2(s[0 * 33], s[1 * 33]); o.y = pk2(s[2 * 33], s[3 * 33]); o.z = pk2(s[4 * 33], s[5 * 33]); o.w = pk2(s[6 * 33], s[7 * 33]);
        *(v4u*)(WT + (size_t)(n0 + n) * K + k0 + 8 * c) = o; }
    LDS_WAIT(); asm volatile("" ::: "memory");
}
__device__ __forceinline__ void p0_prologue(Frame& F) {
    float* mods = (float*)(F.ws + WS_MODS);
    for (int it = blockIdx.x; it < 96; it += F.G) {
        const int l = it / 48, c0 = (it % 48) * 64;
        float* S = (float*)F.lds;
        for (int idx = F.tid; idx < 9216; idx += NWAVES * 64) { const int n = idx >> 10, k = idx & 1023; const float v = n == 0 ? F.in[7][k] : F.in[6][(n - 1) * 1024 + k]; S[idx] = siluf(v); }
        __syncthreads();
        const float* W = F.in[9] + (size_t)l * 1024 * 3072 + c0 + F.lane;
        float acc[9];
#pragma unroll
        for (int n = 0; n < 9; ++n) acc[n] = 0.f;
        const int k0 = F.wave * 128;
#pragma unroll 4
        for (int kk = 0; kk < 128; ++kk) { const float wv = W[(size_t)(k0 + kk) * 3072];
#pragma unroll
            for (int n = 0; n < 9; ++n) acc[n] += S[n * 1024 + k0 + kk] * wv; }
        float* red = S + 9216;
#pragma unroll
        for (int n = 0; n < 9; ++n) red[(F.wave * 9 + n) * 64 + F.lane] = acc[n];
        __syncthreads();
        for (int idx = F.tid; idx < 576; idx += NWAVES * 64) { const int n = idx >> 6, ln = idx & 63; float s = F.in[10][l * 3072 + c0 + ln];
#pragma unroll
            for (int w = 0; w < 8; ++w) s += red[(w * 9 + n) * 64 + ln];
            mods[(size_t)(l * 9 + n) * 3072 + c0 + ln] = s; }
        __syncthreads();
    }
    float* scr = (float*)(F.lds + F.wave * 16384);
    const int gw = F.vcu * NWAVES + F.wave, NGW = F.G * NWAVES;
    constexpr int I0 = 16 * 144, I1 = 16 * 32, I2 = 16 * 64, I3 = 16 * 32, I4 = 32 * 8;
    for (int it = gw; it < I0 + I1 + I2 + I3 + I4; it += NGW) {
        int r = it;
        if (r < I0) { p0_transpose_item(F.in[11], 1024, 4608, (bf16*)(F.ws + WS_WIE), scr, r, F.lane); continue; } r -= I0;
        if (r < I1) { p0_transpose_item(F.in[12], 1024, 1024, (bf16*)(F.ws + WS_WOE), scr, r, F.lane); continue; } r -= I1;
        if (r < I2) { p0_transpose_item(F.in[16], 1024, 2048, (bf16*)(F.ws + WS_WIO), scr, r, F.lane); continue; } r -= I2;
        if (r < I3) { p0_transpose_item(F.in[17], 1024, 1024, (bf16*)(F.ws + WS_WOO), scr, r, F.lane); continue; } r -= I3;
        const int mat = r >> 3;
        p0_transpose_item(F.in[20] + (size_t)mat * 16384, 128, 128, (bf16*)(F.ws + WS_GW) + (size_t)mat * 16384, scr, r & 7, F.lane);
    }
}
__device__ __forceinline__ void modnorm_rows(Frame& F, int layer, const float* xa, const float* xb) {
    const float* mods = (const float*)(F.ws + WS_MODS) + (size_t)layer * 9 * 3072;
    const float* gain = F.in[8] + layer * 1024;
    bf16* H = (bf16*)(F.ws + WS_H);
    const int gw = F.vcu * NWAVES + F.wave, NGW = F.G * NWAVES;
    for (int m = gw; m < M_ALL; m += NGW) {
        const int n = m < M_CTX ? 0 : 1 + ((m - M_CTX) >> 11);
        const f32x4* xr = (const f32x4*)(m < M_CTX ? xa + (size_t)m * DM : xb + (size_t)(m - M_CTX) * DM) + F.lane;
        const f32x4* sh = (const f32x4*)(mods + (size_t)n * 3072) + F.lane; const f32x4* sc = (const f32x4*)(mods + (size_t)n * 3072 + 1024) + F.lane;
        const f32x4* gp = (const f32x4*)gain + F.lane;
        f32x4 v[4]; float s = 0.f;
#pragma unroll
        for (int j = 0; j < 4; ++j) { v[j] = xr[64 * j]; s += (v[j].x * v[j].x + v[j].y * v[j].y) + (v[j].z * v[j].z + v[j].w * v[j].w); }
        const float rstd = 1.0f / sqrtf(wave_sum(s) * (1.0f / DM) + 1e-6f);
        unsigned long long* o8 = (unsigned long long*)(H + (size_t)m * DM) + F.lane;
#pragma unroll
        for (int j = 0; j < 4; ++j) { const f32x4 g = gp[64 * j], a = sc[64 * j], b = sh[64 * j]; const f32x4 o = v[j] * rstd * g * (1.0f + a) + b;
            o8[64 * j] = (unsigned long long)pk2(o.x, o.y) | ((unsigned long long)pk2(o.z, o.w) << 32); }
    }
}
__device__ __forceinline__ void hgrn_naive_item(Frame& F, int item) {
    const int s = item >> 3, h = (item >> 1) & 3, d = item & 1;
    const bool lat = s >= 16; const int T = lat ? 2048 : 256; const int row0 = lat ? M_CTX + (s - 16) * 2048 : s * 256;
    bf16* P = (bf16*)(F.ws + WS_PROJ);
    float* Lq = (float*)F.lds; float* Lf = Lq + 128; float* Lk = Lf + 128; float* Lv = Lk + 128; float* Lp = Lv + 128;
    const int tid = F.tid, dv = tid & 127, kq = tid >> 7;
    const int zcol = (d == 0 ? 512 : 1024) + h * 128;
    float S[32];
    if (lat) { const float* s0 = F.in[2] + ((size_t)(((s - 16) * 2 + d) * 4 + h)) * 16384;
#pragma unroll
        for (int i = 0; i < 32; ++i) S[i] = s0[(32 * kq + i) * 128 + dv]; }
    else {
#pragma unroll
        for (int i = 0; i < 32; ++i) S[i] = 0.f; }
    float lbv = 0.f;
    if (tid < 128) { const float l0 = F.in[13][(d * 2 + 0) * 512 + h * 128 + tid], l1 = F.in[13][(d * 2 + 1) * 512 + h * 128 + tid]; lbv = 1.0f / (1.0f + __expf(l1 - l0)); }
    __syncthreads();
    for (int tt = 0; tt < T; ++tt) {
        const int tok = d == 0 ? tt : T - 1 - tt; const size_t rb = (size_t)(row0 + tok) * EVEN_IN;
        if (tid < 128) { const float z = bf2f(P[rb + zcol + tid]); const float sg = sigmoidf(z);
            Lf[tid] = lbv + (1.0f - lbv) * sg; Lk[tid] = (1.0f - lbv) * (1.0f - sg); Lq[tid] = bf2f(P[rb + h * 128 + tid]); }
        else if (tid < 256) Lv[tid - 128] = bf2f(P[rb + 1536 + h * 128 + (tid - 128)]);
        __syncthreads();
        const float v = Lv[dv]; float part = 0.f;
#pragma unroll
        for (int i = 0; i < 32; ++i) { const int dk = 32 * kq + i; S[i] = Lf[dk] * S[i] + Lk[dk] * v; part += S[i] * Lq[dk]; }
        Lp[kq * 128 + dv] = part;
        __syncthreads();
        if (tid < 128) { const float o = (Lp[tid] + Lp[128 + tid]) + (Lp[256 + tid] + Lp[384 + tid]); P[rb + zcol + tid] = (bf16)f2bf(o); }
    }
    if (!lat) { float* so = F.out + OUT_HG + ((size_t)((s * 2 + d) * 4 + h)) * 16384;
#pragma unroll
        for (int i = 0; i < 32; ++i) so[(32 * kq + i) * 128 + dv] = S[i]; }
    __syncthreads();
}
__device__ __forceinline__ float dot64_bf(const float* qs, const bf16* kp) {
    float dot = 0.f;
    for (int e = 0; e < 8; ++e) { const v4u w = ((const v4u*)kp)[e]; const float* q = qs + 8 * e;
        dot += (q[0] * bflo(w.x) + q[1] * bfhi(w.x)) + (q[2] * bflo(w.y) + q[3] * bfhi(w.y)) + (q[4] * bflo(w.z) + q[5] * bfhi(w.z)) + (q[6] * bflo(w.w) + q[7] * bfhi(w.w)); }
    return dot;
}
__device__ __forceinline__ void attn_naive_item(Frame& F, int it) {
    const int m = it >> 3, head = it & 7, lane = F.lane;
    bf16* P = (bf16*)(F.ws + WS_PROJ);
    float* qs = (float*)(F.lds + F.wave * 2048); float* ps = qs + 64;
    qs[lane] = bf2f(P[(size_t)m * EVEN_IN + 2560 + head * 64 + lane]);
    LDS_WAIT(); asm volatile("" ::: "memory");
    float sc[6]; int nk;
    const bool lat = m >= M_CTX;
    int b = 0, r = 0, c = 0, rs = 0, wsx = 0;
    if (lat) { b = (m - M_CTX) >> 11; const int t = (m - M_CTX) & 2047; r = t >> 6; c = t & 63; rs = min(max(r - 4, 0), 24); wsx = min(max(c - 8, 0), 48); nk = 6; } else { b = m >> 8; nk = 4; }
#pragma unroll
    for (int i = 0; i < 6; ++i) {
        sc[i] = -1e30f;
        if (i < nk) {
            const int j = lane + 64 * i; float dot = 0.f, bias = 0.f;
            if (lat && i < 2) { const int kr = j >> 4, kc = j & 15; const int tk = (rs + kr) * 64 + wsx + kc;
                dot = dot64_bf(qs, P + (size_t)(M_CTX + b * 2048 + tk) * EVEN_IN + 3072 + head * 64);
                bias = F.in[15][(head * 15 + (rs + kr - r + 7)) * 31 + (wsx + kc - c + 15)]; }
            else if (lat) { const float* kp = F.in[3] + ((size_t)(b * 8 + head) * 256 + (j - 128)) * 64;
                for (int e = 0; e < 16; ++e) { const f32x4 kv = ((const f32x4*)kp)[e]; dot += (qs[4 * e] * kv.x + qs[4 * e + 1] * kv.y) + (qs[4 * e + 2] * kv.z + qs[4 * e + 3] * kv.w); } }
            else dot = dot64_bf(qs, P + (size_t)(b * 256 + j) * EVEN_IN + 3072 + head * 64);
            sc[i] = dot * 0.125f + bias;
        }
    }
    float mx = sc[0];
#pragma unroll
    for (int i = 1; i < 6; ++i) mx = fmaxf(mx, sc[i]);
#pragma unroll
    for (int o = 1; o < 64; o <<= 1) mx = fmaxf(mx, __shfl_xor(mx, o));
    float sum = 0.f;
#pragma unroll
    for (int i = 0; i < 6; ++i) { sc[i] = (i < nk) ? __expf(sc[i] - mx) : 0.f; sum += sc[i]; }
    sum = wave_sum(sum); const float inv = 1.0f / sum;
#pragma unroll
    for (int i = 0; i < 6; ++i) if (i < nk) ps[lane + 64 * i] = sc[i] * inv;
    LDS_WAIT(); asm volatile("" ::: "memory");
    float o = 0.f;
    if (lat) {
        for (int j = 0; j < 128; ++j) { const int kr = j >> 4, kc = j & 15; const int tk = (rs + kr) * 64 + wsx + kc;
            o += ps[j] * bf2f(P[(size_t)(M_CTX + b * 2048 + tk) * EVEN_IN + 3584 + head * 64 + lane]); }
        const float* vp = F.in[4] + ((size_t)(b * 8 + head) * 256) * 64 + lane;
        for (int j = 0; j < 256; ++j) o += ps[128 + j] * vp[(size_t)j * 64];
    } else {
        for (int j = 0; j < 256; ++j) o += ps[j] * bf2f(P[(size_t)(b * 256 + j) * EVEN_IN + 3584 + head * 64 + lane]);
    }
    P[(size_t)m * EVEN_IN + 2560 + head * 64 + lane] = (bf16)f2bf(o);
    LDS_WAIT(); asm volatile("" ::: "memory");
}
constexpr size_t WS_RGF = WS_PROJ + 80 * MiB, WS_RGB = WS_PROJ + 120 * MiB;
__device__ __forceinline__ void rg_naive_item(Frame& F, int item) {
    const int s = item >> 4, hb = (item >> 1) & 7, d = item & 1;
    const bool lat = s >= 16; const int T = lat ? 2048 : 256; const int row0 = lat ? M_CTX + (s - 16) * 2048 : s * 256;
    const bf16* P2 = (const bf16*)(F.ws + WS_PROJ);
    bf16* O = (bf16*)(F.ws + (d == 0 ? WS_RGF : WS_RGB));
    float* XB = (float*)F.lds; float* XC = XB + 19 * 128; float* GG = XC + 16 * 128;
    const int tid = F.tid;
    float hst = 0.f, sp = 0.f;
    if (tid < 128) { if (lat) hst = F.in[5][((s - 16) * 2 + d) * 1024 + hb * 128 + tid]; const float lam = F.in[22][d * 1024 + hb * 128 + tid]; sp = log1pf(__expf(-lam)); }
    for (int k = 0; k < T / 16; ++k) {
        const int tb = d == 0 ? 16 * k : T - 16 * (k + 1);
        for (int idx = tid; idx < 19 * 128; idx += NWAVES * 64) { const int hr = idx >> 7, ch = idx & 127, tok = tb + hr - 2;
            XB[idx] = (tok >= 0 && tok < T) ? bf2f(P2[(size_t)(row0 + tok) * ODD_IN + hb * 128 + ch]) : 0.f; }
        __syncthreads();
        for (int idx = tid; idx < 16 * 128; idx += NWAVES * 64) { const int t = idx >> 7, ch = idx & 127; float a = F.in[19][hb * 128 + ch];
#pragma unroll
            for (int j = 0; j < 4; ++j) a += F.in[18][j * 1024 + hb * 128 + ch] * XB[(t + j) * 128 + ch];
            XC[idx] = a; }
        __syncthreads();
        { const int g = tid >> 8, th = (tid >> 7) & 1, j = tid & 127;
          const float* w = F.in[20] + ((size_t)((d * 2 + g) * 8 + hb) * 128) * 128 + j;
          float acc[8];
#pragma unroll
          for (int t = 0; t < 8; ++t) acc[t] = 0.f;
          for (int i = 0; i < 128; ++i) { const float wv = w[(size_t)i * 128];
#pragma unroll
              for (int t = 0; t < 8; ++t) acc[t] += XC[(th * 8 + t) * 128 + i] * wv; }
          const float gb = F.in[21][(d * 2 + g) * 1024 + hb * 128 + j];
#pragma unroll
          for (int t = 0; t < 8; ++t) GG[(g * 16 + th * 8 + t) * 128 + j] = sigmoidf(acc[t] + gb); }
        __syncthreads();
        if (tid < 128) {
            for (int tt = 0; tt < 16; ++tt) { const int t = d == 0 ? tt : 15 - tt;
                const float rr = GG[t * 128 + tid], ii = GG[(16 + t) * 128 + tid];
                const float la = -8.0f * rr * sp; const float a = __expf(la); const float u = sqrtf(-expm1f(2.0f * la)) * (ii * XC[t * 128 + tid]);
                hst = a * hst + u;
                O[(size_t)(row0 + tb + t) * DM + hb * 128 + tid] = (bf16)f2bf(hst); } }
        __syncthreads();
    }
    if (!lat && tid < 128) F.out[OUT_RG + (s * 2 + d) * 1024 + hb * 128 + tid] = hst;
}
__device__ __forceinline__ void gate_even_rows(Frame& F) {
    const bf16* P = (const bf16*)(F.ws + WS_PROJ); bf16* Y = (bf16*)(F.ws + WS_H);
    const int gw = F.vcu * NWAVES + F.wave, NGW = F.G * NWAVES, lane = F.lane;
    const f32x4 g0 = ((const f32x4*)F.in[14])[lane * 2], g1 = ((const f32x4*)F.in[14])[lane * 2 + 1];
    const float gain[8] = {g0.x, g0.y, g0.z, g0.w, g1.x, g1.y, g1.z, g1.w};
    for (int m = gw; m < M_ALL; m += NGW) {
        const bf16* pr = P + (size_t)m * EVEN_IN + lane * 8;
        const v4u wf = *(const v4u*)(pr + 512), wb = *(const v4u*)(pr + 1024), wga = *(const v4u*)(pr + 2048), wo = *(const v4u*)(pr + 2560), wgb = *(const v4u*)(pr + 4096);
        float o[8], ga[8], ob[8], gb[8];
#pragma unroll
        for (int e = 0; e < 4; ++e) { o[2 * e] = bflo(wf[e]) + bflo(wb[e]); o[2 * e + 1] = bfhi(wf[e]) + bfhi(wb[e]); ga[2 * e] = bflo(wga[e]); ga[2 * e + 1] = bfhi(wga[e]);
            ob[2 * e] = bflo(wo[e]); ob[2 * e + 1] = bfhi(wo[e]); gb[2 * e] = bflo(wgb[e]); gb[2 * e + 1] = bfhi(wgb[e]); }
        float ss = 0.f;
#pragma unroll
        for (int e = 0; e < 8; ++e) ss += o[e] * o[e];
        ss += __shfl_xor(ss, 1); ss += __shfl_xor(ss, 2); ss += __shfl_xor(ss, 4); ss += __shfl_xor(ss, 8);
        const float rstd = 1.0f / sqrtf(ss * (1.0f / 128.0f) + 1e-6f);
        float ya[8], yb[8];
#pragma unroll
        for (int e = 0; e < 8; ++e) { ya[e] = o[e] * rstd * gain[e] * siluf(ga[e]); yb[e] = ob[e] * siluf(gb[e]); }
        v4u wa, wbo;
#pragma unroll
        for (int e = 0; e < 4; ++e) { wa[e] = pk2(ya[2 * e], ya[2 * e + 1]); wbo[e] = pk2(yb[2 * e], yb[2 * e + 1]); }
        bf16* yr = Y + (size_t)m * DM + lane * 8;
        *(v4u*)yr = wa; *(v4u*)(yr + 512) = wbo;
    }
}
__device__ __forceinline__ void rg_combine_rows(Frame& F) {
    const bf16* P2 = (const bf16*)(F.ws + WS_PROJ); const bf16* OF = (const bf16*)(F.ws + WS_RGF); const bf16* OB = (const bf16*)(F.ws + WS_RGB); bf16* Y = (bf16*)(F.ws + WS_H);
    const int gw = F.vcu * NWAVES + F.wave, NGW = F.G * NWAVES, lane = F.lane;
    for (int m = gw; m < M_ALL; m += NGW) {
#pragma unroll
        for (int part = 0; part < 2; ++part) { const int c0 = part * 512 + lane * 8;
            const v4u a = *(const v4u*)(OF + (size_t)m * DM + c0), b = *(const v4u*)(OB + (size_t)m * DM + c0), g = *(const v4u*)(P2 + (size_t)m * ODD_IN + 1024 + c0);
            v4u w;
#pragma unroll
            for (int e = 0; e < 4; ++e) w[e] = pk2((bflo(a[e]) + bflo(b[e])) * siluf(bflo(g[e])), (bfhi(a[e]) + bfhi(b[e])) * siluf(bfhi(g[e])));
            *(v4u*)(Y + (size_t)m * DM + c0) = w; }
    }
}
__device__ __forceinline__ void final_norm_rows(Frame& F) {
    const int gw = F.vcu * NWAVES + F.wave, NGW = F.G * NWAVES;
    const f32x4* gp = (const f32x4*)F.in[23] + F.lane;
    for (int m = gw; m < M_ALL; m += NGW) {
        f32x4* xr = (f32x4*)(F.out + (size_t)m * DM) + F.lane;
        f32x4 v[4]; float s = 0.f;
#pragma unroll
        for (int j = 0; j < 4; ++j) { v[j] = xr[64 * j]; s += (v[j].x * v[j].x + v[j].y * v[j].y) + (v[j].z * v[j].z + v[j].w * v[j].w); }
        const float rstd = 1.0f / sqrtf(wave_sum(s) * (1.0f / DM) + 1e-6f);
#pragma unroll
        for (int j = 0; j < 4; ++j) xr[64 * j] = v[j] * rstd * gp[64 * j];
    }
}
struct Args { const float* in[24]; float* out; unsigned char* ws; int ph_lo, ph_hi; };
__global__ void __launch_bounds__(NWAVES * 64, 2) mega_fwd(Args args) {
    extern __shared__ __attribute__((aligned(16))) unsigned char lds[];
    Frame F;
    F.lds = lds;
    F.MISC = (volatile LAS unsigned*)((LAS unsigned char*)lds + MISC_OFF);
    F.tid = threadIdx.x; F.lane = F.tid & 63; F.wave = __builtin_amdgcn_readfirstlane(F.tid >> 6);
    F.G = gridDim.x; { const int bx = blockIdx.x; F.vcu = (F.G % 8 == 0) ? (bx % 8) * (F.G / 8) + bx / 8 : bx; }
    F.ws = args.ws; F.out = args.out; F.ctl = (gu32*)(args.ws + WS_CTL);
#pragma unroll
    for (int i = 0; i < 24; ++i) F.in[i] = args.in[i];
    for (int u = F.tid; u < (LDS_BYTES - MISC_OFF) / 4; u += NWAVES * 64) ((LAS unsigned*)((LAS unsigned char*)lds + MISC_OFF))[u] = 0u;
    __syncthreads();
    const int lo = args.ph_lo, hi = args.ph_hi;
    const bool one = (lo == 0 && hi == NPHASE);
    XcdBarrier bar; bar.bar = (unsigned*)(F.ctl + CW_BAR); bar.x = 0; bar.st = nullptr;
    if (one) bar = xcd_barrier_post((unsigned*)(F.ctl + CW_BAR), F.MISC + 8);
#define IN(k) (lo <= (k) && (k) < hi)
#define GRID_BAR(k) do { if (IN(k) && IN((k) + 1)) xcd_barrier(bar); } while (0)
    LAS unsigned char* ring = (LAS unsigned char*)lds;

    if (IN(0)) { p0_prologue(F); GRID_BAR(0); }
    if (IN(1)) { modnorm_rows(F, 0, F.in[0], F.in[1]); GRID_BAR(1); }
    if (IN(2)) {
        pg8::Gemm g{(const bf16*)(F.ws + WS_H), (const bf16*)(F.ws + WS_WIE), M_ALL, EVEN_IN, DM}; pg8::StaticOrder S; S.init(M_ALL, EVEN_IN, F.G, (int)blockIdx.x);
        pg8::EpiProj E{(bf16*)(F.ws + WS_PROJ), EVEN_IN, F.out + OUT_K};
        pg8::gemm_phase<pg8::EpiProj, pg8::StaticOrder, true, true>(ring, g, S, E);
        GRID_BAR(2);
    }
    if (IN(3)) {
        for (int it = blockIdx.x; it < 192; it += F.G) hgrn_naive_item(F, 191 - it);
        { const int gw = F.vcu * NWAVES + F.wave, NGW = F.G * NWAVES; for (int it = gw; it < M_ALL * 8; it += NGW) attn_naive_item(F, it); }
        GRID_BAR(3);
    }
    if (IN(4)) { gate_even_rows(F); GRID_BAR(4); }
    if (IN(5)) {
        pg8::Gemm g{(const bf16*)(F.ws + WS_H), (const bf16*)(F.ws + WS_WOE), M_ALL, DM, DM}; pg8::StaticOrder S; S.init(M_ALL, DM, F.G, (int)blockIdx.x);
        pg8::EpiRes E{F.in[0], F.in[1], F.out, (const float*)(F.ws + WS_MODS) + 2048};
        pg8::gemm_phase<pg8::EpiRes, pg8::StaticOrder, true, true>(ring, g, S, E);
        GRID_BAR(5);
    }
    if (IN(6)) { modnorm_rows(F, 1, F.out, F.out + (size_t)M_CTX * DM); GRID_BAR(6); }
    if (IN(7)) {
        pg8::Gemm g{(const bf16*)(F.ws + WS_H), (const bf16*)(F.ws + WS_WIO), M_ALL, ODD_IN, DM}; pg8::StaticOrder S; S.init(M_ALL, ODD_IN, F.G, (int)blockIdx.x);
        pg8::EpiProj E{(bf16*)(F.ws + WS_PROJ), ODD_IN, nullptr};
        pg8::gemm_phase<pg8::EpiProj, pg8::StaticOrder, true, true>(ring, g, S, E);
        GRID_BAR(7);
    }
    if (IN(8)) { for (int it = blockIdx.x; it < 384; it += F.G) rg_naive_item(F, 383 - it); GRID_BAR(8); }
    if (IN(9)) { rg_combine_rows(F); GRID_BAR(9); }
    if (IN(10)) {
        pg8::Gemm g{(const bf16*)(F.ws + WS_H), (const bf16*)(F.ws + WS_WOO), M_ALL, DM, DM}; pg8::StaticOrder S; S.init(M_ALL, DM, F.G, (int)blockIdx.x);
        pg8::EpiRes E{F.out, F.out + (size_t)M_CTX * DM, F.out, (const float*)(F.ws + WS_MODS) + 9 * 3072 + 2048};
        pg8::gemm_phase<pg8::EpiRes, pg8::StaticOrder, true, true>(ring, g, S, E);
        GRID_BAR(10);
    }
    if (IN(11)) { final_norm_rows(F); }

#undef IN
#undef GRID_BAR
}

extern "C" void kernel_launch(void* const* d_in, const int* in_sizes, int n_in, void* d_out, int out_size, void* d_ws, size_t ws_size, hipStream_t stream) {
    static int grid = 0;
    if (grid == 0) {
        if (n_in != 24 || out_size != (int)OUT_TOTAL || ws_size < WS_END) { fprintf(stderr, "kernel_launch: unexpected shapes (n_in %d out %d ws %zu)\n", n_in, out_size, ws_size); grid = -1; return; }
        int dev = 0, cus = 0, per_cu = 0;
        if (hipGetDevice(&dev) != hipSuccess || hipDeviceGetAttribute(&cus, hipDeviceAttributeMultiprocessorCount, dev) != hipSuccess) { grid = -1; return; }
        if (hipFuncSetAttribute((const void*)mega_fwd, hipFuncAttributeMaxDynamicSharedMemorySize, LDS_BYTES) != hipSuccess) { fprintf(stderr, "kernel_launch: hipFuncSetAttribute failed\n"); grid = -1; return; }
        if (hipOccupancyMaxActiveBlocksPerMultiprocessor(&per_cu, (const void*)mega_fwd, NWAVES * 64, LDS_BYTES) != hipSuccess || per_cu < 1) { fprintf(stderr, "kernel_launch: occupancy query says %d\n", per_cu); }
        (void)hipGetLastError();
        grid = cus;
    }
    if (grid < 0) return;
    (void)hipMemsetAsync((char*)d_ws + WS_CTL, 0, CTL_ZERO_BYTES, stream);
    Args a{};
    for (int i = 0; i < 24; ++i) a.in[i] = (const float*)d_in[i];
    a.out = (float*)d_out; a.ws = (unsigned char*)d_ws;
#if defined(MK_PER_PHASE)
    for (int p = 0; p < NPHASE; ++p) { a.ph_lo = p; a.ph_hi = p + 1; hipLaunchKernelGGL(mega_fwd, dim3(grid), dim3(NWAVES * 64), LDS_BYTES, stream, a); }
#else
    a.ph_lo = 0; a.ph_hi = NPHASE;
    hipLaunchKernelGGL(mega_fwd, dim3(grid), dim3(NWAVES * 64), LDS_BYTES, stream, a);
#endif
}
```

```cpp
#include <hip/hip_runtime.h>
#include <cstdio>
#include <cstdint>
namespace pg8 {
#define PG8_LAS __attribute__((address_space(3)))
typedef unsigned short bf16_t;
typedef short bf16x8 __attribute__((ext_vector_type(8)));
typedef float f32x4 __attribute__((ext_vector_type(4)));
typedef unsigned u32x4 __attribute__((ext_vector_type(4)));
constexpr int BM = 256, BK = 64, HALF = 128, HTB = HALF * BK * 2  , STAGE_BYTES = 8 * HTB, NXCD = 8, WGM = 8;

__host__ __device__ __forceinline__ int lds_byte(int r, int c) { const int st = (r >> 4) * 2 + (c >> 5), rr = r & 15, cc = c & 31, ob = rr * 64 + cc * 2; return st * 1024 + (ob ^ (((ob >> 9) & 1) << 5)); }
__host__ __device__ __forceinline__ void stage_rc(int b, int& R, int& C) { const int st = b / 1024, sb = b % 1024, swz = sb ^ (((sb >> 9) & 1) << 5); R = (st >> 1) * 16 + swz / 64; C = (st & 1) * 32 + (swz % 64) / 2; }
__host__ __device__ __forceinline__ int perm32(int rho) { const int n = rho >> 4, i = rho & 15; return 8 * (i >> 2) + 4 * n + (i & 3); }

struct Unit { int pm, pn; };
struct Gemm { const bf16_t* A; const bf16_t* Bt; int M, N, K; };

struct StaticOrder {
    int nM, nN, nwg, G, c;
    __host__ __device__ void init(int M, int N, int G_, int c_) { nM = M / BM; nN = N / BM; nwg = nM * nN; G = G_; c = c_; }
    __host__ __device__ bool next(int i, Unit& u) const {
        const long L = (long)i * G + c; if (L >= nwg) return false;
        int wgid = (int)L; { const int q = nwg / NXCD, r = nwg % NXCD, xcd = wgid % NXCD, off = wgid / NXCD; wgid = (xcd < r ? xcd * (q + 1) : r * (q + 1) + (xcd - r) * q) + off; }
        const int nig = WGM * nN, gid = wgid / nig, fm = gid * WGM, gsz = (nM - fm) < WGM ? (nM - fm) : WGM;
        u.pm = fm + ((wgid % nig) % gsz); u.pn = (wgid % nig) / gsz; return true;
    }
    __device__ __forceinline__ void a_ready(const Unit&) const {}
    __device__ __forceinline__ void done(const Unit&) const {}
};

__device__ __forceinline__ unsigned cvt_pk_bf16(float lo, float hi) { unsigned r; asm volatile("v_cvt_pk_bf16_f32 %0, %1, %2" : "=v"(r) : "v"(lo), "v"(hi)); return r; }
typedef float f32x2 __attribute__((ext_vector_type(2)));
struct EpiProj {
    static constexpr bool PERM = true, AFTER_DRAIN = false;
    bf16_t* O; int ldc; float* kv;
    __device__ __forceinline__ void operator()(const f32x4 (&acc)[2][2][4][2], const Unit& u, int wr, int wc, int fr, int fq) const {
        const int row0 = u.pm * BM + wr * 64 + fr; const int col0 = u.pn * BM + wc * 32 + 8 * fq;
        const bool dokv = (kv != nullptr) && u.pm < 16 && u.pn >= 12 && u.pn < 16;
#pragma unroll
        for (int ai = 0; ai < 2; ++ai)
#pragma unroll
            for (int m = 0; m < 4; ++m) { bf16_t* rowp = O + (size_t)(row0 + ai * HALF + m * 16) * ldc + col0;
#pragma unroll
                for (int bj = 0; bj < 2; ++bj) { const f32x4 v0 = acc[ai][bj][m][0], v1 = acc[ai][bj][m][1];
                    u32x4 w; w.x = cvt_pk_bf16(v0[0], v0[1]); w.y = cvt_pk_bf16(v0[2], v0[3]); w.z = cvt_pk_bf16(v1[0], v1[1]); w.w = cvt_pk_bf16(v1[2], v1[3]);
                    *(u32x4*)(rowp + bj * HALF) = w;
                    if (dokv) { const int cc = col0 + bj * HALF - 3072, which = cc >> 9, c2 = cc & 511, head = c2 >> 6, d = c2 & 63, t = wr * 64 + fr + ai * HALF + m * 16;
                        float* p = kv + (size_t)which * 2097152 + ((size_t)(u.pm * 8 + head) * 256 + t) * 64 + d; *(f32x4*)p = v0; *(f32x4*)(p + 4) = v1; } } }
    }
};
struct EpiRes {
    static constexpr bool PERM = false, AFTER_DRAIN = false;
    const float* base0; const float* base1; float* out; const float* gate;
    __device__ __forceinline__ void operator()(const f32x4 (&acc)[2][2][4][2], const Unit& u, int wr, int wc, int fr, int fq) const {
        const int nidx = u.pm < 16 ? 0 : 1 + ((u.pm - 16) >> 3);
        const float* gp = gate + (size_t)nidx * 3072;
        const int col0 = u.pn * BM + wc * 32 + 4 * fq;
        f32x4 gv[2][2];
#pragma unroll
        for (int bj = 0; bj < 2; ++bj)
#pragma unroll
            for (int n = 0; n < 2; ++n) gv[bj][n] = *(const f32x4*)(gp + col0 + bj * HALF + n * 16);
#pragma unroll
        for (int ai = 0; ai < 2; ++ai)
#pragma unroll
            for (int m = 0; m < 4; ++m) { const int row = u.pm * BM + ai * HALF + wr * 64 + m * 16 + fr;
                const float* bp = (row < 4096 ? base0 + (size_t)row * 1024 : base1 + (size_t)(row - 4096) * 1024) + col0;
                float* op = out + (size_t)row * 1024 + col0;
#pragma unroll
                for (int bj = 0; bj < 2; ++bj)
#pragma unroll
                    for (int n = 0; n < 2; ++n) { const f32x4 b = *(const f32x4*)(bp + bj * HALF + n * 16); *(f32x4*)(op + bj * HALF + n * 16) = b + gv[bj][n] * acc[ai][bj][m][n]; } }
    }
};
template <class Epi, class Sched, bool ALIGN_EPI = false, bool SP2 = false>
__device__ __forceinline__ void gemm_phase(PG8_LAS unsigned char* lds, const Gemm g, const Sched& S, const Epi& E) {
    const int tid = threadIdx.x, wid = __builtin_amdgcn_readfirstlane(tid >> 6), lane = tid & 63, wr = wid >> 2, wc = wid & 3, fr = lane & 15, fq = lane >> 4;
    const int K = g.K, nt = K / BK;
    unsigned voffA[2], voffB[2];
#pragma unroll
    for (int i = 0; i < 2; ++i) { int R, C; stage_rc(tid * 16 + i * 8192, R, C); const int Rb = Epi::PERM ? ((R & ~31) + perm32(R & 31)) : R;
        voffA[i] = (unsigned)(R * K + C) * 2u; voffB[i] = (unsigned)(Rb * K + C) * 2u; }
    const size_t kstep = (size_t)(BK * 2);
    const size_t hstep = (size_t)HALF * K * 2;
    const size_t tstep = 2 * hstep;
    const unsigned ldsw = (unsigned)wid * 1024u;
    const int aoff = lds_byte(wr * 64 + fr, fq * 8), boff = lds_byte(wc * 32 + fr, fq * 8);
#define PG8_SA(b, h) (((b) * 2 + (h)) * HTB)
#define PG8_SB(b, h) ((4 + (b) * 2 + (h)) * HTB)
#define PG8_STAGE(bufoff, gbase, voff) do { _Pragma("unroll") for (int _i = 0; _i < 2; ++_i) \
        __builtin_amdgcn_global_load_lds((const unsigned*)((const char*)(gbase) + (voff)[_i]), (PG8_LAS unsigned*)(lds + (bufoff) + ldsw + _i * 8192), 16, 0, 0); } while (0)
#define PG8_LDA(dst, b, h) do { _Pragma("unroll") for (int m = 0; m < 4; ++m) _Pragma("unroll") for (int k = 0; k < 2; ++k) dst[m][k] = *(const PG8_LAS bf16x8*)(lds + PG8_SA(b, h) + aoff + m * 2048 + k * 1024); } while (0)
#define PG8_LDB(dst, b, h) do { _Pragma("unroll") for (int n = 0; n < 2; ++n) _Pragma("unroll") for (int k = 0; k < 2; ++k) dst[n][k] = *(const PG8_LAS bf16x8*)(lds + PG8_SB(b, h) + boff + n * 2048 + k * 1024); } while (0)
#define PG8_MMA(ai, bj, At, Bt) do { __builtin_amdgcn_s_setprio(1); _Pragma("unroll") for (int m = 0; m < 4; ++m) _Pragma("unroll") for (int n = 0; n < 2; ++n) _Pragma("unroll") for (int k = 0; k < 2; ++k) \
        acc[ai][bj][m][n] = __builtin_amdgcn_mfma_f32_16x16x32_bf16(Bt[n][k], At[m][k], acc[ai][bj][m][n], 0, 0, 0); __builtin_amdgcn_s_setprio(0); } while (0)
#define PG8_WAIT_V(n) asm volatile("s_waitcnt vmcnt(" #n ")" ::: "memory")
#define PG8_WAIT_L(n) asm volatile("s_waitcnt lgkmcnt(" #n ")" ::: "memory")
#define PG8_BAR __builtin_amdgcn_s_barrier()
#define PG8_SCHED __builtin_amdgcn_sched_barrier(0)
    Unit cur, nxt; int ui = 0;
    if (!S.next(0, cur)) return;
    f32x4 acc[2][2][4][2];
#pragma unroll
    for (int a = 0; a < 2; ++a)
#pragma unroll
        for (int b = 0; b < 2; ++b)
#pragma unroll
            for (int m = 0; m < 4; ++m)
#pragma unroll
                for (int n = 0; n < 2; ++n) acc[a][b][m][n] = (f32x4){0.f, 0.f, 0.f, 0.f};
    bf16x8 At[4][2], B0[2][2], B1[2][2];
    const char* cA = (const char*)g.A + (size_t)cur.pm * tstep; const char* cB = (const char*)g.Bt + (size_t)cur.pn * tstep;
    S.a_ready(cur);
    if constexpr (SP2) {
        PG8_STAGE(PG8_SB(0, 0), cB, voffB); PG8_STAGE(PG8_SB(0, 1), cB + hstep, voffB); PG8_STAGE(PG8_SA(0, 0), cA, voffA); PG8_STAGE(PG8_SA(0, 1), cA + hstep, voffA);
        if (wr == 1) PG8_BAR;
        PG8_WAIT_V(2); PG8_BAR;
        PG8_STAGE(PG8_SB(1, 0), cB + kstep, voffB); PG8_STAGE(PG8_SA(1, 0), cA + kstep, voffA); PG8_STAGE(PG8_SB(1, 1), cB + hstep + kstep, voffB);
        PG8_WAIT_V(6); PG8_BAR;
    } else {
        PG8_STAGE(PG8_SB(0, 0), cB, voffB); PG8_STAGE(PG8_SA(0, 0), cA, voffA); PG8_STAGE(PG8_SB(0, 1), cB + hstep, voffB); PG8_STAGE(PG8_SA(0, 1), cA + hstep, voffA);
        if (wr == 1) PG8_BAR;
        PG8_WAIT_V(4); PG8_BAR;
        PG8_STAGE(PG8_SB(1, 0), cB + kstep, voffB); PG8_STAGE(PG8_SA(1, 0), cA + kstep, voffA); PG8_STAGE(PG8_SB(1, 1), cB + hstep + kstep, voffB);
        PG8_WAIT_V(6); PG8_BAR;
    }
    for (;;) {
        const bool has_next = S.next(ui + 1, nxt);
        const char* nA = has_next ? (const char*)g.A + (size_t)nxt.pm * tstep : cA; const char* nB = has_next ? (const char*)g.Bt + (size_t)nxt.pn * tstep : cB;
        for (int t = 0; t < nt; t += 2) {
            const bool last = (t == nt - 2);
            const char* a1 = cA + (size_t)(t + 1) * kstep;
            const char* a2 = last ? nA : cA + (size_t)(t + 2) * kstep; const char* b2 = last ? nB : cB + (size_t)(t + 2) * kstep;
            const char* a3 = a2 + kstep; const char* b3 = b2 + kstep;
            if (last && has_next) S.a_ready(nxt);
            if constexpr (SP2) {
            PG8_LDB(B0, 0, 0); PG8_LDB(B1, 0, 1); PG8_SCHED; PG8_LDA(At, 0, 0); PG8_STAGE(PG8_SA(1, 1), a1 + hstep, voffA);
            PG8_WAIT_V(8); PG8_WAIT_L(0); PG8_BAR; PG8_MMA(0, 0, At, B0); PG8_MMA(0, 1, At, B1); PG8_BAR; PG8_SCHED;
            PG8_LDA(At, 0, 1); PG8_STAGE(PG8_SB(0, 0), b2, voffB); PG8_STAGE(PG8_SB(0, 1), b2 + hstep, voffB); PG8_STAGE(PG8_SA(0, 0), a2, voffA);
            PG8_WAIT_V(8); PG8_WAIT_L(0); PG8_BAR; PG8_MMA(1, 0, At, B0); PG8_MMA(1, 1, At, B1); PG8_BAR; PG8_SCHED;
            PG8_LDB(B0, 1, 0); PG8_LDB(B1, 1, 1); PG8_SCHED; PG8_LDA(At, 1, 0); PG8_STAGE(PG8_SA(0, 1), a2 + hstep, voffA);
            PG8_WAIT_V(8); PG8_WAIT_L(0); PG8_BAR; PG8_MMA(0, 0, At, B0); PG8_MMA(0, 1, At, B1); PG8_BAR; PG8_SCHED;
            PG8_LDA(At, 1, 1); PG8_STAGE(PG8_SB(1, 0), b3, voffB); PG8_STAGE(PG8_SB(1, 1), b3 + hstep, voffB); PG8_STAGE(PG8_SA(1, 0), a3, voffA);
            PG8_WAIT_V(8); PG8_WAIT_L(0); PG8_BAR; PG8_MMA(1, 0, At, B0); PG8_MMA(1, 1, At, B1); PG8_BAR; PG8_SCHED;
            } else {
            PG8_LDB(B0, 0, 0); PG8_SCHED; PG8_LDA(At, 0, 0); PG8_STAGE(PG8_SA(1, 1), a1 + hstep, voffA);
            PG8_WAIT_L(8); PG8_BAR; PG8_WAIT_L(0); PG8_MMA(0, 0, At, B0); PG8_BAR; PG8_SCHED;
            PG8_LDB(B1, 0, 1); PG8_STAGE(PG8_SB(0, 0), b2, voffB);
            PG8_BAR; PG8_WAIT_L(0); PG8_MMA(0, 1, At, B1); PG8_BAR;
            PG8_LDA(At, 0, 1); PG8_STAGE(PG8_SA(0, 0), a2, voffA);
            PG8_BAR; PG8_WAIT_L(0); PG8_MMA(1, 0, At, B0); PG8_BAR; PG8_SCHED;
            PG8_STAGE(PG8_SB(0, 1), b2 + hstep, voffB);
            PG8_WAIT_V(6); PG8_BAR; PG8_MMA(1, 1, At, B1); PG8_BAR;
            PG8_LDB(B0, 1, 0); PG8_SCHED; PG8_LDA(At, 1, 0); PG8_STAGE(PG8_SA(0, 1), a2 + hstep, voffA);
            PG8_WAIT_L(8); PG8_BAR; PG8_WAIT_L(0); PG8_MMA(0, 0, At, B0); PG8_BAR; PG8_SCHED;
            PG8_LDB(B1, 1, 1); PG8_STAGE(PG8_SB(1, 0), b3, voffB);
            PG8_BAR; PG8_WAIT_L(0); PG8_MMA(0, 1, At, B1); PG8_BAR;
            PG8_LDA(At, 1, 1); PG8_STAGE(PG8_SA(1, 0), a3, voffA);
            PG8_BAR; PG8_WAIT_L(0); PG8_MMA(1, 0, At, B0); PG8_BAR; PG8_SCHED;
            PG8_STAGE(PG8_SB(1, 1), b3 + hstep, voffB);
            PG8_WAIT_V(6); PG8_BAR; PG8_MMA(1, 1, At, B1); PG8_BAR;
            }
        }
        if constexpr (ALIGN_EPI) { if (wr == 0) PG8_BAR; }
        if constexpr (!Epi::AFTER_DRAIN) { E(acc, cur, wr, wc, fr, fq); S.done(cur); }
        if (!has_next) break;
#pragma unroll
        for (int a = 0; a < 2; ++a)
#pragma unroll
            for (int b = 0; b < 2; ++b)
#pragma unroll
                for (int m = 0; m < 4; ++m)
#pragma unroll
                    for (int n = 0; n < 2; ++n) acc[a][b][m][n] = (f32x4){0.f, 0.f, 0.f, 0.f};
        cur = nxt; cA = nA; cB = nB; ++ui;
        if constexpr (ALIGN_EPI) { if (wr == 1) PG8_BAR; }
    }
    PG8_WAIT_V(0);
    if constexpr (!ALIGN_EPI) { if (wr == 0) PG8_BAR; }
    PG8_BAR;
    if constexpr (Epi::AFTER_DRAIN) { E.fused(acc, cur, wr, wc, fr, fq, lds, wid, lane); S.done(cur); }
#undef PG8_SA
#undef PG8_SB
#undef PG8_STAGE
#undef PG8_LDA
#undef PG8_LDB
#undef PG8_MMA
#undef PG8_WAIT_V
#undef PG8_WAIT_L
#undef PG8_BAR
#undef PG8_SCHED
}
}
constexpr int NWAVES = 8;
constexpr int DM = 1024, M_CTX = 4096, M_LAT = 16384, M_ALL = 20480, EVEN_IN = 4608, ODD_IN = 2048;
constexpr size_t MiB = 1u << 20;
constexpr size_t WS_CTL = 0, CTL_ZERO_BYTES = 1 * MiB;
constexpr size_t WS_MODS = 1 * MiB;
constexpr size_t WS_WIE = 2 * MiB, WS_WOE = 11 * MiB, WS_WIO = 13 * MiB, WS_WOO = 17 * MiB, WS_GW = 19 * MiB;
constexpr size_t WS_AGG = 20 * MiB;
constexpr size_t WS_H = 26 * MiB;
constexpr size_t WS_PROJ = 66 * MiB;
constexpr size_t WS_END = 246 * MiB;
constexpr size_t OUT_Y = 0, OUT_HG = 20971520, OUT_K = 23068672, OUT_V = 25165824, OUT_RG = 27262976, OUT_TOTAL = 27295744;
constexpr int CW_TMO = 0, CW_CODE = 1, CW_BAR = 4096, CW_QUEUE = 16384;
constexpr int RING_BYTES = 131072;
constexpr int LDS_BYTES = 162816, MISC_OFF = LDS_BYTES - 512;
constexpr int NPHASE = 12;

#define GAS __attribute__((address_space(1)))
#define LAS __attribute__((address_space(3)))
typedef unsigned short bf16;
typedef unsigned v4u __attribute__((ext_vector_type(4)));
typedef unsigned v2u __attribute__((ext_vector_type(2)));
typedef float f32x4 __attribute__((ext_vector_type(4)));
typedef float f32x16 __attribute__((ext_vector_type(16)));
typedef short bf16x8 __attribute__((ext_vector_type(8)));
typedef short s16x4 __attribute__((ext_vector_type(4)));
typedef GAS unsigned gu32;
#define RLX_AGENT __ATOMIC_RELAXED, __HIP_MEMORY_SCOPE_AGENT
#define LDS_WAIT() asm volatile("s_waitcnt lgkmcnt(0)" ::: "memory")
#define VM_WAIT() asm volatile("s_waitcnt vmcnt(0)" ::: "memory")
__device__ __forceinline__ unsigned f2bf(float f) { unsigned u = __builtin_bit_cast(unsigned, f); return (u + 0x7fffu + ((u >> 16) & 1u)) >> 16; }
__device__ __forceinline__ unsigned pk2(float lo, float hi) { return f2bf(lo) | (f2bf(hi) << 16); }
__device__ __forceinline__ float bf2f(unsigned b) { return __builtin_bit_cast(float, b << 16); }
__device__ __forceinline__ float bflo(unsigned w) { return __builtin_bit_cast(float, w << 16); }
__device__ __forceinline__ float bfhi(unsigned w) { return __builtin_bit_cast(float, w & 0xffff0000u); }
__device__ __forceinline__ float sigmoidf(float x) { return 1.0f / (1.0f + __expf(-x)); }
__device__ __forceinline__ float siluf(float x) { return x / (1.0f + __expf(-x)); }
#define XB_TMO      128
#define XB_XCNT(j)  (256  + 64 * (j))
#define XB_XSUB(j)  (1280 + 64 * (j))
#define XB_XGEN(j)  (2304 + 64 * (j))
#define XB_TOP      3328
#define XB_TOPGEN   3392
#define XCD_BAR_WORDS 3456
#define XB_SPIN_CAP (1u << 18)

__device__ __forceinline__ unsigned xb_ld(unsigned* p)              { return __hip_atomic_load(p, __ATOMIC_RELAXED, __HIP_MEMORY_SCOPE_AGENT); }
__device__ __forceinline__ unsigned xb_add(unsigned* p, unsigned v) { return __hip_atomic_fetch_add(p, v, __ATOMIC_RELAXED, __HIP_MEMORY_SCOPE_AGENT); }
__device__ __forceinline__ unsigned xb_xcc_id() { return (unsigned)__builtin_amdgcn_s_getreg((3 << 11) | 20) & 0xFu; }
#define XB_SPIN(cond, bar) do { unsigned _sp = 0; while (cond) { __builtin_amdgcn_s_sleep(1); \
    if ((++_sp & 255u) == 0u) { if (xb_ld(&(bar)[XB_TMO])) break; if (_sp > XB_SPIN_CAP) { atomicAdd(&(bar)[XB_TMO], 1u); break; } } } } while (0)

struct XcdBarrier {
    unsigned* bar; unsigned x;
    volatile LAS unsigned* st;
};

__device__ __forceinline__ XcdBarrier xcd_barrier_post(unsigned* bar, volatile LAS unsigned* st) {
    XcdBarrier b; b.bar = bar; b.x = xb_xcc_id(); b.st = st;
    if (threadIdx.x == 0) (void)xb_add(&bar[XB_XCNT(b.x)], 1u);
    return b;
}
__device__ __forceinline__ void xcd_barrier_complete(unsigned* bar, unsigned x, unsigned& nloc, unsigned& nx) {
    const unsigned G = gridDim.x * gridDim.y * gridDim.z;
    unsigned sum, cnt, mine, sp = 0u;
    for (;;) {
        sum = 0u; cnt = 0u; mine = 0u;
#pragma unroll
        for (unsigned j = 0; j < 16; ++j) { const unsigned c = xb_ld(&bar[XB_XCNT(j)]); sum += c; cnt += (c > 0u) ? 1u : 0u; mine = (j == x) ? c : mine; }
        if (sum == G) break;
        __builtin_amdgcn_s_sleep(1);
        if ((++sp & 255u) == 0u) { if (xb_ld(&bar[XB_TMO])) break; if (sp > XB_SPIN_CAP) { atomicAdd(&bar[XB_TMO], 1u); break; } }
    }
    nloc = mine > 0u ? mine : 1u; nx = cnt > 0u ? cnt : 1u;
}

__device__ __forceinline__ void xcd_barrier(const XcdBarrier& b) {
    asm volatile("s_waitcnt vmcnt(0)" ::: "memory");
    __syncthreads();
    if (threadIdx.x == 0) {
        unsigned* bar = b.bar;
        __builtin_amdgcn_s_waitcnt(0);
        unsigned nloc = b.st[0], nx = b.st[1];
        if (nloc == 0u) { xcd_barrier_complete(bar, b.x, nloc, nx); b.st[0] = nloc; b.st[1] = nx; }
        const unsigned old = xb_add(&bar[XB_XSUB(b.x)], 1u);
        const unsigned gen = old / nloc;
        if (old + 1u == (gen + 1u) * nloc) {
            __builtin_amdgcn_fence(__ATOMIC_RELEASE, "agent");
            asm volatile("s_waitcnt vmcnt(0)" ::: "memory");
            const unsigned og = xb_add(&bar[XB_TOP], 1u);
            const unsigned tg = og / nx;
            if (og + 1u == (tg + 1u) * nx) xb_add(&bar[XB_TOPGEN], 1u);
            else XB_SPIN(xb_ld(&bar[XB_TOPGEN]) == tg, bar);
            __builtin_amdgcn_fence(__ATOMIC_ACQUIRE, "agent");
            xb_add(&bar[XB_XGEN(b.x)], 1u);
            asm volatile("s_waitcnt vmcnt(0)" ::: "memory");
        } else {
            XB_SPIN(xb_ld(&bar[XB_XGEN(b.x)]) == gen, bar);
            __builtin_amdgcn_fence(__ATOMIC_ACQUIRE, "agent");
            asm volatile("s_waitcnt vmcnt(0)" ::: "memory");
        }
    }
    __syncthreads();
}
struct Frame {
    unsigned char* lds;
    volatile LAS unsigned* MISC;
    gu32* ctl;
    int tid, lane, wave, vcu, G;
    const float* in[24];
    float* out; unsigned char* ws;
};
__device__ __forceinline__ float wave_sum(float v) {
#pragma unroll
    for (int o = 1; o < 64; o <<= 1) v += __shfl_xor(v, o);
    return v;
}
__device__ __forceinline__ void p0_transpose_item(const float* W, int K, int N, bf16* WT, float* scr, int item, int lane) {
    const int nblk = N / 32, kb = item / nblk, nb = item % nblk, k0 = 64 * kb, n0 = 32 * nb;
#pragma unroll 8
    for (int i = 0; i < 32; ++i) { const int kk = 2 * i + (lane >> 5); scr[kk * 33 + (lane & 31)] = W[(size_t)(k0 + kk) * N + n0 + (lane & 31)]; }
    LDS_WAIT(); asm volatile("" ::: "memory");
    const int c = lane & 7;
#pragma unroll
    for (int j = 0; j < 4; ++j) { const int n = (lane >> 3) + 8 * j; const float* s = scr + (8 * c) * 33 + n;
        v4u o; o.x = pk2(s[0 * 33], s[1 * 33]); o.y = pk2(s[2 * 33], s[3 * 33]); o.z = pk2(s[4 * 33], s[5 * 33]); o.w = pk2(s[6 * 33], s[7 * 33]);
        *(v4u*)(WT + (size_t)(n0 + n) * K + k0 + 8 * c) = o; }
    LDS_WAIT(); asm volatile("" ::: "memory");
}
__device__ __forceinline__ void p0_prologue(Frame& F) {
    float* mods = (float*)(F.ws + WS_MODS);
    for (int it = blockIdx.x; it < 96; it += F.G) {
        const int l = it / 48, c0 = (it % 48) * 64;
        float* S = (float*)F.lds;
        for (int idx = F.tid; idx < 9216; idx += NWAVES * 64) { const int n = idx >> 10, k = idx & 1023; const float v = n == 0 ? F.in[7][k] : F.in[6][(n - 1) * 1024 + k]; S[idx] = siluf(v); }
        __syncthreads();
        const float* W = F.in[9] + (size_t)l * 1024 * 3072 + c0 + F.lane;
        float acc[9];
#pragma unroll
        for (int n = 0; n < 9; ++n) acc[n] = 0.f;
        const int k0 = F.wave * 128;
#pragma unroll 4
        for (int kk = 0; kk < 128; ++kk) { const float wv = W[(size_t)(k0 + kk) * 3072];
#pragma unroll
            for (int n = 0; n < 9; ++n) acc[n] += S[n * 1024 + k0 + kk] * wv; }
        float* red = S + 9216;
#pragma unroll
        for (int n = 0; n < 9; ++n) red[(F.wave * 9 + n) * 64 + F.lane] = acc[n];
        __syncthreads();
        for (int idx = F.tid; idx < 576; idx += NWAVES * 64) { const int n = idx >> 6, ln = idx & 63; float s = F.in[10][l * 3072 + c0 + ln];
#pragma unroll
            for (int w = 0; w < 8; ++w) s += red[(w * 9 + n) * 64 + ln];
            mods[(size_t)(l * 9 + n) * 3072 + c0 + ln] = s; }
        __syncthreads();
    }
    float* scr = (float*)(F.lds + F.wave * 16384);
    const int gw = F.vcu * NWAVES + F.wave, NGW = F.G * NWAVES;
    constexpr int I0 = 16 * 144, I1 = 16 * 32, I2 = 16 * 64, I3 = 16 * 32, I4 = 32 * 8;
    for (int it = gw; it < I0 + I1 + I2 + I3 + I4; it += NGW) {
        int r = it;
        if (r < I0) { p0_transpose_item(F.in[11], 1024, 4608, (bf16*)(F.ws + WS_WIE), scr, r, F.lane); continue; } r -= I0;
        if (r < I1) { p0_transpose_item(F.in[12], 1024, 1024, (bf16*)(F.ws + WS_WOE), scr, r, F.lane); continue; } r -= I1;
        if (r < I2) { p0_transpose_item(F.in[16], 1024, 2048, (bf16*)(F.ws + WS_WIO), scr, r, F.lane); continue; } r -= I2;
        if (r < I3) { p0_transpose_item(F.in[17], 1024, 1024, (bf16*)(F.ws + WS_WOO), scr, r, F.lane); continue; } r -= I3;
        const int mat = r >> 3;
        p0_transpose_item(F.in[20] + (size_t)mat * 16384, 128, 128, (bf16*)(F.ws + WS_GW) + (size_t)mat * 16384, scr, r & 7, F.lane);
    }
}
__device__ __forceinline__ void modnorm_rows(Frame& F, int layer, const float* xa, const float* xb) {
    const float* mods = (const float*)(F.ws + WS_MODS) + (size_t)layer * 9 * 3072;
    const float* gain = F.in[8] + layer * 1024;
    bf16* H = (bf16*)(F.ws + WS_H);
    const int gw = F.vcu * NWAVES + F.wave, NGW = F.G * NWAVES;
    for (int m = gw; m < M_ALL; m += NGW) {
        const int n = m < M_CTX ? 0 : 1 + ((m - M_CTX) >> 11);
        const f32x4* xr = (const f32x4*)(m < M_CTX ? xa + (size_t)m * DM : xb + (size_t)(m - M_CTX) * DM) + F.lane;
        const f32x4* sh = (const f32x4*)(mods + (size_t)n * 3072) + F.lane; const f32x4* sc = (const f32x4*)(mods + (size_t)n * 3072 + 1024) + F.lane;
        const f32x4* gp = (const f32x4*)gain + F.lane;
        f32x4 v[4]; float s = 0.f;
#pragma unroll
        for (int j = 0; j < 4; ++j) { v[j] = xr[64 * j]; s += (v[j].x * v[j].x + v[j].y * v[j].y) + (v[j].z * v[j].z + v[j].w * v[j].w); }
        const float rstd = 1.0f / sqrtf(wave_sum(s) * (1.0f / DM) + 1e-6f);
        unsigned long long* o8 = (unsigned long long*)(H + (size_t)m * DM) + F.lane;
#pragma unroll
        for (int j = 0; j < 4; ++j) { const f32x4 g = gp[64 * j], a = sc[64 * j], b = sh[64 * j]; const f32x4 o = v[j] * rstd * g * (1.0f + a) + b;
            o8[64 * j] = (unsigned long long)pk2(o.x, o.y) | ((unsigned long long)pk2(o.z, o.w) << 32); }
    }
}
__device__ __forceinline__ void hgrn_naive_item(Frame& F, int item) {
    const int s = item >> 3, h = (item >> 1) & 3, d = item & 1;
    const bool lat = s >= 16; const int T = lat ? 2048 : 256; const int row0 = lat ? M_CTX + (s - 16) * 2048 : s * 256;
    bf16* P = (bf16*)(F.ws + WS_PROJ);
    float* Lq = (float*)F.lds; float* Lf = Lq + 128; float* Lk = Lf + 128; float* Lv = Lk + 128; float* Lp = Lv + 128;
    const int tid = F.tid, dv = tid & 127, kq = tid >> 7;
    const int zcol = (d == 0 ? 512 : 1024) + h * 128;
    float S[32];
    if (lat) { const float* s0 = F.in[2] + ((size_t)(((s - 16) * 2 + d) * 4 + h)) * 16384;
#pragma unroll
        for (int i = 0; i < 32; ++i) S[i] = s0[(32 * kq + i) * 128 + dv]; }
    else {
#pragma unroll
        for (int i = 0; i < 32; ++i) S[i] = 0.f; }
    float lbv = 0.f;
    if (tid < 128) { const float l0 = F.in[13][(d * 2 + 0) * 512 + h * 128 + tid], l1 = F.in[13][(d * 2 + 1) * 512 + h * 128 + tid]; lbv = 1.0f / (1.0f + __expf(l1 - l0)); }
    __syncthreads();
    for (int tt = 0; tt < T; ++tt) {
        const int tok = d == 0 ? tt : T - 1 - tt; const size_t rb = (size_t)(row0 + tok) * EVEN_IN;
        if (tid < 128) { const float z = bf2f(P[rb + zcol + tid]); const float sg = sigmoidf(z);
            Lf[tid] = lbv + (1.0f - lbv) * sg; Lk[tid] = (1.0f - lbv) * (1.0f - sg); Lq[tid] = bf2f(P[rb + h * 128 + tid]); }
        else if (tid < 256) Lv[tid - 128] = bf2f(P[rb + 1536 + h * 128 + (tid - 128)]);
        __syncthreads();
        const float v = Lv[dv]; float part = 0.f;
#pragma unroll
        for (int i = 0; i < 32; ++i) { const int dk = 32 * kq + i; S[i] = Lf[dk] * S[i] + Lk[dk] * v; part += S[i] * Lq[dk]; }
        Lp[kq * 128 + dv] = part;
        __syncthreads();
        if (tid < 128) { const float o = (Lp[tid] + Lp[128 + tid]) + (Lp[256 + tid] + Lp[384 + tid]); P[rb + zcol + tid] = (bf16)f2bf(o); }
    }
    if (!lat) { float* so = F.out + OUT_HG + ((size_t)((s * 2 + d) * 4 + h)) * 16384;
#pragma unroll
        for (int i = 0; i < 32; ++i) so[(32 * kq + i) * 128 + dv] = S[i]; }
    __syncthreads();
}
__device__ __forceinline__ float dot64_bf(const float* qs, const bf16* kp) {
    float dot = 0.f;
    for (int e = 0; e < 8; ++e) { const v4u w = ((const v4u*)kp)[e]; const float* q = qs + 8 * e;
        dot += (q[0] * bflo(w.x) + q[1] * bfhi(w.x)) + (q[2] * bflo(w.y) + q[3] * bfhi(w.y)) + (q[4] * bflo(w.z) + q[5] * bfhi(w.z)) + (q[6] * bflo(w.w) + q[7] * bfhi(w.w)); }
    return dot;
}
__device__ __forceinline__ void attn_naive_item(Frame& F, int it) {
    const int m = it >> 3, head = it & 7, lane = F.lane;
    bf16* P = (bf16*)(F.ws + WS_PROJ);
    float* qs = (float*)(F.lds + F.wave * 2048); float* ps = qs + 64;
    qs[lane] = bf2f(P[(size_t)m * EVEN_IN + 2560 + head * 64 + lane]);
    LDS_WAIT(); asm volatile("" ::: "memory");
    float sc[6]; int nk;
    const bool lat = m >= M_CTX;
    int b = 0, r = 0, c = 0, rs = 0, wsx = 0;
    if (lat) { b = (m - M_CTX) >> 11; const int t = (m - M_CTX) & 2047; r = t >> 6; c = t & 63; rs = min(max(r - 4, 0), 24); wsx = min(max(c - 8, 0), 48); nk = 6; } else { b = m >> 8; nk = 4; }
#pragma unroll
    for (int i = 0; i < 6; ++i) {
        sc[i] = -1e30f;
        if (i < nk) {
            const int j = lane + 64 * i; float dot = 0.f, bias = 0.f;
            if (lat && i < 2) { const int kr = j >> 4, kc = j & 15; const int tk = (rs + kr) * 64 + wsx + kc;
                dot = dot64_bf(qs, P + (size_t)(M_CTX + b * 2048 + tk) * EVEN_IN + 3072 + head * 64);
                bias = F.in[15][(head * 15 + (rs + kr - r + 7)) * 31 + (wsx + kc - c + 15)]; }
            else if (lat) { const float* kp = F.in[3] + ((size_t)(b * 8 + head) * 256 + (j - 128)) * 64;
                for (int e = 0; e < 16; ++e) { const f32x4 kv = ((const f32x4*)kp)[e]; dot += (qs[4 * e] * kv.x + qs[4 * e + 1] * kv.y) + (qs[4 * e + 2] * kv.z + qs[4 * e + 3] * kv.w); } }
            else dot = dot64_bf(qs, P + (size_t)(b * 256 + j) * EVEN_IN + 3072 + head * 64);
            sc[i] = dot * 0.125f + bias;
        }
    }
    float mx = sc[0];
#pragma unroll
    for (int i = 1; i < 6; ++i) mx = fmaxf(mx, sc[i]);
#pragma unroll
    for (int o = 1; o < 64; o <<= 1) mx = fmaxf(mx, __shfl_xor(mx, o));
    float sum = 0.f;
#pragma unroll
    for (int i = 0; i < 6; ++i) { sc[i] = (i < nk) ? __expf(sc[i] - mx) : 0.f; sum += sc[i]; }
    sum = wave_sum(sum); const float inv = 1.0f / sum;
#pragma unroll
    for (int i = 0; i < 6; ++i) if (i < nk) ps[lane + 64 * i] = sc[i] * inv;
    LDS_WAIT(); asm volatile("" ::: "memory");
    float o = 0.f;
    if (lat) {
        for (int j = 0; j < 128; ++j) { const int kr = j >> 4, kc = j & 15; const int tk = (rs + kr) * 64 + wsx + kc;
            o += ps[j] * bf2f(P[(size_t)(M_CTX + b * 2048 + tk) * EVEN_IN + 3584 + head * 64 + lane]); }
        const float* vp = F.in[4] + ((size_t)(b * 8 + head) * 256) * 64 + lane;
        for (int j = 0; j < 256; ++j) o += ps[128 + j] * vp[(size_t)j * 64];
    } else {
        for (int j = 0; j < 256; ++j) o += ps[j] * bf2f(P[(size_t)(b * 256 + j) * EVEN_IN + 3584 + head * 64 + lane]);
    }
    P[(size_t)m * EVEN_IN + 2560 + head * 64 + lane] = (bf16)f2bf(o);
    LDS_WAIT(); asm volatile("" ::: "memory");
}
constexpr size_t WS_RGF = WS_PROJ + 80 * MiB, WS_RGB = WS_PROJ + 120 * MiB;
__device__ __forceinline__ void rg_naive_item(Frame& F, int item) {
    const int s = item >> 4, hb = (item >> 1) & 7, d = item & 1;
    const bool lat = s >= 16; const int T = lat ? 2048 : 256; const int row0 = lat ? M_CTX + (s - 16) * 2048 : s * 256;
    const bf16* P2 = (const bf16*)(F.ws + WS_PROJ);
    bf16* O = (bf16*)(F.ws + (d == 0 ? WS_RGF : WS_RGB));
    float* XB = (float*)F.lds; float* XC = XB + 19 * 128; float* GG = XC + 16 * 128;
    const int tid = F.tid;
    float hst = 0.f, sp = 0.f;
    if (tid < 128) { if (lat) hst = F.in[5][((s - 16) * 2 + d) * 1024 + hb * 128 + tid]; const float lam = F.in[22][d * 1024 + hb * 128 + tid]; sp = log1pf(__expf(-lam)); }
    for (int k = 0; k < T / 16; ++k) {
        const int tb = d == 0 ? 16 * k : T - 16 * (k + 1);
        for (int idx = tid; idx < 19 * 128; idx += NWAVES * 64) { const int hr = idx >> 7, ch = idx & 127, tok = tb + hr - 2;
            XB[idx] = (tok >= 0 && tok < T) ? bf2f(P2[(size_t)(row0 + tok) * ODD_IN + hb * 128 + ch]) : 0.f; }
        __syncthreads();
        for (int idx = tid; idx < 16 * 128; idx += NWAVES * 64) { const int t = idx >> 7, ch = idx & 127; float a = F.in[19][hb * 128 + ch];
#pragma unroll
            for (int j = 0; j < 4; ++j) a += F.in[18][j * 1024 + hb * 128 + ch] * XB[(t + j) * 128 + ch];
            XC[idx] = a; }
        __syncthreads();
        { const int g = tid >> 8, th = (tid >> 7) & 1, j = tid & 127;
          const float* w = F.in[20] + ((size_t)((d * 2 + g) * 8 + hb) * 128) * 128 + j;
          float acc[8];
#pragma unroll
          for (int t = 0; t < 8; ++t) acc[t] = 0.f;
          for (int i = 0; i < 128; ++i) { const float wv = w[(size_t)i * 128];
#pragma unroll
              for (int t = 0; t < 8; ++t) acc[t] += XC[(th * 8 + t) * 128 + i] * wv; }
          const float gb = F.in[21][(d * 2 + g) * 1024 + hb * 128 + j];
#pragma unroll
          for (int t = 0; t < 8; ++t) GG[(g * 16 + th * 8 + t) * 128 + j] = sigmoidf(acc[t] + gb); }
        __syncthreads();
        if (tid < 128) {
            for (int tt = 0; tt < 16; ++tt) { const int t = d == 0 ? tt : 15 - tt;
                const float rr = GG[t * 128 + tid], ii = GG[(16 + t) * 128 + tid];
                const float la = -8.0f * rr * sp; const float a = __expf(la); const float u = sqrtf(-expm1f(2.0f * la)) * (ii * XC[t * 128 + tid]);
                hst = a * hst + u;
                O[(size_t)(row0 + tb + t) * DM + hb * 128 + tid] = (bf16)f2bf(hst); } }
        __syncthreads();
    }
    if (!lat && tid < 128) F.out[OUT_RG + (s * 2 + d) * 1024 + hb * 128 + tid] = hst;
}
__device__ __forceinline__ void gate_even_rows(Frame& F) {
    const bf16* P = (const bf16*)(F.ws + WS_PROJ); bf16* Y = (bf16*)(F.ws + WS_H);
    const int gw = F.vcu * NWAVES + F.wave, NGW = F.G * NWAVES, lane = F.lane;
    const f32x4 g0 = ((const f32x4*)F.in[14])[lane * 2], g1 = ((const f32x4*)F.in[14])[lane * 2 + 1];
    const float gain[8] = {g0.x, g0.y, g0.z, g0.w, g1.x, g1.y, g1.z, g1.w};
    for (int m = gw; m < M_ALL; m += NGW) {
        const bf16* pr = P + (size_t)m * EVEN_IN + lane * 8;
        const v4u wf = *(const v4u*)(pr + 512), wb = *(const v4u*)(pr + 1024), wga = *(const v4u*)(pr + 2048), wo = *(const v4u*)(pr + 2560), wgb = *(const v4u*)(pr + 4096);
        float o[8], ga[8], ob[8], gb[8];
#pragma unroll
        for (int e = 0; e < 4; ++e) { o[2 * e] = bflo(wf[e]) + bflo(wb[e]); o[2 * e + 1] = bfhi(wf[e]) + bfhi(wb[e]); ga[2 * e] = bflo(wga[e]); ga[2 * e + 1] = bfhi(wga[e]);
            ob[2 * e] = bflo(wo[e]); ob[2 * e + 1] = bfhi(wo[e]); gb[2 * e] = bflo(wgb[e]); gb[2 * e + 1] = bfhi(wgb[e]); }
        float ss = 0.f;
#pragma unroll
        for (int e = 0; e < 8; ++e) ss += o[e] * o[e];
        ss += __shfl_xor(ss, 1); ss += __shfl_xor(ss, 2); ss += __shfl_xor(ss, 4); ss += __shfl_xor(ss, 8);
        const float rstd = 1.0f / sqrtf(ss * (1.0f / 128.0f) + 1e-6f);
        float ya[8], yb[8];
#pragma unroll
        for (int e = 0; e < 8; ++e) { ya[e] = o[e] * rstd * gain[e] * siluf(ga[e]); yb[e] = ob[e] * siluf(gb[e]); }
        v4u wa, wbo;
#pragma unroll
        for (int e = 0; e < 4; ++e) { wa[e] = pk2(ya[2 * e], ya[2 * e + 1]); wbo[e] = pk2(yb[2 * e], yb[2 * e + 1]); }
        bf16* yr = Y + (size_t)m * DM + lane * 8;
        *(v4u*)yr = wa; *(v4u*)(yr + 512) = wbo;
    }
}
__device__ __forceinline__ void rg_combine_rows(Frame& F) {
    const bf16* P2 = (const bf16*)(F.ws + WS_PROJ); const bf16* OF = (const bf16*)(F.ws + WS_RGF); const bf16* OB = (const bf16*)(F.ws + WS_RGB); bf16* Y = (bf16*)(F.ws + WS_H);
    const int gw = F.vcu * NWAVES + F.wave, NGW = F.G * NWAVES, lane = F.lane;
    for (int m = gw; m < M_ALL; m += NGW) {
#pragma unroll
        for (int part = 0; part < 2; ++part) { const int c0 = part * 512 + lane * 8;
            const v4u a = *(const v4u*)(OF + (size_t)m * DM + c0), b = *(const v4u*)(OB + (size_t)m * DM + c0), g = *(const v4u*)(P2 + (size_t)m * ODD_IN + 1024 + c0);
            v4u w;
#pragma unroll
            for (int e = 0; e < 4; ++e) w[e] = pk2((bflo(a[e]) + bflo(b[e])) * siluf(bflo(g[e])), (bfhi(a[e]) + bfhi(b[e])) * siluf(bfhi(g[e])));
            *(v4u*)(Y + (size_t)m * DM + c0) = w; }
    }
}
__device__ __forceinline__ void final_norm_rows(Frame& F) {
    const int gw = F.vcu * NWAVES + F.wave, NGW = F.G * NWAVES;
    const f32x4* gp = (const f32x4*)F.in[23] + F.lane;
    for (int m = gw; m < M_ALL; m += NGW) {
        f32x4* xr = (f32x4*)(F.out + (size_t)m * DM) + F.lane;
        f32x4 v[4]; float s = 0.f;
#pragma unroll
        for (int j = 0; j < 4; ++j) { v[j] = xr[64 * j]; s += (v[j].x * v[j].x + v[j].y * v[j].y) + (v[j].z * v[j].z + v[j].w * v[j].w); }
        const float rstd = 1.0f / sqrtf(wave_sum(s) * (1.0f / DM) + 1e-6f);
#pragma unroll
        for (int j = 0; j < 4; ++j) xr[64 * j] = v[j] * rstd * gp[64 * j];
    }
}
typedef float f32x2_t __attribute__((ext_vector_type(2))); typedef __bf16 bf16x2_t __attribute__((ext_vector_type(2)));
__device__ __forceinline__ unsigned cvtpk(float lo, float hi) { f32x2_t v = {lo, hi}; bf16x2_t b = __builtin_convertvector(v, bf16x2_t); return __builtin_bit_cast(unsigned, b); }
#define MFMA32(a, b, c) __builtin_amdgcn_mfma_f32_32x32x16_bf16((a), (b), (c), 0, 0, 0)
template <int ST> __device__ __forceinline__ bf16x8 pack8(const f32x16& x) {
    v4u p; p.x = cvtpk(x[8 * ST], x[8 * ST + 1]); p.y = cvtpk(x[8 * ST + 2], x[8 * ST + 3]); p.z = cvtpk(x[8 * ST + 4], x[8 * ST + 5]); p.w = cvtpk(x[8 * ST + 6], x[8 * ST + 7]);
    return __builtin_bit_cast(bf16x8, p);
}
__device__ __forceinline__ bf16x8 cat4(s16x4 lo, s16x4 hi) { return __builtin_shufflevector(lo, hi, 0, 1, 2, 3, 4, 5, 6, 7); }
constexpr int HG_QD = 0, HG_KI = 8704, HG_KDT = 17408, HG_VT = 27648, HG_DEC = 37888, HG_BUF = 38400;
__device__ __forceinline__ void hgrn_mfma_item(Frame& F, int item) {
    const int s = item >> 3, h = (item >> 1) & 3, d = item & 1;
    const bool lat = s >= 16; const int T = lat ? 2048 : 256; const int row0 = lat ? M_CTX + (s - 16) * 2048 : s * 256; const int nch = T / 32;
    bf16* P = (bf16*)(F.ws + WS_PROJ);
    LAS unsigned char* L = (LAS unsigned char*)F.lds;
    const int zcol = (d == 0 ? 512 : 1024) + h * 128;
    const int lane = F.lane, r = lane & 31, hh = lane >> 5;
    if (F.wave >= 4) {
        const int pw = F.wave - 4, dk = 32 * pw + r;
        const float l0 = F.in[13][(d * 2 + 0) * 512 + h * 128 + dk], l1 = F.in[13][(d * 2 + 1) * 512 + h * 128 + dk];
        const float lbv = 1.0f / (1.0f + __expf(l1 - l0)), omlb = 1.0f - lbv;
        unsigned short zr[16], qr[16], vr[16];
#define HG_LOAD(n) do { _Pragma("unroll") for (int ii = 0; ii < 16; ++ii) { const int i = 16 * hh + ii; const int tok = d == 0 ? 32 * (n) + i : T - 1 - (32 * (n) + i); \
            const bf16* pr = P + (size_t)(row0 + tok) * EVEN_IN; zr[ii] = pr[zcol + dk]; qr[ii] = pr[h * 128 + dk]; vr[ii] = pr[1536 + h * 128 + dk]; } } while (0)
        HG_LOAD(0);
        for (int n = 0; n <= nch; ++n) {
            if (n < nch) {
                LAS unsigned char* B = L + (n & 1) * HG_BUF;
                float lf[16], kk[16]; float tot = 0.f;
#pragma unroll
                for (int ii = 0; ii < 16; ++ii) { const float z = bf2f(zr[ii]); const float sg = sigmoidf(z); const float f = lbv + omlb * sg; lf[ii] = __logf(f); kk[ii] = omlb * (1.0f - sg); tot += lf[ii]; }
                const float other = __shfl_xor(tot, 32);
                const float bend = tot + other; float b = hh ? other : 0.f;
                unsigned kd[8], vv[8];
#pragma unroll
                for (int ii = 0; ii < 16; ++ii) { b += lf[ii]; const int i = 16 * hh + ii;
                    const float qd = bf2f(qr[ii]) * __expf(b), ki = kk[ii] * __expf(-b), kdv = kk[ii] * __expf(bend - b);
                    *(LAS unsigned short*)(B + HG_QD + i * 272 + dk * 2) = (unsigned short)f2bf(qd);
                    *(LAS unsigned short*)(B + HG_KI + i * 272 + dk * 2) = (unsigned short)f2bf(ki);
                    if (ii & 1) { kd[ii >> 1] |= f2bf(kdv) << 16; vv[ii >> 1] |= (unsigned)vr[ii] << 16; } else { kd[ii >> 1] = f2bf(kdv); vv[ii >> 1] = vr[ii]; } }
                *(LAS v4u*)(B + HG_KDT + dk * 80 + hh * 32) = (v4u){kd[0], kd[1], kd[2], kd[3]}; *(LAS v4u*)(B + HG_KDT + dk * 80 + hh * 32 + 16) = (v4u){kd[4], kd[5], kd[6], kd[7]};
                *(LAS v4u*)(B + HG_VT + dk * 80 + hh * 32) = (v4u){vv[0], vv[1], vv[2], vv[3]}; *(LAS v4u*)(B + HG_VT + dk * 80 + hh * 32 + 16) = (v4u){vv[4], vv[5], vv[6], vv[7]};
                if (hh == 0) *(LAS float*)(B + HG_DEC + dk * 4) = __expf(bend);
                if (n + 1 < nch) HG_LOAD(n + 1);
            }
            __syncthreads();
        }
#undef HG_LOAD
    } else {
        const int w = F.wave, dvc = 32 * w + r;
        f32x16 S[4];
        if (lat) { const float* s0 = F.in[2] + ((size_t)(((s - 16) * 2 + d) * 4 + h)) * 16384;
#pragma unroll
            for (int i = 0; i < 4; ++i)
#pragma unroll
                for (int g = 0; g < 16; ++g) S[i][g] = s0[(32 * i + (g & 3) + 8 * (g >> 2) + 4 * hh) * 128 + dvc]; }
        else {
#pragma unroll
            for (int i = 0; i < 4; ++i)
#pragma unroll
                for (int g = 0; g < 16; ++g) S[i][g] = 0.f; }
        __syncthreads();
        for (int n = 0; n < nch; ++n) {
            LAS unsigned char* B = L + (n & 1) * HG_BUF;
            f32x16 X;
#pragma unroll
            for (int g = 0; g < 16; ++g) X[g] = 0.f;
#pragma unroll
            for (int st = 0; st < 8; ++st) { const bf16x8 a = *(LAS bf16x8*)(B + HG_KI + r * 272 + (16 * st + 8 * hh) * 2), b = *(LAS bf16x8*)(B + HG_QD + r * 272 + (16 * st + 8 * hh) * 2); X = MFMA32(a, b, X); }
#pragma unroll
            for (int g = 0; g < 16; ++g) { const int sr = (g & 3) + 8 * (g >> 2) + 4 * hh; X[g] = sr <= r ? X[g] : 0.f; }
            const bf16x8 xa0 = pack8<0>(X), xa1 = pack8<1>(X);
            f32x16 O;
#pragma unroll
            for (int g = 0; g < 16; ++g) O[g] = 0.f;
            { const LAS unsigned char* vt = B + HG_VT + dvc * 80 + 8 * hh;
              O = MFMA32(xa0, cat4(*(const LAS s16x4*)(vt), *(const LAS s16x4*)(vt + 16)), O);
              O = MFMA32(xa1, cat4(*(const LAS s16x4*)(vt + 32), *(const LAS s16x4*)(vt + 48)), O); }
#pragma unroll
            for (int i = 0; i < 4; ++i) { const LAS unsigned char* qd = B + HG_QD + r * 272 + (32 * i) * 2 + 8 * hh;
                O = MFMA32(cat4(*(const LAS s16x4*)(qd), *(const LAS s16x4*)(qd + 16)), pack8<0>(S[i]), O);
                O = MFMA32(cat4(*(const LAS s16x4*)(qd + 32), *(const LAS s16x4*)(qd + 48)), pack8<1>(S[i]), O); }
#pragma unroll
            for (int g = 0; g < 16; ++g) { const int t = (g & 3) + 8 * (g >> 2) + 4 * hh; const int tok = d == 0 ? 32 * n + t : T - 1 - (32 * n + t);
                P[(size_t)(row0 + tok) * EVEN_IN + zcol + dvc] = (bf16)f2bf(O[g]); }
#pragma unroll
            for (int i = 0; i < 4; ++i) {
#pragma unroll
                for (int g = 0; g < 16; ++g) S[i][g] *= *(const LAS float*)(B + HG_DEC + (32 * i + (g & 3) + 8 * (g >> 2) + 4 * hh) * 4);
#pragma unroll
                for (int st = 0; st < 2; ++st) { const bf16x8 a = *(const LAS bf16x8*)(B + HG_KDT + (32 * i + r) * 80 + (16 * st + 8 * hh) * 2), b = *(const LAS bf16x8*)(B + HG_VT + dvc * 80 + (16 * st + 8 * hh) * 2); S[i] = MFMA32(a, b, S[i]); } }
            __syncthreads();
        }
        if (!lat) { float* so = F.out + OUT_HG + ((size_t)((s * 2 + d) * 4 + h)) * 16384;
#pragma unroll
            for (int i = 0; i < 4; ++i)
#pragma unroll
                for (int g = 0; g < 16; ++g) so[(32 * i + (g & 3) + 8 * (g >> 2) + 4 * hh) * 128 + dvc] = S[i][g]; }
    }
}
struct Args { const float* in[24]; float* out; unsigned char* ws; int ph_lo, ph_hi; };
__global__ void __launch_bounds__(NWAVES * 64, 2) mega_fwd(Args args) {
    extern __shared__ __attribute__((aligned(16))) unsigned char lds[];
    Frame F;
    F.lds = lds;
    F.MISC = (volatile LAS unsigned*)((LAS unsigned char*)lds + MISC_OFF);
    F.tid = threadIdx.x; F.lane = F.tid & 63; F.wave = __builtin_amdgcn_readfirstlane(F.tid >> 6);
    F.G = gridDim.x; { const int bx = blockIdx.x; F.vcu = (F.G % 8 == 0) ? (bx % 8) * (F.G / 8) + bx / 8 : bx; }
    F.ws = args.ws; F.out = args.out; F.ctl = (gu32*)(args.ws + WS_CTL);
#pragma unroll
    for (int i = 0; i < 24; ++i) F.in[i] = args.in[i];
    for (int u = F.tid; u < (LDS_BYTES - MISC_OFF) / 4; u += NWAVES * 64) ((LAS unsigned*)((LAS unsigned char*)lds + MISC_OFF))[u] = 0u;
    __syncthreads();
    const int lo = args.ph_lo, hi = args.ph_hi;
    const bool one = (lo == 0 && hi == NPHASE);
    XcdBarrier bar; bar.bar = (unsigned*)(F.ctl + CW_BAR); bar.x = 0; bar.st = nullptr;
    if (one) bar = xcd_barrier_post((unsigned*)(F.ctl + CW_BAR), F.MISC + 8);
#define IN(k) (lo <= (k) && (k) < hi)
#define GRID_BAR(k) do { if (IN(k) && IN((k) + 1)) xcd_barrier(bar); } while (0)
    LAS unsigned char* ring = (LAS unsigned char*)lds;

    if (IN(0)) { p0_prologue(F); GRID_BAR(0); }
    if (IN(1)) { modnorm_rows(F, 0, F.in[0], F.in[1]); GRID_BAR(1); }
    if (IN(2)) {
        pg8::Gemm g{(const bf16*)(F.ws + WS_H), (const bf16*)(F.ws + WS_WIE), M_ALL, EVEN_IN, DM}; pg8::StaticOrder S; S.init(M_ALL, EVEN_IN, F.G, (int)blockIdx.x);
        pg8::EpiProj E{(bf16*)(F.ws + WS_PROJ), EVEN_IN, F.out + OUT_K};
        pg8::gemm_phase<pg8::EpiProj, pg8::StaticOrder, true, true>(ring, g, S, E);
        GRID_BAR(2);
    }
    if (IN(3)) {
        for (int it = blockIdx.x; it < 192; it += F.G) hgrn_mfma_item(F, 191 - it);
        { const int gw = F.vcu * NWAVES + F.wave, NGW = F.G * NWAVES; for (int it = gw; it < M_ALL * 8; it += NGW) attn_naive_item(F, it); }
        GRID_BAR(3);
    }
    if (IN(4)) { gate_even_rows(F); GRID_BAR(4); }
    if (IN(5)) {
        pg8::Gemm g{(const bf16*)(F.ws + WS_H), (const bf16*)(F.ws + WS_WOE), M_ALL, DM, DM}; pg8::StaticOrder S; S.init(M_ALL, DM, F.G, (int)blockIdx.x);
        pg8::EpiRes E{F.in[0], F.in[1], F.out, (const float*)(F.ws + WS_MODS) + 2048};
        pg8::gemm_phase<pg8::EpiRes, pg8::StaticOrder, true, true>(ring, g, S, E);
        GRID_BAR(5);
    }
    if (IN(6)) { modnorm_rows(F, 1, F.out, F.out + (size_t)M_CTX * DM); GRID_BAR(6); }
    if (IN(7)) {
        pg8::Gemm g{(const bf16*)(F.ws + WS_H), (const bf16*)(F.ws + WS_WIO), M_ALL, ODD_IN, DM}; pg8::StaticOrder S; S.init(M_ALL, ODD_IN, F.G, (int)blockIdx.x);
        pg8::EpiProj E{(bf16*)(F.ws + WS_PROJ), ODD_IN, nullptr};
        pg8::gemm_phase<pg8::EpiProj, pg8::StaticOrder, true, true>(ring, g, S, E);
        GRID_BAR(7);
    }
    if (IN(8)) { for (int it = blockIdx.x; it < 384; it += F.G) rg_naive_item(F, 383 - it); GRID_BAR(8); }
    if (IN(9)) { rg_combine_rows(F); GRID_BAR(9); }
    if (IN(10)) {
        pg8::Gemm g{(const bf16*)(F.ws + WS_H), (const bf16*)(F.ws + WS_WOO), M_ALL, DM, DM}; pg8::StaticOrder S; S.init(M_ALL, DM, F.G, (int)blockIdx.x);
        pg8::EpiRes E{F.out, F.out + (size_t)M_CTX * DM, F.out, (const float*)(F.ws + WS_MODS) + 9 * 3072 + 2048};
        pg8::gemm_phase<pg8::EpiRes, pg8::StaticOrder, true, true>(ring, g, S, E);
        GRID_BAR(10);
    }
    if (IN(11)) { final_norm_rows(F); }

#undef IN
#undef GRID_BAR
}

extern "C" void kernel_launch(void* const* d_in, const int* in_sizes, int n_in, void* d_out, int out_size, void* d_ws, size_t ws_size, hipStream_t stream) {
    static int grid = 0;
    if (grid == 0) {
        if (n_in != 24 || out_size != (int)OUT_TOTAL || ws_size < WS_END) { fprintf(stderr, "kernel_launch: unexpected shapes (n_in %d out %d ws %zu)\n", n_in, out_size, ws_size); grid = -1; return; }
        int dev = 0, cus = 0, per_cu = 0;
        if (hipGetDevice(&dev) != hipSuccess || hipDeviceGetAttribute(&cus, hipDeviceAttributeMultiprocessorCount, dev) != hipSuccess) { grid = -1; return; }
        if (hipFuncSetAttribute((const void*)mega_fwd, hipFuncAttributeMaxDynamicSharedMemorySize, LDS_BYTES) != hipSuccess) { fprintf(stderr, "kernel_launch: hipFuncSetAttribute failed\n"); grid = -1; return; }
        if (hipOccupancyMaxActiveBlocksPerMultiprocessor(&per_cu, (const void*)mega_fwd, NWAVES * 64, LDS_BYTES) != hipSuccess || per_cu < 1) { fprintf(stderr, "kernel_launch: occupancy query says %d\n", per_cu); }
        (void)hipGetLastError();
        grid = cus;
    }
    if (grid < 0) return;
    (void)hipMemsetAsync((char*)d_ws + WS_CTL, 0, CTL_ZERO_BYTES, stream);
    Args a{};
    for (int i = 0; i < 24; ++i) a.in[i] = (const float*)d_in[i];
    a.out = (float*)d_out; a.ws = (unsigned char*)d_ws;
#if defined(MK_PER_PHASE)
    for (int p = 0; p < NPHASE; ++p) { a.ph_lo = p; a.ph_hi = p + 1; hipLaunchKernelGGL(mega_fwd, dim3(grid), dim3(NWAVES * 64), LDS_BYTES, stream, a); }
#else
    a.ph_lo = 0; a.ph_hi = NPHASE;
    hipLaunchKernelGGL(mega_fwd, dim3(grid), dim3(NWAVES * 64), LDS_BYTES, stream, a);
#endif
}
```

```cpp
#include <hip/hip_runtime.h>
#include <cstdio>
#include <cstdint>
namespace pg8 {
#define PG8_LAS __attribute__((address_space(3)))
typedef unsigned short bf16_t;
typedef short bf16x8 __attribute__((ext_vector_type(8)));
typedef float f32x4 __attribute__((ext_vector_type(4)));
typedef unsigned u32x4 __attribute__((ext_vector_type(4)));
constexpr int BM = 256, BK = 64, HALF = 128, HTB = HALF * BK * 2  , STAGE_BYTES = 8 * HTB, NXCD = 8, WGM = 8;

__host__ __device__ __forceinline__ int lds_byte(int r, int c) { const int st = (r >> 4) * 2 + (c >> 5), rr = r & 15, cc = c & 31, ob = rr * 64 + cc * 2; return st * 1024 + (ob ^ (((ob >> 9) & 1) << 5)); }
__host__ __device__ __forceinline__ void stage_rc(int b, int& R, int& C) { const int st = b / 1024, sb = b % 1024, swz = sb ^ (((sb >> 9) & 1) << 5); R = (st >> 1) * 16 + swz / 64; C = (st & 1) * 32 + (swz % 64) / 2; }
__host__ __device__ __forceinline__ int perm32(int rho) { const int n = rho >> 4, i = rho & 15; return 8 * (i >> 2) + 4 * n + (i & 3); }

struct Unit { int pm, pn; };
struct Gemm { const bf16_t* A; const bf16_t* Bt; int M, N, K; };

struct StaticOrder {
    int nM, nN, nwg, G, c;
    __host__ __device__ void init(int M, int N, int G_, int c_) { nM = M / BM; nN = N / BM; nwg = nM * nN; G = G_; c = c_; }
    __host__ __device__ bool next(int i, Unit& u) const {
        const long L = (long)i * G + c; if (L >= nwg) return false;
        int wgid = (int)L; { const int q = nwg / NXCD, r = nwg % NXCD, xcd = wgid % NXCD, off = wgid / NXCD; wgid = (xcd < r ? xcd * (q + 1) : r * (q + 1) + (xcd - r) * q) + off; }
        const int nig = WGM * nN, gid = wgid / nig, fm = gid * WGM, gsz = (nM - fm) < WGM ? (nM - fm) : WGM;
        u.pm = fm + ((wgid % nig) % gsz); u.pn = (wgid % nig) / gsz; return true;
    }
    __device__ __forceinline__ void a_ready(const Unit&) const {}
    __device__ __forceinline__ void done(const Unit&) const {}
};

__device__ __forceinline__ unsigned cvt_pk_bf16(float lo, float hi) { unsigned r; asm volatile("v_cvt_pk_bf16_f32 %0, %1, %2" : "=v"(r) : "v"(lo), "v"(hi)); return r; }
typedef float f32x2 __attribute__((ext_vector_type(2)));
struct EpiProj {
    static constexpr bool PERM = true, AFTER_DRAIN = false;
    bf16_t* O; int ldc; float* kv;
    __device__ __forceinline__ void operator()(const f32x4 (&acc)[2][2][4][2], const Unit& u, int wr, int wc, int fr, int fq) const {
        const int row0 = u.pm * BM + wr * 64 + fr; const int col0 = u.pn * BM + wc * 32 + 8 * fq;
        const bool dokv = (kv != nullptr) && u.pm < 16 && u.pn >= 12 && u.pn < 16;
#pragma unroll
        for (int ai = 0; ai < 2; ++ai)
#pragma unroll
            for (int m = 0; m < 4; ++m) { bf16_t* rowp = O + (size_t)(row0 + ai * HALF + m * 16) * ldc + col0;
#pragma unroll
                for (int bj = 0; bj < 2; ++bj) { const f32x4 v0 = acc[ai][bj][m][0], v1 = acc[ai][bj][m][1];
                    u32x4 w; w.x = cvt_pk_bf16(v0[0], v0[1]); w.y = cvt_pk_bf16(v0[2], v0[3]); w.z = cvt_pk_bf16(v1[0], v1[1]); w.w = cvt_pk_bf16(v1[2], v1[3]);
                    *(u32x4*)(rowp + bj * HALF) = w;
                    if (dokv) { const int cc = col0 + bj * HALF - 3072, which = cc >> 9, c2 = cc & 511, head = c2 >> 6, d = c2 & 63, t = wr * 64 + fr + ai * HALF + m * 16;
                        float* p = kv + (size_t)which * 2097152 + ((size_t)(u.pm * 8 + head) * 256 + t) * 64 + d; *(f32x4*)p = v0; *(f32x4*)(p + 4) = v1; } } }
    }
};
struct EpiRes {
    static constexpr bool PERM = false, AFTER_DRAIN = false;
    const float* base0; const float* base1; float* out; const float* gate;
    __device__ __forceinline__ void operator()(const f32x4 (&acc)[2][2][4][2], const Unit& u, int wr, int wc, int fr, int fq) const {
        const int nidx = u.pm < 16 ? 0 : 1 + ((u.pm - 16) >> 3);
        const float* gp = gate + (size_t)nidx * 3072;
        const int col0 = u.pn * BM + wc * 32 + 4 * fq;
        f32x4 gv[2][2];
#pragma unroll
        for (int bj = 0; bj < 2; ++bj)
#pragma unroll
            for (int n = 0; n < 2; ++n) gv[bj][n] = *(const f32x4*)(gp + col0 + bj * HALF + n * 16);
#pragma unroll
        for (int ai = 0; ai < 2; ++ai)
#pragma unroll
            for (int m = 0; m < 4; ++m) { const int row = u.pm * BM + ai * HALF + wr * 64 + m * 16 + fr;
                const float* bp = (row < 4096 ? base0 + (size_t)row * 1024 : base1 + (size_t)(row - 4096) * 1024) + col0;
                float* op = out + (size_t)row * 1024 + col0;
#pragma unroll
                for (int bj = 0; bj < 2; ++bj)
#pragma unroll
                    for (int n = 0; n < 2; ++n) { const f32x4 b = *(const f32x4*)(bp + bj * HALF + n * 16); *(f32x4*)(op + bj * HALF + n * 16) = b + gv[bj][n] * acc[ai][bj][m][n]; } }
    }
};
template <class Epi, class Sched, bool ALIGN_EPI = false, bool SP2 = false>
__device__ __forceinline__ void gemm_phase(PG8_LAS unsigned char* lds, const Gemm g, const Sched& S, const Epi& E) {
    const int tid = threadIdx.x, wid = __builtin_amdgcn_readfirstlane(tid >> 6), lane = tid & 63, wr = wid >> 2, wc = wid & 3, fr = lane & 15, fq = lane >> 4;
    const int K = g.K, nt = K / BK;
    unsigned voffA[2], voffB[2];
#pragma unroll
    for (int i = 0; i < 2; ++i) { int R, C; stage_rc(tid * 16 + i * 8192, R, C); const int Rb = Epi::PERM ? ((R & ~31) + perm32(R & 31)) : R;
        voffA[i] = (unsigned)(R * K + C) * 2u; voffB[i] = (unsigned)(Rb * K + C) * 2u; }
    const size_t kstep = (size_t)(BK * 2);
    const size_t hstep = (size_t)HALF * K * 2;
    const size_t tstep = 2 * hstep;
    const unsigned ldsw = (unsigned)wid * 1024u;
    const int aoff = lds_byte(wr * 64 + fr, fq * 8), boff = lds_byte(wc * 32 + fr, fq * 8);
#define PG8_SA(b, h) (((b) * 2 + (h)) * HTB)
#define PG8_SB(b, h) ((4 + (b) * 2 + (h)) * HTB)
#define PG8_STAGE(bufoff, gbase, voff) do { _Pragma("unroll") for (int _i = 0; _i < 2; ++_i) \
        __builtin_amdgcn_global_load_lds((const unsigned*)((const char*)(gbase) + (voff)[_i]), (PG8_LAS unsigned*)(lds + (bufoff) + ldsw + _i * 8192), 16, 0, 0); } while (0)
#define PG8_LDA(dst, b, h) do { _Pragma("unroll") for (int m = 0; m < 4; ++m) _Pragma("unroll") for (int k = 0; k < 2; ++k) dst[m][k] = *(const PG8_LAS bf16x8*)(lds + PG8_SA(b, h) + aoff + m * 2048 + k * 1024); } while (0)
#define PG8_LDB(dst, b, h) do { _Pragma("unroll") for (int n = 0; n < 2; ++n) _Pragma("unroll") for (int k = 0; k < 2; ++k) dst[n][k] = *(const PG8_LAS bf16x8*)(lds + PG8_SB(b, h) + boff + n * 2048 + k * 1024); } while (0)
#define PG8_MMA(ai, bj, At, Bt) do { __builtin_amdgcn_s_setprio(1); _Pragma("unroll") for (int m = 0; m < 4; ++m) _Pragma("unroll") for (int n = 0; n < 2; ++n) _Pragma("unroll") for (int k = 0; k < 2; ++k) \
        acc[ai][bj][m][n] = __builtin_amdgcn_mfma_f32_16x16x32_bf16(Bt[n][k], At[m][k], acc[ai][bj][m][n], 0, 0, 0); __builtin_amdgcn_s_setprio(0); } while (0)
#define PG8_WAIT_V(n) asm volatile("s_waitcnt vmcnt(" #n ")" ::: "memory")
#define PG8_WAIT_L(n) asm volatile("s_waitcnt lgkmcnt(" #n ")" ::: "memory")
#define PG8_BAR __builtin_amdgcn_s_barrier()
#define PG8_SCHED __builtin_amdgcn_sched_barrier(0)
    Unit cur, nxt; int ui = 0;
    if (!S.next(0, cur)) return;
    f32x4 acc[2][2][4][2];
#pragma unroll
    for (int a = 0; a < 2; ++a)
#pragma unroll
        for (int b = 0; b < 2; ++b)
#pragma unroll
            for (int m = 0; m < 4; ++m)
#pragma unroll
                for (int n = 0; n < 2; ++n) acc[a][b][m][n] = (f32x4){0.f, 0.f, 0.f, 0.f};
    bf16x8 At[4][2], B0[2][2], B1[2][2];
    const char* cA = (const char*)g.A + (size_t)cur.pm * tstep; const char* cB = (const char*)g.Bt + (size_t)cur.pn * tstep;
    S.a_ready(cur);
    if constexpr (SP2) {
        PG8_STAGE(PG8_SB(0, 0), cB, voffB); PG8_STAGE(PG8_SB(0, 1), cB + hstep, voffB); PG8_STAGE(PG8_SA(0, 0), cA, voffA); PG8_STAGE(PG8_SA(0, 1), cA + hstep, voffA);
        if (wr == 1) PG8_BAR;
        PG8_WAIT_V(2); PG8_BAR;
        PG8_STAGE(PG8_SB(1, 0), cB + kstep, voffB); PG8_STAGE(PG8_SA(1, 0), cA + kstep, voffA); PG8_STAGE(PG8_SB(1, 1), cB + hstep + kstep, voffB);
        PG8_WAIT_V(6); PG8_BAR;
    } else {
        PG8_STAGE(PG8_SB(0, 0), cB, voffB); PG8_STAGE(PG8_SA(0, 0), cA, voffA); PG8_STAGE(PG8_SB(0, 1), cB + hstep, voffB); PG8_STAGE(PG8_SA(0, 1), cA + hstep, voffA);
        if (wr == 1) PG8_BAR;
        PG8_WAIT_V(4); PG8_BAR;
        PG8_STAGE(PG8_SB(1, 0), cB + kstep, voffB); PG8_STAGE(PG8_SA(1, 0), cA + kstep, voffA); PG8_STAGE(PG8_SB(1, 1), cB + hstep + kstep, voffB);
        PG8_WAIT_V(6); PG8_BAR;
    }
    for (;;) {
        const bool has_next = S.next(ui + 1, nxt);
        const char* nA = has_next ? (const char*)g.A + (size_t)nxt.pm * tstep : cA; const char* nB = has_next ? (const char*)g.Bt + (size_t)nxt.pn * tstep : cB;
        for (int t = 0; t < nt; t += 2) {
            const bool last = (t == nt - 2);
            const char* a1 = cA + (size_t)(t + 1) * kstep;
            const char* a2 = last ? nA : cA + (size_t)(t + 2) * kstep; const char* b2 = last ? nB : cB + (size_t)(t + 2) * kstep;
            const char* a3 = a2 + kstep; const char* b3 = b2 + kstep;
            if (last && has_next) S.a_ready(nxt);
            if constexpr (SP2) {
            PG8_LDB(B0, 0, 0); PG8_LDB(B1, 0, 1); PG8_SCHED; PG8_LDA(At, 0, 0); PG8_STAGE(PG8_SA(1, 1), a1 + hstep, voffA);
            PG8_WAIT_V(8); PG8_WAIT_L(0); PG8_BAR; PG8_MMA(0, 0, At, B0); PG8_MMA(0, 1, At, B1); PG8_BAR; PG8_SCHED;
            PG8_LDA(At, 0, 1); PG8_STAGE(PG8_SB(0, 0), b2, voffB); PG8_STAGE(PG8_SB(0, 1), b2 + hstep, voffB); PG8_STAGE(PG8_SA(0, 0), a2, voffA);
            PG8_WAIT_V(8); PG8_WAIT_L(0); PG8_BAR; PG8_MMA(1, 0, At, B0); PG8_MMA(1, 1, At, B1); PG8_BAR; PG8_SCHED;
            PG8_LDB(B0, 1, 0); PG8_LDB(B1, 1, 1); PG8_SCHED; PG8_LDA(At, 1, 0); PG8_STAGE(PG8_SA(0, 1), a2 + hstep, voffA);
            PG8_WAIT_V(8); PG8_WAIT_L(0); PG8_BAR; PG8_MMA(0, 0, At, B0); PG8_MMA(0, 1, At, B1); PG8_BAR; PG8_SCHED;
            PG8_LDA(At, 1, 1); PG8_STAGE(PG8_SB(1, 0), b3, voffB); PG8_STAGE(PG8_SB(1, 1), b3 + hstep, voffB); PG8_STAGE(PG8_SA(1, 0), a3, voffA);
            PG8_WAIT_V(8); PG8_WAIT_L(0); PG8_BAR; PG8_MMA(1, 0, At, B0); PG8_MMA(1, 1, At, B1); PG8_BAR; PG8_SCHED;
            } else {
            PG8_LDB(B0, 0, 0); PG8_SCHED; PG8_LDA(At, 0, 0); PG8_STAGE(PG8_SA(1, 1), a1 + hstep, voffA);
            PG8_WAIT_L(8); PG8_BAR; PG8_WAIT_L(0); PG8_MMA(0, 0, At, B0); PG8_BAR; PG8_SCHED;
            PG8_LDB(B1, 0, 1); PG8_STAGE(PG8_SB(0, 0), b2, voffB);
            PG8_BAR; PG8_WAIT_L(0); PG8_MMA(0, 1, At, B1); PG8_BAR;
            PG8_LDA(At, 0, 1); PG8_STAGE(PG8_SA(0, 0), a2, voffA);
            PG8_BAR; PG8_WAIT_L(0); PG8_MMA(1, 0, At, B0); PG8_BAR; PG8_SCHED;
            PG8_STAGE(PG8_SB(0, 1), b2 + hstep, voffB);
            PG8_WAIT_V(6); PG8_BAR; PG8_MMA(1, 1, At, B1); PG8_BAR;
            PG8_LDB(B0, 1, 0); PG8_SCHED; PG8_LDA(At, 1, 0); PG8_STAGE(PG8_SA(0, 1), a2 + hstep, voffA);
            PG8_WAIT_L(8); PG8_BAR; PG8_WAIT_L(0); PG8_MMA(0, 0, At, B0); PG8_BAR; PG8_SCHED;
            PG8_LDB(B1, 1, 1); PG8_STAGE(PG8_SB(1, 0), b3, voffB);
            PG8_BAR; PG8_WAIT_L(0); PG8_MMA(0, 1, At, B1); PG8_BAR;
            PG8_LDA(At, 1, 1); PG8_STAGE(PG8_SA(1, 0), a3, voffA);
            PG8_BAR; PG8_WAIT_L(0); PG8_MMA(1, 0, At, B0); PG8_BAR; PG8_SCHED;
            PG8_STAGE(PG8_SB(1, 1), b3 + hstep, voffB);
            PG8_WAIT_V(6); PG8_BAR; PG8_MMA(1, 1, At, B1); PG8_BAR;
            }
        }
        if constexpr (ALIGN_EPI) { if (wr == 0) PG8_BAR; }
        if constexpr (!Epi::AFTER_DRAIN) { E(acc, cur, wr, wc, fr, fq); S.done(cur); }
        if (!has_next) break;
#pragma unroll
        for (int a = 0; a < 2; ++a)
#pragma unroll
            for (int b = 0; b < 2; ++b)
#pragma unroll
                for (int m = 0; m < 4; ++m)
#pragma unroll
                    for (int n = 0; n < 2; ++n) acc[a][b][m][n] = (f32x4){0.f, 0.f, 0.f, 0.f};
        cur = nxt; cA = nA; cB = nB; ++ui;
        if constexpr (ALIGN_EPI) { if (wr == 1) PG8_BAR; }
    }
    PG8_WAIT_V(0);
    if constexpr (!ALIGN_EPI) { if (wr == 0) PG8_BAR; }
    PG8_BAR;
    if constexpr (Epi::AFTER_DRAIN) { E.fused(acc, cur, wr, wc, fr, fq, lds, wid, lane); S.done(cur); }
#undef PG8_SA
#undef PG8_SB
#undef PG8_STAGE
#undef PG8_LDA
#undef PG8_LDB
#undef PG8_MMA
#undef PG8_WAIT_V
#undef PG8_WAIT_L
#undef PG8_BAR
#undef PG8_SCHED
}
}
constexpr int NWAVES = 8;
constexpr int DM = 1024, M_CTX = 4096, M_LAT = 16384, M_ALL = 20480, EVEN_IN = 4608, ODD_IN = 2048;
constexpr size_t MiB = 1u << 20;
constexpr size_t WS_CTL = 0, CTL_ZERO_BYTES = 1 * MiB;
constexpr size_t WS_MODS = 1 * MiB;
constexpr size_t WS_WIE = 2 * MiB, WS_WOE = 11 * MiB, WS_WIO = 13 * MiB, WS_WOO = 17 * MiB, WS_GW = 19 * MiB;
constexpr size_t WS_AGG = 20 * MiB;
constexpr size_t WS_H = 26 * MiB;
constexpr size_t WS_PROJ = 66 * MiB;
constexpr size_t WS_END = 246 * MiB;
constexpr size_t OUT_Y = 0, OUT_HG = 20971520, OUT_K = 23068672, OUT_V = 25165824, OUT_RG = 27262976, OUT_TOTAL = 27295744;
constexpr int CW_TMO = 0, CW_CODE = 1, CW_BAR = 4096, CW_QUEUE = 16384;
constexpr int RING_BYTES = 131072;
constexpr int LDS_BYTES = 162816, MISC_OFF = LDS_BYTES - 512;
constexpr int NPHASE = 12;

#define GAS __attribute__((address_space(1)))
#define LAS __attribute__((address_space(3)))
typedef unsigned short bf16;
typedef unsigned v4u __attribute__((ext_vector_type(4)));
typedef unsigned v2u __attribute__((ext_vector_type(2)));
typedef float f32x4 __attribute__((ext_vector_type(4)));
typedef float f32x16 __attribute__((ext_vector_type(16)));
typedef short bf16x8 __attribute__((ext_vector_type(8)));
typedef short s16x4 __attribute__((ext_vector_type(4)));
typedef GAS unsigned gu32;
#define RLX_AGENT __ATOMIC_RELAXED, __HIP_MEMORY_SCOPE_AGENT
#define LDS_WAIT() asm volatile("s_waitcnt lgkmcnt(0)" ::: "memory")
#define VM_WAIT() asm volatile("s_waitcnt vmcnt(0)" ::: "memory")
__device__ __forceinline__ unsigned f2bf(float f) { unsigned u = __builtin_bit_cast(unsigned, f); return (u + 0x7fffu + ((u >> 16) & 1u)) >> 16; }
__device__ __forceinline__ unsigned pk2(float lo, float hi) { return f2bf(lo) | (f2bf(hi) << 16); }
__device__ __forceinline__ float bf2f(unsigned b) { return __builtin_bit_cast(float, b << 16); }
__device__ __forceinline__ float bflo(unsigned w) { return __builtin_bit_cast(float, w << 16); }
__device__ __forceinline__ float bfhi(unsigned w) { return __builtin_bit_cast(float, w & 0xffff0000u); }
__device__ __forceinline__ float sigmoidf(float x) { return 1.0f / (1.0f + __expf(-x)); }
__device__ __forceinline__ float siluf(float x) { return x / (1.0f + __expf(-x)); }
#define XB_TMO      128
#define XB_XCNT(j)  (256  + 64 * (j))
#define XB_XSUB(j)  (1280 + 64 * (j))
#define XB_XGEN(j)  (2304 + 64 * (j))
#define XB_TOP      3328
#define XB_TOPGEN   3392
#define XCD_BAR_WORDS 3456
#define XB_SPIN_CAP (1u << 18)

__device__ __forceinline__ unsigned xb_ld(unsigned* p)              { return __hip_atomic_load(p, __ATOMIC_RELAXED, __HIP_MEMORY_SCOPE_AGENT); }
__device__ __forceinline__ unsigned xb_add(unsigned* p, unsigned v) { return __hip_atomic_fetch_add(p, v, __ATOMIC_RELAXED, __HIP_MEMORY_SCOPE_AGENT); }
__device__ __forceinline__ unsigned xb_xcc_id() { return (unsigned)__builtin_amdgcn_s_getreg((3 << 11) | 20) & 0xFu; }
#define XB_SPIN(cond, bar) do { unsigned _sp = 0; while (cond) { __builtin_amdgcn_s_sleep(1); \
    if ((++_sp & 255u) == 0u) { if (xb_ld(&(bar)[XB_TMO])) break; if (_sp > XB_SPIN_CAP) { atomicAdd(&(bar)[XB_TMO], 1u); break; } } } } while (0)

struct XcdBarrier {
    unsigned* bar; unsigned x;
    volatile LAS unsigned* st;
};

__device__ __forceinline__ XcdBarrier xcd_barrier_post(unsigned* bar, volatile LAS unsigned* st) {
    XcdBarrier b; b.bar = bar; b.x = xb_xcc_id(); b.st = st;
    if (threadIdx.x == 0) (void)xb_add(&bar[XB_XCNT(b.x)], 1u);
    return b;
}
__device__ __forceinline__ void xcd_barrier_complete(unsigned* bar, unsigned x, unsigned& nloc, unsigned& nx) {
    const unsigned G = gridDim.x * gridDim.y * gridDim.z;
    unsigned sum, cnt, mine, sp = 0u;
    for (;;) {
        sum = 0u; cnt = 0u; mine = 0u;
#pragma unroll
        for (unsigned j = 0; j < 16; ++j) { const unsigned c = xb_ld(&bar[XB_XCNT(j)]); sum += c; cnt += (c > 0u) ? 1u : 0u; mine = (j == x) ? c : mine; }
        if (sum == G) break;
        __builtin_amdgcn_s_sleep(1);
        if ((++sp & 255u) == 0u) { if (xb_ld(&bar[XB_TMO])) break; if (sp > XB_SPIN_CAP) { atomicAdd(&bar[XB_TMO], 1u); break; } }
    }
    nloc = mine > 0u ? mine : 1u; nx = cnt > 0u ? cnt : 1u;
}

__device__ __forceinline__ void xcd_barrier(const XcdBarrier& b) {
    asm volatile("s_waitcnt vmcnt(0)" ::: "memory");
    __syncthreads();
    if (threadIdx.x == 0) {
        unsigned* bar = b.bar;
        __builtin_amdgcn_s_waitcnt(0);
        unsigned nloc = b.st[0], nx = b.st[1];
        if (nloc == 0u) { xcd_barrier_complete(bar, b.x, nloc, nx); b.st[0] = nloc; b.st[1] = nx; }
        const unsigned old = xb_add(&bar[XB_XSUB(b.x)], 1u);
        const unsigned gen = old / nloc;
        if (old + 1u == (gen + 1u) * nloc) {
            __builtin_amdgcn_fence(__ATOMIC_RELEASE, "agent");
            asm volatile("s_waitcnt vmcnt(0)" ::: "memory");
            const unsigned og = xb_add(&bar[XB_TOP], 1u);
            const unsigned tg = og / nx;
            if (og + 1u == (tg + 1u) * nx) xb_add(&bar[XB_TOPGEN], 1u);
            else XB_SPIN(xb_ld(&bar[XB_TOPGEN]) == tg, bar);
            __builtin_amdgcn_fence(__ATOMIC_ACQUIRE, "agent");
            xb_add(&bar[XB_XGEN(b.x)], 1u);
            asm volatile("s_waitcnt vmcnt(0)" ::: "memory");
        } else {
            XB_SPIN(xb_ld(&bar[XB_XGEN(b.x)]) == gen, bar);
            __builtin_amdgcn_fence(__ATOMIC_ACQUIRE, "agent");
            asm volatile("s_waitcnt vmcnt(0)" ::: "memory");
        }
    }
    __syncthreads();
}
struct Frame {
    unsigned char* lds;
    volatile LAS unsigned* MISC;
    gu32* ctl;
    int tid, lane, wave, vcu, G;
    const float* in[24];
    float* out; unsigned char* ws;
};
__device__ __forceinline__ float wave_sum(float v) {
#pragma unroll
    for (int o = 1; o < 64; o <<= 1) v += __shfl_xor(v, o);
    return v;
}
__device__ __forceinline__ void p0_transpose_item(const float* W, int K, int N, bf16* WT, float* scr, int item, int lane) {
    const int nblk = N / 32, kb = item / nblk, nb = item % nblk, k0 = 64 * kb, n0 = 32 * nb;
#pragma unroll 8
    for (int i = 0; i < 32; ++i) { const int kk = 2 * i + (lane >> 5); scr[kk * 33 + (lane & 31)] = W[(size_t)(k0 + kk) * N + n0 + (lane & 31)]; }
    LDS_WAIT(); asm volatile("" ::: "memory");
    const int c = lane & 7;
#pragma unroll
    for (int j = 0; j < 4; ++j) { const int n = (lane >> 3) + 8 * j; const float* s = scr + (8 * c) * 33 + n;
        v4u o; o.x = pk2(s[0 * 33], s[1 * 33]); o.y = pk2(s[2 * 33], s[3 * 33]); o.z = pk2(s[4 * 33], s[5 * 33]); o.w = pk2(s[6 * 33], s[7 * 33]);
        *(v4u*)(WT + (size_t)(n0 + n) * K + k0 + 8 * c) = o; }
    LDS_WAIT(); asm volatile("" ::: "memory");
}
__device__ __forceinline__ void p0_prologue(Frame& F) {
    float* mods = (float*)(F.ws + WS_MODS);
    for (int it = blockIdx.x; it < 96; it += F.G) {
        const int l = it / 48, c0 = (it % 48) * 64;
        float* S = (float*)F.lds;
        for (int idx = F.tid; idx < 9216; idx += NWAVES * 64) { const int n = idx >> 10, k = idx & 1023; const float v = n == 0 ? F.in[7][k] : F.in[6][(n - 1) * 1024 + k]; S[idx] = siluf(v); }
        __syncthreads();
        const float* W = F.in[9] + (size_t)l * 1024 * 3072 + c0 + F.lane;
        float acc[9];
#pragma unroll
        for (int n = 0; n < 9; ++n) acc[n] = 0.f;
        const int k0 = F.wave * 128;
#pragma unroll 4
        for (int kk = 0; kk < 128; ++kk) { const float wv = W[(size_t)(k0 + kk) * 3072];
#pragma unroll
            for (int n = 0; n < 9; ++n) acc[n] += S[n * 1024 + k0 + kk] * wv; }
        float* red = S + 9216;
#pragma unroll
        for (int n = 0; n < 9; ++n) red[(F.wave * 9 + n) * 64 + F.lane] = acc[n];
        __syncthreads();
        for (int idx = F.tid; idx < 576; idx += NWAVES * 64) { const int n = idx >> 6, ln = idx & 63; float s = F.in[10][l * 3072 + c0 + ln];
#pragma unroll
            for (int w = 0; w < 8; ++w) s += red[(w * 9 + n) * 64 + ln];
            mods[(size_t)(l * 9 + n) * 3072 + c0 + ln] = s; }
        __syncthreads();
    }
    float* scr = (float*)(F.lds + F.wave * 16384);
    const int gw = F.vcu * NWAVES + F.wave, NGW = F.G * NWAVES;
    constexpr int I0 = 16 * 144, I1 = 16 * 32, I2 = 16 * 64, I3 = 16 * 32, I4 = 32 * 8;
    for (int it = gw; it < I0 + I1 + I2 + I3 + I4; it += NGW) {
        int r = it;
        if (r < I0) { p0_transpose_item(F.in[11], 1024, 4608, (bf16*)(F.ws + WS_WIE), scr, r, F.lane); continue; } r -= I0;
        if (r < I1) { p0_transpose_item(F.in[12], 1024, 1024, (bf16*)(F.ws + WS_WOE), scr, r, F.lane); continue; } r -= I1;
        if (r < I2) { p0_transpose_item(F.in[16], 1024, 2048, (bf16*)(F.ws + WS_WIO), scr, r, F.lane); continue; } r -= I2;
        if (r < I3) { p0_transpose_item(F.in[17], 1024, 1024, (bf16*)(F.ws + WS_WOO), scr, r, F.lane); continue; } r -= I3;
        const int mat = r >> 3;
        p0_transpose_item(F.in[20] + (size_t)mat * 16384, 128, 128, (bf16*)(F.ws + WS_GW) + (size_t)mat * 16384, scr, r & 7, F.lane);
    }
}
__device__ __forceinline__ void modnorm_rows(Frame& F, int layer, const float* xa, const float* xb) {
    const float* mods = (const float*)(F.ws + WS_MODS) + (size_t)layer * 9 * 3072;
    const float* gain = F.in[8] + layer * 1024;
    bf16* H = (bf16*)(F.ws + WS_H);
    const int gw = F.vcu * NWAVES + F.wave, NGW = F.G * NWAVES;
    for (int m = gw; m < M_ALL; m += NGW) {
        const int n = m < M_CTX ? 0 : 1 + ((m - M_CTX) >> 11);
        const f32x4* xr = (const f32x4*)(m < M_CTX ? xa + (size_t)m * DM : xb + (size_t)(m - M_CTX) * DM) + F.lane;
        const f32x4* sh = (const f32x4*)(mods + (size_t)n * 3072) + F.lane; const f32x4* sc = (const f32x4*)(mods + (size_t)n * 3072 + 1024) + F.lane;
        const f32x4* gp = (const f32x4*)gain + F.lane;
        f32x4 v[4]; float s = 0.f;
#pragma unroll
        for (int j = 0; j < 4; ++j) { v[j] = xr[64 * j]; s += (v[j].x * v[j].x + v[j].y * v[j].y) + (v[j].z * v[j].z + v[j].w * v[j].w); }
        const float rstd = 1.0f / sqrtf(wave_sum(s) * (1.0f / DM) + 1e-6f);
        unsigned long long* o8 = (unsigned long long*)(H + (size_t)m * DM) + F.lane;
#pragma unroll
        for (int j = 0; j < 4; ++j) { const f32x4 g = gp[64 * j], a = sc[64 * j], b = sh[64 * j]; const f32x4 o = v[j] * rstd * g * (1.0f + a) + b;
            o8[64 * j] = (unsigned long long)pk2(o.x, o.y) | ((unsigned long long)pk2(o.z, o.w) << 32); }
    }
}
__device__ __forceinline__ void hgrn_naive_item(Frame& F, int item) {
    const int s = item >> 3, h = (item >> 1) & 3, d = item & 1;
    const bool lat = s >= 16; const int T = lat ? 2048 : 256; const int row0 = lat ? M_CTX + (s - 16) * 2048 : s * 256;
    bf16* P = (bf16*)(F.ws + WS_PROJ);
    float* Lq = (float*)F.lds; float* Lf = Lq + 128; float* Lk = Lf + 128; float* Lv = Lk + 128; float* Lp = Lv + 128;
    const int tid = F.tid, dv = tid & 127, kq = tid >> 7;
    const int zcol = (d == 0 ? 512 : 1024) + h * 128;
    float S[32];
    if (lat) { const float* s0 = F.in[2] + ((size_t)(((s - 16) * 2 + d) * 4 + h)) * 16384;
#pragma unroll
        for (int i = 0; i < 32; ++i) S[i] = s0[(32 * kq + i) * 128 + dv]; }
    else {
#pragma unroll
        for (int i = 0; i < 32; ++i) S[i] = 0.f; }
    float lbv = 0.f;
    if (tid < 128) { const float l0 = F.in[13][(d * 2 + 0) * 512 + h * 128 + tid], l1 = F.in[13][(d * 2 + 1) * 512 + h * 128 + tid]; lbv = 1.0f / (1.0f + __expf(l1 - l0)); }
    __syncthreads();
    for (int tt = 0; tt < T; ++tt) {
        const int tok = d == 0 ? tt : T - 1 - tt; const size_t rb = (size_t)(row0 + tok) * EVEN_IN;
        if (tid < 128) { const float z = bf2f(P[rb + zcol + tid]); const float sg = sigmoidf(z);
            Lf[tid] = lbv + (1.0f - lbv) * sg; Lk[tid] = (1.0f - lbv) * (1.0f - sg); Lq[tid] = bf2f(P[rb + h * 128 + tid]); }
        else if (tid < 256) Lv[tid - 128] = bf2f(P[rb + 1536 + h * 128 + (tid - 128)]);
        __syncthreads();
        const float v = Lv[dv]; float part = 0.f;
#pragma unroll
        for (int i = 0; i < 32; ++i) { const int dk = 32 * kq + i; S[i] = Lf[dk] * S[i] + Lk[dk] * v; part += S[i] * Lq[dk]; }
        Lp[kq * 128 + dv] = part;
        __syncthreads();
        if (tid < 128) { const float o = (Lp[tid] + Lp[128 + tid]) + (Lp[256 + tid] + Lp[384 + tid]); P[rb + zcol + tid] = (bf16)f2bf(o); }
    }
    if (!lat) { float* so = F.out + OUT_HG + ((size_t)((s * 2 + d) * 4 + h)) * 16384;
#pragma unroll
        for (int i = 0; i < 32; ++i) so[(32 * kq + i) * 128 + dv] = S[i]; }
    __syncthreads();
}
__device__ __forceinline__ float dot64_bf(const float* qs, const bf16* kp) {
    float dot = 0.f;
    for (int e = 0; e < 8; ++e) { const v4u w = ((const v4u*)kp)[e]; const float* q = qs + 8 * e;
        dot += (q[0] * bflo(w.x) + q[1] * bfhi(w.x)) + (q[2] * bflo(w.y) + q[3] * bfhi(w.y)) + (q[4] * bflo(w.z) + q[5] * bfhi(w.z)) + (q[6] * bflo(w.w) + q[7] * bfhi(w.w)); }
    return dot;
}
__device__ __forceinline__ void attn_naive_item(Frame& F, int it) {
    const int m = it >> 3, head = it & 7, lane = F.lane;
    bf16* P = (bf16*)(F.ws + WS_PROJ);
    float* qs = (float*)(F.lds + F.wave * 2048); float* ps = qs + 64;
    qs[lane] = bf2f(P[(size_t)m * EVEN_IN + 2560 + head * 64 + lane]);
    LDS_WAIT(); asm volatile("" ::: "memory");
    float sc[6]; int nk;
    const bool lat = m >= M_CTX;
    int b = 0, r = 0, c = 0, rs = 0, wsx = 0;
    if (lat) { b = (m - M_CTX) >> 11; const int t = (m - M_CTX) & 2047; r = t >> 6; c = t & 63; rs = min(max(r - 4, 0), 24); wsx = min(max(c - 8, 0), 48); nk = 6; } else { b = m >> 8; nk = 4; }
#pragma unroll
    for (int i = 0; i < 6; ++i) {
        sc[i] = -1e30f;
        if (i < nk) {
            const int j = lane + 64 * i; float dot = 0.f, bias = 0.f;
            if (lat && i < 2) { const int kr = j >> 4, kc = j & 15; const int tk = (rs + kr) * 64 + wsx + kc;
                dot = dot64_bf(qs, P + (size_t)(M_CTX + b * 2048 + tk) * EVEN_IN + 3072 + head * 64);
                bias = F.in[15][(head * 15 + (rs + kr - r + 7)) * 31 + (wsx + kc - c + 15)]; }
            else if (lat) { const float* kp = F.in[3] + ((size_t)(b * 8 + head) * 256 + (j - 128)) * 64;
                for (int e = 0; e < 16; ++e) { const f32x4 kv = ((const f32x4*)kp)[e]; dot += (qs[4 * e] * kv.x + qs[4 * e + 1] * kv.y) + (qs[4 * e + 2] * kv.z + qs[4 * e + 3] * kv.w); } }
            else dot = dot64_bf(qs, P + (size_t)(b * 256 + j) * EVEN_IN + 3072 + head * 64);
            sc[i] = dot * 0.125f + bias;
        }
    }
    float mx = sc[0];
#pragma unroll
    for (int i = 1; i < 6; ++i) mx = fmaxf(mx, sc[i]);
#pragma unroll
    for (int o = 1; o < 64; o <<= 1) mx = fmaxf(mx, __shfl_xor(mx, o));
    float sum = 0.f;
#pragma unroll
    for (int i = 0; i < 6; ++i) { sc[i] = (i < nk) ? __expf(sc[i] - mx) : 0.f; sum += sc[i]; }
    sum = wave_sum(sum); const float inv = 1.0f / sum;
#pragma unroll
    for (int i = 0; i < 6; ++i) if (i < nk) ps[lane + 64 * i] = sc[i] * inv;
    LDS_WAIT(); asm volatile("" ::: "memory");
    float o = 0.f;
    if (lat) {
        for (int j = 0; j < 128; ++j) { const int kr = j >> 4, kc = j & 15; const int tk = (rs + kr) * 64 + wsx + kc;
            o += ps[j] * bf2f(P[(size_t)(M_CTX + b * 2048 + tk) * EVEN_IN + 3584 + head * 64 + lane]); }
        const float* vp = F.in[4] + ((size_t)(b * 8 + head) * 256) * 64 + lane;
        for (int j = 0; j < 256; ++j) o += ps[128 + j] * vp[(size_t)j * 64];
    } else {
        for (int j = 0; j < 256; ++j) o += ps[j] * bf2f(P[(size_t)(b * 256 + j) * EVEN_IN + 3584 + head * 64 + lane]);
    }
    P[(size_t)m * EVEN_IN + 2560 + head * 64 + lane] = (bf16)f2bf(o);
    LDS_WAIT(); asm volatile("" ::: "memory");
}
constexpr size_t WS_RGF = WS_PROJ + 80 * MiB, WS_RGB = WS_PROJ + 120 * MiB;
__device__ __forceinline__ void rg_naive_item(Frame& F, int item) {
    const int s = item >> 4, hb = (item >> 1) & 7, d = item & 1;
    const bool lat = s >= 16; const int T = lat ? 2048 : 256; const int row0 = lat ? M_CTX + (s - 16) * 2048 : s * 256;
    const bf16* P2 = (const bf16*)(F.ws + WS_PROJ);
    bf16* O = (bf16*)(F.ws + (d == 0 ? WS_RGF : WS_RGB));
    float* XB = (float*)F.lds; float* XC = XB + 19 * 128; float* GG = XC + 16 * 128;
    const int tid = F.tid;
    float hst = 0.f, sp = 0.f;
    if (tid < 128) { if (lat) hst = F.in[5][((s - 16) * 2 + d) * 1024 + hb * 128 + tid]; const float lam = F.in[22][d * 1024 + hb * 128 + tid]; sp = log1pf(__expf(-lam)); }
    for (int k = 0; k < T / 16; ++k) {
        const int tb = d == 0 ? 16 * k : T - 16 * (k + 1);
        for (int idx = tid; idx < 19 * 128; idx += NWAVES * 64) { const int hr = idx >> 7, ch = idx & 127, tok = tb + hr - 2;
            XB[idx] = (tok >= 0 && tok < T) ? bf2f(P2[(size_t)(row0 + tok) * ODD_IN + hb * 128 + ch]) : 0.f; }
        __syncthreads();
        for (int idx = tid; idx < 16 * 128; idx += NWAVES * 64) { const int t = idx >> 7, ch = idx & 127; float a = F.in[19][hb * 128 + ch];
#pragma unroll
            for (int j = 0; j < 4; ++j) a += F.in[18][j * 1024 + hb * 128 + ch] * XB[(t + j) * 128 + ch];
            XC[idx] = a; }
        __syncthreads();
        { const int g = tid >> 8, th = (tid >> 7) & 1, j = tid & 127;
          const float* w = F.in[20] + ((size_t)((d * 2 + g) * 8 + hb) * 128) * 128 + j;
          float acc[8];
#pragma unroll
          for (int t = 0; t < 8; ++t) acc[t] = 0.f;
          for (int i = 0; i < 128; ++i) { const float wv = w[(size_t)i * 128];
#pragma unroll
              for (int t = 0; t < 8; ++t) acc[t] += XC[(th * 8 + t) * 128 + i] * wv; }
          const float gb = F.in[21][(d * 2 + g) * 1024 + hb * 128 + j];
#pragma unroll
          for (int t = 0; t < 8; ++t) GG[(g * 16 + th * 8 + t) * 128 + j] = sigmoidf(acc[t] + gb); }
        __syncthreads();
        if (tid < 128) {
            for (int tt = 0; tt < 16; ++tt) { const int t = d == 0 ? tt : 15 - tt;
                const float rr = GG[t * 128 + tid], ii = GG[(16 + t) * 128 + tid];
                const float la = -8.0f * rr * sp; const float a = __expf(la); const float u = sqrtf(-expm1f(2.0f * la)) * (ii * XC[t * 128 + tid]);
                hst = a * hst + u;
                O[(size_t)(row0 + tb + t) * DM + hb * 128 + tid] = (bf16)f2bf(hst); } }
        __syncthreads();
    }
    if (!lat && tid < 128) F.out[OUT_RG + (s * 2 + d) * 1024 + hb * 128 + tid] = hst;
}
__device__ __forceinline__ void gate_even_rows(Frame& F) {
    const bf16* P = (const bf16*)(F.ws + WS_PROJ); bf16* Y = (bf16*)(F.ws + WS_H);
    const int gw = F.vcu * NWAVES + F.wave, NGW = F.G * NWAVES, lane = F.lane;
    const f32x4 g0 = ((const f32x4*)F.in[14])[lane * 2], g1 = ((const f32x4*)F.in[14])[lane * 2 + 1];
    const float gain[8] = {g0.x, g0.y, g0.z, g0.w, g1.x, g1.y, g1.z, g1.w};
    for (int m = gw; m < M_ALL; m += NGW) {
        const bf16* pr = P + (size_t)m * EVEN_IN + lane * 8;
        const v4u wf = *(const v4u*)(pr + 512), wb = *(const v4u*)(pr + 1024), wga = *(const v4u*)(pr + 2048), wo = *(const v4u*)(pr + 2560), wgb = *(const v4u*)(pr + 4096);
        float o[8], ga[8], ob[8], gb[8];
#pragma unroll
        for (int e = 0; e < 4; ++e) { o[2 * e] = bflo(wf[e]) + bflo(wb[e]); o[2 * e + 1] = bfhi(wf[e]) + bfhi(wb[e]); ga[2 * e] = bflo(wga[e]); ga[2 * e + 1] = bfhi(wga[e]);
            ob[2 * e] = bflo(wo[e]); ob[2 * e + 1] = bfhi(wo[e]); gb[2 * e] = bflo(wgb[e]); gb[2 * e + 1] = bfhi(wgb[e]); }
        float ss = 0.f;
#pragma unroll
        for (int e = 0; e < 8; ++e) ss += o[e] * o[e];
        ss += __shfl_xor(ss, 1); ss += __shfl_xor(ss, 2); ss += __shfl_xor(ss, 4); ss += __shfl_xor(ss, 8);
        const float rstd = 1.0f / sqrtf(ss * (1.0f / 128.0f) + 1e-6f);
        float ya[8], yb[8];
#pragma unroll
        for (int e = 0; e < 8; ++e) { ya[e] = o[e] * rstd * gain[e] * siluf(ga[e]); yb[e] = ob[e] * siluf(gb[e]); }
        v4u wa, wbo;
#pragma unroll
        for (int e = 0; e < 4; ++e) { wa[e] = pk2(ya[2 * e], ya[2 * e + 1]); wbo[e] = pk2(yb[2 * e], yb[2 * e + 1]); }
        bf16* yr = Y + (size_t)m * DM + lane * 8;
        *(v4u*)yr = wa; *(v4u*)(yr + 512) = wbo;
    }
}
__device__ __forceinline__ void rg_combine_rows(Frame& F) {
    const bf16* P2 = (const bf16*)(F.ws + WS_PROJ); const bf16* OF = (const bf16*)(F.ws + WS_RGF); const bf16* OB = (const bf16*)(F.ws + WS_RGB); bf16* Y = (bf16*)(F.ws + WS_H);
    const int gw = F.vcu * NWAVES + F.wave, NGW = F.G * NWAVES, lane = F.lane;
    for (int m = gw; m < M_ALL; m += NGW) {
#pragma unroll
        for (int part = 0; part < 2; ++part) { const int c0 = part * 512 + lane * 8;
            const v4u a = *(const v4u*)(OF + (size_t)m * DM + c0), b = *(const v4u*)(OB + (size_t)m * DM + c0), g = *(const v4u*)(P2 + (size_t)m * ODD_IN + 1024 + c0);
            v4u w;
#pragma unroll
            for (int e = 0; e < 4; ++e) w[e] = pk2((bflo(a[e]) + bflo(b[e])) * siluf(bflo(g[e])), (bfhi(a[e]) + bfhi(b[e])) * siluf(bfhi(g[e])));
            *(v4u*)(Y + (size_t)m * DM + c0) = w; }
    }
}
__device__ __forceinline__ void final_norm_rows(Frame& F) {
    const int gw = F.vcu * NWAVES + F.wave, NGW = F.G * NWAVES;
    const f32x4* gp = (const f32x4*)F.in[23] + F.lane;
    for (int m = gw; m < M_ALL; m += NGW) {
        f32x4* xr = (f32x4*)(F.out + (size_t)m * DM) + F.lane;
        f32x4 v[4]; float s = 0.f;
#pragma unroll
        for (int j = 0; j < 4; ++j) { v[j] = xr[64 * j]; s += (v[j].x * v[j].x + v[j].y * v[j].y) + (v[j].z * v[j].z + v[j].w * v[j].w); }
        const float rstd = 1.0f / sqrtf(wave_sum(s) * (1.0f / DM) + 1e-6f);
#pragma unroll
        for (int j = 0; j < 4; ++j) xr[64 * j] = v[j] * rstd * gp[64 * j];
    }
}
typedef float f32x2_t __attribute__((ext_vector_type(2))); typedef __bf16 bf16x2_t __attribute__((ext_vector_type(2)));
__device__ __forceinline__ unsigned cvtpk(float lo, float hi) { f32x2_t v = {lo, hi}; bf16x2_t b = __builtin_convertvector(v, bf16x2_t); return __builtin_bit_cast(unsigned, b); }
#define MFMA32(a, b, c) __builtin_amdgcn_mfma_f32_32x32x16_bf16((a), (b), (c), 0, 0, 0)
template <int ST> __device__ __forceinline__ bf16x8 pack8(const f32x16& x) {
    v4u p; p.x = cvtpk(x[8 * ST], x[8 * ST + 1]); p.y = cvtpk(x[8 * ST + 2], x[8 * ST + 3]); p.z = cvtpk(x[8 * ST + 4], x[8 * ST + 5]); p.w = cvtpk(x[8 * ST + 6], x[8 * ST + 7]);
    return __builtin_bit_cast(bf16x8, p);
}
__device__ __forceinline__ bf16x8 cat4(s16x4 lo, s16x4 hi) { return __builtin_shufflevector(lo, hi, 0, 1, 2, 3, 4, 5, 6, 7); }
constexpr int HG_QD = 0, HG_KI = 8704, HG_KDT = 17408, HG_VT = 27648, HG_DEC = 37888, HG_BUF = 38400;
__device__ __forceinline__ void hgrn_mfma_item(Frame& F, int item) {
    const int s = item >> 3, h = (item >> 1) & 3, d = item & 1;
    const bool lat = s >= 16; const int T = lat ? 2048 : 256; const int row0 = lat ? M_CTX + (s - 16) * 2048 : s * 256; const int nch = T / 32;
    bf16* P = (bf16*)(F.ws + WS_PROJ);
    LAS unsigned char* L = (LAS unsigned char*)F.lds;
    const int zcol = (d == 0 ? 512 : 1024) + h * 128;
    const int lane = F.lane, r = lane & 31, hh = lane >> 5;
    if (F.wave >= 4) {
        const int pw = F.wave - 4, dk = 32 * pw + r;
        const float l0 = F.in[13][(d * 2 + 0) * 512 + h * 128 + dk], l1 = F.in[13][(d * 2 + 1) * 512 + h * 128 + dk];
        const float lbv = 1.0f / (1.0f + __expf(l1 - l0)), omlb = 1.0f - lbv;
        unsigned short zr[16], qr[16], vr[16];
#define HG_LOAD(n) do { _Pragma("unroll") for (int ii = 0; ii < 16; ++ii) { const int i = 16 * hh + ii; const int tok = d == 0 ? 32 * (n) + i : T - 1 - (32 * (n) + i); \
            const bf16* pr = P + (size_t)(row0 + tok) * EVEN_IN; zr[ii] = pr[zcol + dk]; qr[ii] = pr[h * 128 + dk]; vr[ii] = pr[1536 + h * 128 + dk]; } } while (0)
        HG_LOAD(0);
        for (int n = 0; n <= nch; ++n) {
            if (n < nch) {
                LAS unsigned char* B = L + (n & 1) * HG_BUF;
                float lf[16], kk[16]; float tot = 0.f;
#pragma unroll
                for (int ii = 0; ii < 16; ++ii) { const float z = bf2f(zr[ii]); const float sg = sigmoidf(z); const float f = lbv + omlb * sg; lf[ii] = __logf(f); kk[ii] = omlb * (1.0f - sg); tot += lf[ii]; }
                const float other = __shfl_xor(tot, 32);
                const float bend = tot + other; float b = hh ? other : 0.f;
                unsigned kd[8], vv[8];
#pragma unroll
                for (int ii = 0; ii < 16; ++ii) { b += lf[ii]; const int i = 16 * hh + ii;
                    const float qd = bf2f(qr[ii]) * __expf(b), ki = kk[ii] * __expf(-b), kdv = kk[ii] * __expf(bend - b);
                    *(LAS unsigned short*)(B + HG_QD + i * 272 + dk * 2) = (unsigned short)f2bf(qd);
                    *(LAS unsigned short*)(B + HG_KI + i * 272 + dk * 2) = (unsigned short)f2bf(ki);
                    if (ii & 1) { kd[ii >> 1] |= f2bf(kdv) << 16; vv[ii >> 1] |= (unsigned)vr[ii] << 16; } else { kd[ii >> 1] = f2bf(kdv); vv[ii >> 1] = vr[ii]; } }
                *(LAS v4u*)(B + HG_KDT + dk * 80 + hh * 32) = (v4u){kd[0], kd[1], kd[2], kd[3]}; *(LAS v4u*)(B + HG_KDT + dk * 80 + hh * 32 + 16) = (v4u){kd[4], kd[5], kd[6], kd[7]};
                *(LAS v4u*)(B + HG_VT + dk * 80 + hh * 32) = (v4u){vv[0], vv[1], vv[2], vv[3]}; *(LAS v4u*)(B + HG_VT + dk * 80 + hh * 32 + 16) = (v4u){vv[4], vv[5], vv[6], vv[7]};
                if (hh == 0) *(LAS float*)(B + HG_DEC + dk * 4) = __expf(bend);
                if (n + 1 < nch) HG_LOAD(n + 1);
            }
            __syncthreads();
        }
#undef HG_LOAD
    } else {
        const int w = F.wave, dvc = 32 * w + r;
        f32x16 S[4];
        if (lat) { const float* s0 = F.in[2] + ((size_t)(((s - 16) * 2 + d) * 4 + h)) * 16384;
#pragma unroll
            for (int i = 0; i < 4; ++i)
#pragma unroll
                for (int g = 0; g < 16; ++g) S[i][g] = s0[(32 * i + (g & 3) + 8 * (g >> 2) + 4 * hh) * 128 + dvc]; }
        else {
#pragma unroll
            for (int i = 0; i < 4; ++i)
#pragma unroll
                for (int g = 0; g < 16; ++g) S[i][g] = 0.f; }
        __syncthreads();
        for (int n = 0; n < nch; ++n) {
            LAS unsigned char* B = L + (n & 1) * HG_BUF;
            f32x16 X;
#pragma unroll
            for (int g = 0; g < 16; ++g) X[g] = 0.f;
#pragma unroll
            for (int st = 0; st < 8; ++st) { const bf16x8 a = *(LAS bf16x8*)(B + HG_KI + r * 272 + (16 * st + 8 * hh) * 2), b = *(LAS bf16x8*)(B + HG_QD + r * 272 + (16 * st + 8 * hh) * 2); X = MFMA32(a, b, X); }
#pragma unroll
            for (int g = 0; g < 16; ++g) { const int sr = (g & 3) + 8 * (g >> 2) + 4 * hh; X[g] = sr <= r ? X[g] : 0.f; }
            const bf16x8 xa0 = pack8<0>(X), xa1 = pack8<1>(X);
            f32x16 O;
#pragma unroll
            for (int g = 0; g < 16; ++g) O[g] = 0.f;
            { const LAS unsigned char* vt = B + HG_VT + dvc * 80 + 8 * hh;
              O = MFMA32(xa0, cat4(*(const LAS s16x4*)(vt), *(const LAS s16x4*)(vt + 16)), O);
              O = MFMA32(xa1, cat4(*(const LAS s16x4*)(vt + 32), *(const LAS s16x4*)(vt + 48)), O); }
#pragma unroll
            for (int i = 0; i < 4; ++i) { const LAS unsigned char* qd = B + HG_QD + r * 272 + (32 * i) * 2 + 8 * hh;
                O = MFMA32(cat4(*(const LAS s16x4*)(qd), *(const LAS s16x4*)(qd + 16)), pack8<0>(S[i]), O);
                O = MFMA32(cat4(*(const LAS s16x4*)(qd + 32), *(const LAS s16x4*)(qd + 48)), pack8<1>(S[i]), O); }
#pragma unroll
            for (int g = 0; g < 16; ++g) { const int t = (g & 3) + 8 * (g >> 2) + 4 * hh; const int tok = d == 0 ? 32 * n + t : T - 1 - (32 * n + t);
                P[(size_t)(row0 + tok) * EVEN_IN + zcol + dvc] = (bf16)f2bf(O[g]); }
#pragma unroll
            for (int i = 0; i < 4; ++i) {
#pragma unroll
                for (int g = 0; g < 16; ++g) S[i][g] *= *(const LAS float*)(B + HG_DEC + (32 * i + (g & 3) + 8 * (g >> 2) + 4 * hh) * 4);
#pragma unroll
                for (int st = 0; st < 2; ++st) { const bf16x8 a = *(const LAS bf16x8*)(B + HG_KDT + (32 * i + r) * 80 + (16 * st + 8 * hh) * 2), b = *(const LAS bf16x8*)(B + HG_VT + dvc * 80 + (16 * st + 8 * hh) * 2); S[i] = MFMA32(a, b, S[i]); } }
            __syncthreads();
        }
        if (!lat) { float* so = F.out + OUT_HG + ((size_t)((s * 2 + d) * 4 + h)) * 16384;
#pragma unroll
            for (int i = 0; i < 4; ++i)
#pragma unroll
                for (int g = 0; g < 16; ++g) so[(32 * i + (g & 3) + 8 * (g >> 2) + 4 * hh) * 128 + dvc] = S[i][g]; }
    }
}
#define MFMA16(a, b, c) __builtin_amdgcn_mfma_f32_16x16x32_bf16((a), (b), (c), 0, 0, 0)
typedef short v4i16_t __attribute__((ext_vector_type(4)));
__device__ __forceinline__ s16x4 vtr(const LAS unsigned char* p) { return __builtin_bit_cast(s16x4, __builtin_amdgcn_ds_read_tr16_b64_v4i16((LAS v4i16_t*)p)); }
__device__ __forceinline__ bf16x8 pack44(const f32x4& a, const f32x4& b) { v4u p; p.x = cvtpk(a[0], a[1]); p.y = cvtpk(a[2], a[3]); p.z = cvtpk(b[0], b[1]); p.w = cvtpk(b[2], b[3]); return __builtin_bit_cast(bf16x8, p); }
constexpr int AT_VL = 0, AT_KC = 73728, AT_VC = AT_KC + 36864, AT_BT = AT_VC + 32768, AT_END = AT_BT + 2048;
static_assert(AT_END <= MISC_OFF, "attention LDS map");
template <bool LOCAL> __device__ __forceinline__ void attn_mfma_item(Frame& F, int item) {
    LAS unsigned char* L = (LAS unsigned char*)F.lds;
    bf16* P = (bf16*)(F.ws + WS_PROJ);
    const int tid = F.tid, lane = F.lane, fr = lane & 15, fq = lane >> 4, w = F.wave;
    int b, head, rp = 0, half = 0, rs0 = 0;
    if (LOCAL) { b = item >> 7; head = (item >> 4) & 7; rp = item & 15; rs0 = min(max(2 * rp - 4, 0), 24); }
    else { b = item >> 4; head = (item >> 1) & 7; half = item & 1; }
    if (LOCAL) {
        const int nrows = min(9, 32 - rs0);
        for (int c = tid; c < nrows * 512; c += NWAVES * 64) { const int key = c >> 3, ch = c & 7;
            *(LAS v4u*)(L + AT_VL + key * 128 + ch * 16) = *(const v4u*)(P + (size_t)(M_CTX + b * 2048 + rs0 * 64 + key) * EVEN_IN + 3584 + head * 64 + ch * 8); }
        const float* kc = F.in[3] + (size_t)(b * 8 + head) * 16384; const float* vc = F.in[4] + (size_t)(b * 8 + head) * 16384;
        for (int c = tid; c < 2048; c += NWAVES * 64) { const int key = c >> 3, ch = c & 7;
            const f32x4 a0 = *(const f32x4*)(kc + key * 64 + ch * 8), a1 = *(const f32x4*)(kc + key * 64 + ch * 8 + 4);
            *(LAS v4u*)(L + AT_KC + key * 144 + ch * 16) = (v4u){pk2(a0.x, a0.y), pk2(a0.z, a0.w), pk2(a1.x, a1.y), pk2(a1.z, a1.w)};
            const f32x4 b0 = *(const f32x4*)(vc + key * 64 + ch * 8), b1 = *(const f32x4*)(vc + key * 64 + ch * 8 + 4);
            *(LAS v4u*)(L + AT_VC + key * 128 + ch * 16) = (v4u){pk2(b0.x, b0.y), pk2(b0.z, b0.w), pk2(b1.x, b1.y), pk2(b1.z, b1.w)}; }
        for (int i = tid; i < 465; i += NWAVES * 64) ((LAS float*)(L + AT_BT))[i] = F.in[15][head * 465 + i];
    } else {
        for (int c = tid; c < 2048; c += NWAVES * 64) { const int key = c >> 3, ch = c & 7; const bf16* pr = P + (size_t)(b * 256 + key) * EVEN_IN + head * 64 + ch * 8;
            *(LAS v4u*)(L + AT_KC + key * 144 + ch * 16) = *(const v4u*)(pr + 3072); *(LAS v4u*)(L + AT_VC + key * 128 + ch * 16) = *(const v4u*)(pr + 3584); }
    }
    const int ri = w >> 2, jb = w & 3, r = 2 * rp + ri;
    const int qbase = LOCAL ? M_CTX + b * 2048 + r * 64 + 16 * jb : b * 256 + half * 128 + 16 * w;
    const bf16* qp = P + (size_t)(qbase + fr) * EVEN_IN + 2560 + head * 64 + 8 * fq;
    const bf16x8 qf0 = *(const bf16x8*)qp, qf1 = *(const bf16x8*)(qp + 32);
    __syncthreads();
    const int trow = fr >> 2, tcol = (fr & 3) * 8;
    f32x4 O1[4];
#pragma unroll
    for (int dt = 0; dt < 4; ++dt) O1[dt] = (f32x4){0.f, 0.f, 0.f, 0.f};
    float mx1 = -1e30f, l1 = 0.f;
    {
        f32x4 sc[16];
#pragma unroll
        for (int kt = 0; kt < 16; ++kt) { const LAS unsigned char* kp = L + AT_KC + (16 * kt + fr) * 144 + 16 * fq;
            f32x4 acc = {0.f, 0.f, 0.f, 0.f}; acc = MFMA16(*(const LAS bf16x8*)kp, qf0, acc); acc = MFMA16(*(const LAS bf16x8*)(kp + 64), qf1, acc);
            acc = acc * 0.125f; sc[kt] = acc; mx1 = fmaxf(fmaxf(mx1, fmaxf(acc[0], acc[1])), fmaxf(acc[2], acc[3])); }
        mx1 = fmaxf(mx1, __shfl_xor(mx1, 16)); mx1 = fmaxf(mx1, __shfl_xor(mx1, 32));
#pragma unroll
        for (int kt = 0; kt < 16; ++kt)
#pragma unroll
            for (int e = 0; e < 4; ++e) { const float p = __expf(sc[kt][e] - mx1); sc[kt][e] = p; l1 += p; }
        l1 += __shfl_xor(l1, 16); l1 += __shfl_xor(l1, 32);
#pragma unroll
        for (int c = 0; c < 8; ++c) { const bf16x8 pa = pack44(sc[2 * c], sc[2 * c + 1]);
            const LAS unsigned char* v0 = L + AT_VC + (32 * c + 4 * fq + trow) * 128 + tcol;
#pragma unroll
            for (int dt = 0; dt < 4; ++dt) O1[dt] = MFMA16(pa, cat4(vtr(v0 + dt * 32), vtr(v0 + 16 * 128 + dt * 32)), O1[dt]); }
    }
    float f1 = 1.0f / l1, f2 = 0.f;
    f32x4 O2[4];
#pragma unroll
    for (int dt = 0; dt < 4; ++dt) O2[dt] = (f32x4){0.f, 0.f, 0.f, 0.f};
    if (LOCAL) {
        const int rs = min(max(r - 4, 0), 24), band = jb == 0 ? 0 : (jb == 1 ? 8 : (jb == 2 ? 24 : 32));
        const int qc = 16 * jb + fr, wsx = min(max(qc - 8, 0), 48);
        f32x4 sl[16]; float mx2 = -1e30f, l2 = 0.f;
#pragma unroll
        for (int kr = 0; kr < 8; ++kr)
#pragma unroll
            for (int hf = 0; hf < 2; ++hf) { const int tok = (rs + kr) * 64 + band + 16 * hf + fr;
                const bf16* kp = P + (size_t)(M_CTX + b * 2048 + tok) * EVEN_IN + 3072 + head * 64 + 8 * fq;
                f32x4 acc = {0.f, 0.f, 0.f, 0.f}; acc = MFMA16(*(const bf16x8*)kp, qf0, acc); acc = MFMA16(*(const bf16x8*)(kp + 32), qf1, acc);
                const LAS float* bt = (const LAS float*)(L + AT_BT) + (rs + kr - r + 7) * 31;
#pragma unroll
                for (int e = 0; e < 4; ++e) { const int kc = band + 16 * hf + 4 * fq + e; const bool valid = kc >= wsx && kc < wsx + 16;
                    const float bias = bt[min(max(kc - qc + 15, 0), 30)];
                    acc[e] = valid ? acc[e] * 0.125f + bias : -1e30f; mx2 = fmaxf(mx2, acc[e]); }
                sl[kr * 2 + hf] = acc; }
        mx2 = fmaxf(mx2, __shfl_xor(mx2, 16)); mx2 = fmaxf(mx2, __shfl_xor(mx2, 32));
#pragma unroll
        for (int kt = 0; kt < 16; ++kt)
#pragma unroll
            for (int e = 0; e < 4; ++e) { const float p = __expf(sl[kt][e] - mx2); sl[kt][e] = p; l2 += p; }
        l2 += __shfl_xor(l2, 16); l2 += __shfl_xor(l2, 32);
#pragma unroll
        for (int kr = 0; kr < 8; ++kr) { const bf16x8 pa = pack44(sl[2 * kr], sl[2 * kr + 1]);
            const LAS unsigned char* v0 = L + AT_VL + ((rs + kr - rs0) * 64 + band + 4 * fq + trow) * 128 + tcol;
#pragma unroll
            for (int dt = 0; dt < 4; ++dt) O2[dt] = MFMA16(pa, cat4(vtr(v0 + dt * 32), vtr(v0 + 16 * 128 + dt * 32)), O2[dt]); }
        const float m = fmaxf(mx1, mx2), a1 = __expf(mx1 - m), a2 = __expf(mx2 - m), linv = 1.0f / (l1 * a1 + l2 * a2);
        f1 = a1 * linv; f2 = a2 * linv;
    }
#pragma unroll
    for (int e = 0; e < 4; ++e) { const float g1 = __shfl(f1, 4 * fq + e), g2 = __shfl(f2, 4 * fq + e);
        bf16* op = P + (size_t)(qbase + 4 * fq + e) * EVEN_IN + 2560 + head * 64 + fr;
#pragma unroll
        for (int dt = 0; dt < 4; ++dt) op[16 * dt] = (bf16)f2bf(O1[dt][e] * g1 + O2[dt][e] * g2); }
    __syncthreads();
}
struct Args { const float* in[24]; float* out; unsigned char* ws; int ph_lo, ph_hi; };
__global__ void __launch_bounds__(NWAVES * 64, 2) mega_fwd(Args args) {
    extern __shared__ __attribute__((aligned(16))) unsigned char lds[];
    Frame F;
    F.lds = lds;
    F.MISC = (volatile LAS unsigned*)((LAS unsigned char*)lds + MISC_OFF);
    F.tid = threadIdx.x; F.lane = F.tid & 63; F.wave = __builtin_amdgcn_readfirstlane(F.tid >> 6);
    F.G = gridDim.x; { const int bx = blockIdx.x; F.vcu = (F.G % 8 == 0) ? (bx % 8) * (F.G / 8) + bx / 8 : bx; }
    F.ws = args.ws; F.out = args.out; F.ctl = (gu32*)(args.ws + WS_CTL);
#pragma unroll
    for (int i = 0; i < 24; ++i) F.in[i] = args.in[i];
    for (int u = F.tid; u < (LDS_BYTES - MISC_OFF) / 4; u += NWAVES * 64) ((LAS unsigned*)((LAS unsigned char*)lds + MISC_OFF))[u] = 0u;
    __syncthreads();
    const int lo = args.ph_lo, hi = args.ph_hi;
    const bool one = (lo == 0 && hi == NPHASE);
    XcdBarrier bar; bar.bar = (unsigned*)(F.ctl + CW_BAR); bar.x = 0; bar.st = nullptr;
    if (one) bar = xcd_barrier_post((unsigned*)(F.ctl + CW_BAR), F.MISC + 8);
#define IN(k) (lo <= (k) && (k) < hi)
#define GRID_BAR(k) do { if (IN(k) && IN((k) + 1)) xcd_barrier(bar); } while (0)
    LAS unsigned char* ring = (LAS unsigned char*)lds;

    if (IN(0)) { p0_prologue(F); GRID_BAR(0); }
    if (IN(1)) { modnorm_rows(F, 0, F.in[0], F.in[1]); GRID_BAR(1); }
    if (IN(2)) {
        pg8::Gemm g{(const bf16*)(F.ws + WS_H), (const bf16*)(F.ws + WS_WIE), M_ALL, EVEN_IN, DM}; pg8::StaticOrder S; S.init(M_ALL, EVEN_IN, F.G, (int)blockIdx.x);
        pg8::EpiProj E{(bf16*)(F.ws + WS_PROJ), EVEN_IN, F.out + OUT_K};
        pg8::gemm_phase<pg8::EpiProj, pg8::StaticOrder, true, true>(ring, g, S, E);
        GRID_BAR(2);
    }
    if (IN(3)) {
        for (;;) {
            if (F.tid == 0) F.MISC[16] = __hip_atomic_fetch_add((unsigned*)(F.ctl + CW_QUEUE), 1u, __ATOMIC_RELAXED, __HIP_MEMORY_SCOPE_AGENT);
            __syncthreads();
            const int qi = (int)F.MISC[16];
            __syncthreads();
            if (qi >= 64 + 1024 + 128 + 256) break;
            if (qi < 64) hgrn_mfma_item(F, 128 + qi);
            else if (qi < 64 + 1024) attn_mfma_item<true>(F, qi - 64);
            else if (qi < 64 + 1024 + 128) hgrn_mfma_item(F, qi - (64 + 1024));
            else attn_mfma_item<false>(F, qi - (64 + 1024 + 128));
        }
        GRID_BAR(3);
    }
    if (IN(4)) { gate_even_rows(F); GRID_BAR(4); }
    if (IN(5)) {
        pg8::Gemm g{(const bf16*)(F.ws + WS_H), (const bf16*)(F.ws + WS_WOE), M_ALL, DM, DM}; pg8::StaticOrder S; S.init(M_ALL, DM, F.G, (int)blockIdx.x);
        pg8::EpiRes E{F.in[0], F.in[1], F.out, (const float*)(F.ws + WS_MODS) + 2048};
        pg8::gemm_phase<pg8::EpiRes, pg8::StaticOrder, true, true>(ring, g, S, E);
        GRID_BAR(5);
    }
    if (IN(6)) { modnorm_rows(F, 1, F.out, F.out + (size_t)M_CTX * DM); GRID_BAR(6); }
    if (IN(7)) {
        pg8::Gemm g{(const bf16*)(F.ws + WS_H), (const bf16*)(F.ws + WS_WIO), M_ALL, ODD_IN, DM}; pg8::StaticOrder S; S.init(M_ALL, ODD_IN, F.G, (int)blockIdx.x);
        pg8::EpiProj E{(bf16*)(F.ws + WS_PROJ), ODD_IN, nullptr};
        pg8::gemm_phase<pg8::EpiProj, pg8::StaticOrder, true, true>(ring, g, S, E);
        GRID_BAR(7);
    }
    if (IN(8)) { for (int it = blockIdx.x; it < 384; it += F.G) rg_naive_item(F, 383 - it); GRID_BAR(8); }
    if (IN(9)) { rg_combine_rows(F); GRID_BAR(9); }
    if (IN(10)) {
        pg8::Gemm g{(const bf16*)(F.ws + WS_H), (const bf16*)(F.ws + WS_WOO), M_ALL, DM, DM}; pg8::StaticOrder S; S.init(M_ALL, DM, F.G, (int)blockIdx.x);
        pg8::EpiRes E{F.out, F.out + (size_t)M_CTX * DM, F.out, (const float*)(F.ws + WS_MODS) + 9 * 3072 + 2048};
        pg8::gemm_phase<pg8::EpiRes, pg8::StaticOrder, true, true>(ring, g, S, E);
        GRID_BAR(10);
    }
    if (IN(11)) { final_norm_rows(F); }

#undef IN
#undef GRID_BAR
}

extern "C" void kernel_launch(void* const* d_in, const int* in_sizes, int n_in, void* d_out, int out_size, void* d_ws, size_t ws_size, hipStream_t stream) {
    static int grid = 0;
    if (grid == 0) {
        if (n_in != 24 || out_size != (int)OUT_TOTAL || ws_size < WS_END) { fprintf(stderr, "kernel_launch: unexpected shapes (n_in %d out %d ws %zu)\n", n_in, out_size, ws_size); grid = -1; return; }
        int dev = 0, cus = 0, per_cu = 0;
        if (hipGetDevice(&dev) != hipSuccess || hipDeviceGetAttribute(&cus, hipDeviceAttributeMultiprocessorCount, dev) != hipSuccess) { grid = -1; return; }
        if (hipFuncSetAttribute((const void*)mega_fwd, hipFuncAttributeMaxDynamicSharedMemorySize, LDS_BYTES) != hipSuccess) { fprintf(stderr, "kernel_launch: hipFuncSetAttribute failed\n"); grid = -1; return; }
        if (hipOccupancyMaxActiveBlocksPerMultiprocessor(&per_cu, (const void*)mega_fwd, NWAVES * 64, LDS_BYTES) != hipSuccess || per_cu < 1) { fprintf(stderr, "kernel_launch: occupancy query says %d\n", per_cu); }
        (void)hipGetLastError();
        grid = cus;
    }
    if (grid < 0) return;
    (void)hipMemsetAsync((char*)d_ws + WS_CTL, 0, CTL_ZERO_BYTES, stream);
    Args a{};
    for (int i = 0; i < 24; ++i) a.in[i] = (const float*)d_in[i];
    a.out = (float*)d_out; a.ws = (unsigned char*)d_ws;
#if defined(MK_PER_PHASE)
    for (int p = 0; p < NPHASE; ++p) { a.ph_lo = p; a.ph_hi = p + 1; hipLaunchKernelGGL(mega_fwd, dim3(grid), dim3(NWAVES * 64), LDS_BYTES, stream, a); }
#else
    a.ph_lo = 0; a.ph_hi = NPHASE;
    hipLaunchKernelGGL(mega_fwd, dim3(grid), dim3(NWAVES * 64), LDS_BYTES, stream, a);
#endif
}
```

```cpp
#include <hip/hip_runtime.h>
#include <cstdio>
#include <cstdint>
namespace pg8 {
#define PG8_LAS __attribute__((address_space(3)))
typedef unsigned short bf16_t;
typedef short bf16x8 __attribute__((ext_vector_type(8)));
typedef float f32x4 __attribute__((ext_vector_type(4)));
typedef unsigned u32x4 __attribute__((ext_vector_type(4)));
constexpr int BM = 256, BK = 64, HALF = 128, HTB = HALF * BK * 2  , STAGE_BYTES = 8 * HTB, NXCD = 8, WGM = 8;

__host__ __device__ __forceinline__ int lds_byte(int r, int c) { const int st = (r >> 4) * 2 + (c >> 5), rr = r & 15, cc = c & 31, ob = rr * 64 + cc * 2; return st * 1024 + (ob ^ (((ob >> 9) & 1) << 5)); }
__host__ __device__ __forceinline__ void stage_rc(int b, int& R, int& C) { const int st = b / 1024, sb = b % 1024, swz = sb ^ (((sb >> 9) & 1) << 5); R = (st >> 1) * 16 + swz / 64; C = (st & 1) * 32 + (swz % 64) / 2; }
__host__ __device__ __forceinline__ int perm32(int rho) { const int n = rho >> 4, i = rho & 15; return 8 * (i >> 2) + 4 * n + (i & 3); }

struct Unit { int pm, pn; };
struct Gemm { const bf16_t* A; const bf16_t* Bt; int M, N, K; };

struct StaticOrder {
    int nM, nN, nwg, G, c;
    __host__ __device__ void init(int M, int N, int G_, int c_) { nM = M / BM; nN = N / BM; nwg = nM * nN; G = G_; c = c_; }
    __host__ __device__ bool next(int i, Unit& u) const {
        const long L = (long)i * G + c; if (L >= nwg) return false;
        int wgid = (int)L; { const int q = nwg / NXCD, r = nwg % NXCD, xcd = wgid % NXCD, off = wgid / NXCD; wgid = (xcd < r ? xcd * (q + 1) : r * (q + 1) + (xcd - r) * q) + off; }
        const int nig = WGM * nN, gid = wgid / nig, fm = gid * WGM, gsz = (nM - fm) < WGM ? (nM - fm) : WGM;
        u.pm = fm + ((wgid % nig) % gsz); u.pn = (wgid % nig) / gsz; return true;
    }
    __device__ __forceinline__ void a_ready(const Unit&) const {}
    __device__ __forceinline__ void done(const Unit&) const {}
};

__device__ __forceinline__ unsigned cvt_pk_bf16(float lo, float hi) { unsigned r; asm volatile("v_cvt_pk_bf16_f32 %0, %1, %2" : "=v"(r) : "v"(lo), "v"(hi)); return r; }
typedef float f32x2 __attribute__((ext_vector_type(2)));
struct EpiProj {
    static constexpr bool PERM = true, AFTER_DRAIN = false;
    bf16_t* O; int ldc; float* kv;
    __device__ __forceinline__ void operator()(const f32x4 (&acc)[2][2][4][2], const Unit& u, int wr, int wc, int fr, int fq) const {
        const int row0 = u.pm * BM + wr * 64 + fr; const int col0 = u.pn * BM + wc * 32 + 8 * fq;
        const bool dokv = (kv != nullptr) && u.pm < 16 && u.pn >= 12 && u.pn < 16;
#pragma unroll
        for (int ai = 0; ai < 2; ++ai)
#pragma unroll
            for (int m = 0; m < 4; ++m) { bf16_t* rowp = O + (size_t)(row0 + ai * HALF + m * 16) * ldc + col0;
#pragma unroll
                for (int bj = 0; bj < 2; ++bj) { const f32x4 v0 = acc[ai][bj][m][0], v1 = acc[ai][bj][m][1];
                    u32x4 w; w.x = cvt_pk_bf16(v0[0], v0[1]); w.y = cvt_pk_bf16(v0[2], v0[3]); w.z = cvt_pk_bf16(v1[0], v1[1]); w.w = cvt_pk_bf16(v1[2], v1[3]);
                    *(u32x4*)(rowp + bj * HALF) = w;
                    if (dokv) { const int cc = col0 + bj * HALF - 3072, which = cc >> 9, c2 = cc & 511, head = c2 >> 6, d = c2 & 63, t = wr * 64 + fr + ai * HALF + m * 16;
                        float* p = kv + (size_t)which * 2097152 + ((size_t)(u.pm * 8 + head) * 256 + t) * 64 + d; *(f32x4*)p = v0; *(f32x4*)(p + 4) = v1; } } }
    }
};
struct EpiRes {
    static constexpr bool PERM = false, AFTER_DRAIN = false;
    const float* base0; const float* base1; float* out; const float* gate;
    __device__ __forceinline__ void operator()(const f32x4 (&acc)[2][2][4][2], const Unit& u, int wr, int wc, int fr, int fq) const {
        const int nidx = u.pm < 16 ? 0 : 1 + ((u.pm - 16) >> 3);
        const float* gp = gate + (size_t)nidx * 3072;
        const int col0 = u.pn * BM + wc * 32 + 4 * fq;
        f32x4 gv[2][2];
#pragma unroll
        for (int bj = 0; bj < 2; ++bj)
#pragma unroll
            for (int n = 0; n < 2; ++n) gv[bj][n] = *(const f32x4*)(gp + col0 + bj * HALF + n * 16);
#pragma unroll
        for (int ai = 0; ai < 2; ++ai)
#pragma unroll
            for (int m = 0; m < 4; ++m) { const int row = u.pm * BM + ai * HALF + wr * 64 + m * 16 + fr;
                const float* bp = (row < 4096 ? base0 + (size_t)row * 1024 : base1 + (size_t)(row - 4096) * 1024) + col0;
                float* op = out + (size_t)row * 1024 + col0;
#pragma unroll
                for (int bj = 0; bj < 2; ++bj)
#pragma unroll
                    for (int n = 0; n < 2; ++n) { const f32x4 b = *(const f32x4*)(bp + bj * HALF + n * 16); *(f32x4*)(op + bj * HALF + n * 16) = b + gv[bj][n] * acc[ai][bj][m][n]; } }
    }
};
template <class Epi, class Sched, bool ALIGN_EPI = false, bool SP2 = false>
__device__ __forceinline__ void gemm_phase(PG8_LAS unsigned char* lds, const Gemm g, const Sched& S, const Epi& E) {
    const int tid = threadIdx.x, wid = __builtin_amdgcn_readfirstlane(tid >> 6), lane = tid & 63, wr = wid >> 2, wc = wid & 3, fr = lane & 15, fq = lane >> 4;
    const int K = g.K, nt = K / BK;
    unsigned voffA[2], voffB[2];
#pragma unroll
    for (int i = 0; i < 2; ++i) { int R, C; stage_rc(tid * 16 + i * 8192, R, C); const int Rb = Epi::PERM ? ((R & ~31) + perm32(R & 31)) : R;
        voffA[i] = (unsigned)(R * K + C) * 2u; voffB[i] = (unsigned)(Rb * K + C) * 2u; }
    const size_t kstep = (size_t)(BK * 2);
    const size_t hstep = (size_t)HALF * K * 2;
    const size_t tstep = 2 * hstep;
    const unsigned ldsw = (unsigned)wid * 1024u;
    const int aoff = lds_byte(wr * 64 + fr, fq * 8), boff = lds_byte(wc * 32 + fr, fq * 8);
#define PG8_SA(b, h) (((b) * 2 + (h)) * HTB)
#define PG8_SB(b, h) ((4 + (b) * 2 + (h)) * HTB)
#define PG8_STAGE(bufoff, gbase, voff) do { _Pragma("unroll") for (int _i = 0; _i < 2; ++_i) \
        __builtin_amdgcn_global_load_lds((const unsigned*)((const char*)(gbase) + (voff)[_i]), (PG8_LAS unsigned*)(lds + (bufoff) + ldsw + _i * 8192), 16, 0, 0); } while (0)
#define PG8_LDA(dst, b, h) do { _Pragma("unroll") for (int m = 0; m < 4; ++m) _Pragma("unroll") for (int k = 0; k < 2; ++k) dst[m][k] = *(const PG8_LAS bf16x8*)(lds + PG8_SA(b, h) + aoff + m * 2048 + k * 1024); } while (0)
#define PG8_LDB(dst, b, h) do { _Pragma("unroll") for (int n = 0; n < 2; ++n) _Pragma("unroll") for (int k = 0; k < 2; ++k) dst[n][k] = *(const PG8_LAS bf16x8*)(lds + PG8_SB(b, h) + boff + n * 2048 + k * 1024); } while (0)
#define PG8_MMA(ai, bj, At, Bt) do { __builtin_amdgcn_s_setprio(1); _Pragma("unroll") for (int m = 0; m < 4; ++m) _Pragma("unroll") for (int n = 0; n < 2; ++n) _Pragma("unroll") for (int k = 0; k < 2; ++k) \
        acc[ai][bj][m][n] = __builtin_amdgcn_mfma_f32_16x16x32_bf16(Bt[n][k], At[m][k], acc[ai][bj][m][n], 0, 0, 0); __builtin_amdgcn_s_setprio(0); } while (0)
#define PG8_WAIT_V(n) asm volatile("s_waitcnt vmcnt(" #n ")" ::: "memory")
#define PG8_WAIT_L(n) asm volatile("s_waitcnt lgkmcnt(" #n ")" ::: "memory")
#define PG8_BAR __builtin_amdgcn_s_barrier()
#define PG8_SCHED __builtin_amdgcn_sched_barrier(0)
    Unit cur, nxt; int ui = 0;
    if (!S.next(0, cur)) return;
    f32x4 acc[2][2][4][2];
#pragma unroll
    for (int a = 0; a < 2; ++a)
#pragma unroll
        for (int b = 0; b < 2; ++b)
#pragma unroll
            for (int m = 0; m < 4; ++m)
#pragma unroll
                for (int n = 0; n < 2; ++n) acc[a][b][m][n] = (f32x4){0.f, 0.f, 0.f, 0.f};
    bf16x8 At[4][2], B0[2][2], B1[2][2];
    const char* cA = (const char*)g.A + (size_t)cur.pm * tstep; const char* cB = (const char*)g.Bt + (size_t)cur.pn * tstep;
    S.a_ready(cur);
    if constexpr (SP2) {
        PG8_STAGE(PG8_SB(0, 0), cB, voffB); PG8_STAGE(PG8_SB(0, 1), cB + hstep, voffB); PG8_STAGE(PG8_SA(0, 0), cA, voffA); PG8_STAGE(PG8_SA(0, 1), cA + hstep, voffA);
        if (wr == 1) PG8_BAR;
        PG8_WAIT_V(2); PG8_BAR;
        PG8_STAGE(PG8_SB(1, 0), cB + kstep, voffB); PG8_STAGE(PG8_SA(1, 0), cA + kstep, voffA); PG8_STAGE(PG8_SB(1, 1), cB + hstep + kstep, voffB);
        PG8_WAIT_V(6); PG8_BAR;
    } else {
        PG8_STAGE(PG8_SB(0, 0), cB, voffB); PG8_STAGE(PG8_SA(0, 0), cA, voffA); PG8_STAGE(PG8_SB(0, 1), cB + hstep, voffB); PG8_STAGE(PG8_SA(0, 1), cA + hstep, voffA);
        if (wr == 1) PG8_BAR;
        PG8_WAIT_V(4); PG8_BAR;
        PG8_STAGE(PG8_SB(1, 0), cB + kstep, voffB); PG8_STAGE(PG8_SA(1, 0), cA + kstep, voffA); PG8_STAGE(PG8_SB(1, 1), cB + hstep + kstep, voffB);
        PG8_WAIT_V(6); PG8_BAR;
    }
    for (;;) {
        const bool has_next = S.next(ui + 1, nxt);
        const char* nA = has_next ? (const char*)g.A + (size_t)nxt.pm * tstep : cA; const char* nB = has_next ? (const char*)g.Bt + (size_t)nxt.pn * tstep : cB;
        for (int t = 0; t < nt; t += 2) {
            const bool last = (t == nt - 2);
            const char* a1 = cA + (size_t)(t + 1) * kstep;
            const char* a2 = last ? nA : cA + (size_t)(t + 2) * kstep; const char* b2 = last ? nB : cB + (size_t)(t + 2) * kstep;
            const char* a3 = a2 + kstep; const char* b3 = b2 + kstep;
            if (last && has_next) S.a_ready(nxt);
            if constexpr (SP2) {
            PG8_LDB(B0, 0, 0); PG8_LDB(B1, 0, 1); PG8_SCHED; PG8_LDA(At, 0, 0); PG8_STAGE(PG8_SA(1, 1), a1 + hstep, voffA);
            PG8_WAIT_V(8); PG8_WAIT_L(0); PG8_BAR; PG8_MMA(0, 0, At, B0); PG8_MMA(0, 1, At, B1); PG8_BAR; PG8_SCHED;
            PG8_LDA(At, 0, 1); PG8_STAGE(PG8_SB(0, 0), b2, voffB); PG8_STAGE(PG8_SB(0, 1), b2 + hstep, voffB); PG8_STAGE(PG8_SA(0, 0), a2, voffA);
            PG8_WAIT_V(8); PG8_WAIT_L(0); PG8_BAR; PG8_MMA(1, 0, At, B0); PG8_MMA(1, 1, At, B1); PG8_BAR; PG8_SCHED;
            PG8_LDB(B0, 1, 0); PG8_LDB(B1, 1, 1); PG8_SCHED; PG8_LDA(At, 1, 0); PG8_STAGE(PG8_SA(0, 1), a2 + hstep, voffA);
            PG8_WAIT_V(8); PG8_WAIT_L(0); PG8_BAR; PG8_MMA(0, 0, At, B0); PG8_MMA(0, 1, At, B1); PG8_BAR; PG8_SCHED;
            PG8_LDA(At, 1, 1); PG8_STAGE(PG8_SB(1, 0), b3, voffB); PG8_STAGE(PG8_SB(1, 1), b3 + hstep, voffB); PG8_STAGE(PG8_SA(1, 0), a3, voffA);
            PG8_WAIT_V(8); PG8_WAIT_L(0); PG8_BAR; PG8_MMA(1, 0, At, B0); PG8_MMA(1, 1, At, B1); PG8_BAR; PG8_SCHED;
            } else {
            PG8_LDB(B0, 0, 0); PG8_SCHED; PG8_LDA(At, 0, 0); PG8_STAGE(PG8_SA(1, 1), a1 + hstep, voffA);
            PG8_WAIT_L(8); PG8_BAR; PG8_WAIT_L(0); PG8_MMA(0, 0, At, B0); PG8_BAR; PG8_SCHED;
            PG8_LDB(B1, 0, 1); PG8_STAGE(PG8_SB(0, 0), b2, voffB);
            PG8_BAR; PG8_WAIT_L(0); PG8_MMA(0, 1, At, B1); PG8_BAR;
            PG8_LDA(At, 0, 1); PG8_STAGE(PG8_SA(0, 0), a2, voffA);
            PG8_BAR; PG8_WAIT_L(0); PG8_MMA(1, 0, At, B0); PG8_BAR; PG8_SCHED;
            PG8_STAGE(PG8_SB(0, 1), b2 + hstep, voffB);
            PG8_WAIT_V(6); PG8_BAR; PG8_MMA(1, 1, At, B1); PG8_BAR;
            PG8_LDB(B0, 1, 0); PG8_SCHED; PG8_LDA(At, 1, 0); PG8_STAGE(PG8_SA(0, 1), a2 + hstep, voffA);
            PG8_WAIT_L(8); PG8_BAR; PG8_WAIT_L(0); PG8_MMA(0, 0, At, B0); PG8_BAR; PG8_SCHED;
            PG8_LDB(B1, 1, 1); PG8_STAGE(PG8_SB(1, 0), b3, voffB);
            PG8_BAR; PG8_WAIT_L(0); PG8_MMA(0, 1, At, B1); PG8_BAR;
            PG8_LDA(At, 1, 1); PG8_STAGE(PG8_SA(1, 0), a3, voffA);
            PG8_BAR; PG8_WAIT_L(0); PG8_MMA(1, 0, At, B0); PG8_BAR; PG8_SCHED;
            PG8_STAGE(PG8_SB(1, 1), b3 + hstep, voffB);
            PG8_WAIT_V(6); PG8_BAR; PG8_MMA(1, 1, At, B1); PG8_BAR;
            }
        }
        if constexpr (ALIGN_EPI) { if (wr == 0) PG8_BAR; }
        if constexpr (!Epi::AFTER_DRAIN) { E(acc, cur, wr, wc, fr, fq); S.done(cur); }
        if (!has_next) break;
#pragma unroll
        for (int a = 0; a < 2; ++a)
#pragma unroll
            for (int b = 0; b < 2; ++b)
#pragma unroll
                for (int m = 0; m < 4; ++m)
#pragma unroll
                    for (int n = 0; n < 2; ++n) acc[a][b][m][n] = (f32x4){0.f, 0.f, 0.f, 0.f};
        cur = nxt; cA = nA; cB = nB; ++ui;
        if constexpr (ALIGN_EPI) { if (wr == 1) PG8_BAR; }
    }
    PG8_WAIT_V(0);
    if constexpr (!ALIGN_EPI) { if (wr == 0) PG8_BAR; }
    PG8_BAR;
    if constexpr (Epi::AFTER_DRAIN) { E.fused(acc, cur, wr, wc, fr, fq, lds, wid, lane); S.done(cur); }
#undef PG8_SA
#undef PG8_SB
#undef PG8_STAGE
#undef PG8_LDA
#undef PG8_LDB
#undef PG8_MMA
#undef PG8_WAIT_V
#undef PG8_WAIT_L
#undef PG8_BAR
#undef PG8_SCHED
}
}
constexpr int NWAVES = 8;
constexpr int DM = 1024, M_CTX = 4096, M_LAT = 16384, M_ALL = 20480, EVEN_IN = 4608, ODD_IN = 2048;
constexpr size_t MiB = 1u << 20;
constexpr size_t WS_CTL = 0, CTL_ZERO_BYTES = 1 * MiB;
constexpr size_t WS_MODS = 1 * MiB;
constexpr size_t WS_WIE = 2 * MiB, WS_WOE = 11 * MiB, WS_WIO = 13 * MiB, WS_WOO = 17 * MiB, WS_GW = 19 * MiB;
constexpr size_t WS_AGG = 20 * MiB;
constexpr size_t WS_H = 26 * MiB;
constexpr size_t WS_PROJ = 66 * MiB;
constexpr size_t WS_END = 246 * MiB;
constexpr size_t OUT_Y = 0, OUT_HG = 20971520, OUT_K = 23068672, OUT_V = 25165824, OUT_RG = 27262976, OUT_TOTAL = 27295744;
constexpr int CW_TMO = 0, CW_CODE = 1, CW_BAR = 4096, CW_QUEUE = 16384;
constexpr int RING_BYTES = 131072;
constexpr int LDS_BYTES = 162816, MISC_OFF = LDS_BYTES - 512;
constexpr int NPHASE = 12;

#define GAS __attribute__((address_space(1)))
#define LAS __attribute__((address_space(3)))
typedef unsigned short bf16;
typedef unsigned v4u __attribute__((ext_vector_type(4)));
typedef unsigned v2u __attribute__((ext_vector_type(2)));
typedef float f32x4 __attribute__((ext_vector_type(4)));
typedef float f32x16 __attribute__((ext_vector_type(16)));
typedef short bf16x8 __attribute__((ext_vector_type(8)));
typedef short s16x4 __attribute__((ext_vector_type(4)));
typedef GAS unsigned gu32;
#define RLX_AGENT __ATOMIC_RELAXED, __HIP_MEMORY_SCOPE_AGENT
#define LDS_WAIT() asm volatile("s_waitcnt lgkmcnt(0)" ::: "memory")
#define VM_WAIT() asm volatile("s_waitcnt vmcnt(0)" ::: "memory")
__device__ __forceinline__ unsigned f2bf(float f) { unsigned u = __builtin_bit_cast(unsigned, f); return (u + 0x7fffu + ((u >> 16) & 1u)) >> 16; }
__device__ __forceinline__ unsigned pk2(float lo, float hi) { return f2bf(lo) | (f2bf(hi) << 16); }
__device__ __forceinline__ float bf2f(unsigned b) { return __builtin_bit_cast(float, b << 16); }
__device__ __forceinline__ float bflo(unsigned w) { return __builtin_bit_cast(float, w << 16); }
__device__ __forceinline__ float bfhi(unsigned w) { return __builtin_bit_cast(float, w & 0xffff0000u); }
__device__ __forceinline__ float sigmoidf(float x) { return 1.0f / (1.0f + __expf(-x)); }
__device__ __forceinline__ float siluf(float x) { return x / (1.0f + __expf(-x)); }
#define XB_TMO      128
#define XB_XCNT(j)  (256  + 64 * (j))
#define XB_XSUB(j)  (1280 + 64 * (j))
#define XB_XGEN(j)  (2304 + 64 * (j))
#define XB_TOP      3328
#define XB_TOPGEN   3392
#define XCD_BAR_WORDS 3456
#define XB_SPIN_CAP (1u << 18)

__device__ __forceinline__ unsigned xb_ld(unsigned* p)              { return __hip_atomic_load(p, __ATOMIC_RELAXED, __HIP_MEMORY_SCOPE_AGENT); }
__device__ __forceinline__ unsigned xb_add(unsigned* p, unsigned v) { return __hip_atomic_fetch_add(p, v, __ATOMIC_RELAXED, __HIP_MEMORY_SCOPE_AGENT); }
__device__ __forceinline__ unsigned xb_xcc_id() { return (unsigned)__builtin_amdgcn_s_getreg((3 << 11) | 20) & 0xFu; }
#define XB_SPIN(cond, bar) do { unsigned _sp = 0; while (cond) { __builtin_amdgcn_s_sleep(1); \
    if ((++_sp & 255u) == 0u) { if (xb_ld(&(bar)[XB_TMO])) break; if (_sp > XB_SPIN_CAP) { atomicAdd(&(bar)[XB_TMO], 1u); break; } } } } while (0)

struct XcdBarrier {
    unsigned* bar; unsigned x;
    volatile LAS unsigned* st;
};

__device__ __forceinline__ XcdBarrier xcd_barrier_post(unsigned* bar, volatile LAS unsigned* st) {
    XcdBarrier b; b.bar = bar; b.x = xb_xcc_id(); b.st = st;
    if (threadIdx.x == 0) (void)xb_add(&bar[XB_XCNT(b.x)], 1u);
    return b;
}
__device__ __forceinline__ void xcd_barrier_complete(unsigned* bar, unsigned x, unsigned& nloc, unsigned& nx) {
    const unsigned G = gridDim.x * gridDim.y * gridDim.z;
    unsigned sum, cnt, mine, sp = 0u;
    for (;;) {
        sum = 0u; cnt = 0u; mine = 0u;
#pragma unroll
        for (unsigned j = 0; j < 16; ++j) { const unsigned c = xb_ld(&bar[XB_XCNT(j)]); sum += c; cnt += (c > 0u) ? 1u : 0u; mine = (j == x) ? c : mine; }
        if (sum == G) break;
        __builtin_amdgcn_s_sleep(1);
        if ((++sp & 255u) == 0u) { if (xb_ld(&bar[XB_TMO])) break; if (sp > XB_SPIN_CAP) { atomicAdd(&bar[XB_TMO], 1u); break; } }
    }
    nloc = mine > 0u ? mine : 1u; nx = cnt > 0u ? cnt : 1u;
}

__device__ __forceinline__ void xcd_barrier(const XcdBarrier& b) {
    asm volatile("s_waitcnt vmcnt(0)" ::: "memory");
    __syncthreads();
    if (threadIdx.x == 0) {
        unsigned* bar = b.bar;
        __builtin_amdgcn_s_waitcnt(0);
        unsigned nloc = b.st[0], nx = b.st[1];
        if (nloc == 0u) { xcd_barrier_complete(bar, b.x, nloc, nx); b.st[0] = nloc; b.st[1] = nx; }
        const unsigned old = xb_add(&bar[XB_XSUB(b.x)], 1u);
        const unsigned gen = old / nloc;
        if (old + 1u == (gen + 1u) * nloc) {
            __builtin_amdgcn_fence(__ATOMIC_RELEASE, "agent");
            asm volatile("s_waitcnt vmcnt(0)" ::: "memory");
            const unsigned og = xb_add(&bar[XB_TOP], 1u);
            const unsigned tg = og / nx;
            if (og + 1u == (tg + 1u) * nx) xb_add(&bar[XB_TOPGEN], 1u);
            else XB_SPIN(xb_ld(&bar[XB_TOPGEN]) == tg, bar);
            __builtin_amdgcn_fence(__ATOMIC_ACQUIRE, "agent");
            xb_add(&bar[XB_XGEN(b.x)], 1u);
            asm volatile("s_waitcnt vmcnt(0)" ::: "memory");
        } else {
            XB_SPIN(xb_ld(&bar[XB_XGEN(b.x)]) == gen, bar);
            __builtin_amdgcn_fence(__ATOMIC_ACQUIRE, "agent");
            asm volatile("s_waitcnt vmcnt(0)" ::: "memory");
        }
    }
    __syncthreads();
}
struct Frame {
    unsigned char* lds;
    volatile LAS unsigned* MISC;
    gu32* ctl;
    int tid, lane, wave, vcu, G;
    const float* in[24];
    float* out; unsigned char* ws;
};
__device__ __forceinline__ float wave_sum(float v) {
#pragma unroll
    for (int o = 1; o < 64; o <<= 1) v += __shfl_xor(v, o);
    return v;
}
__device__ __forceinline__ void p0_transpose_item(const float* W, int K, int N, bf16* WT, float* scr, int item, int lane) {
    const int nblk = N / 32, kb = item / nblk, nb = item % nblk, k0 = 64 * kb, n0 = 32 * nb;
#pragma unroll 8
    for (int i = 0; i < 32; ++i) { const int kk = 2 * i + (lane >> 5); scr[kk * 33 + (lane & 31)] = W[(size_t)(k0 + kk) * N + n0 + (lane & 31)]; }
    LDS_WAIT(); asm volatile("" ::: "memory");
    const int c = lane & 7;
#pragma unroll
    for (int j = 0; j < 4; ++j) { const int n = (lane >> 3) + 8 * j; const float* s = scr + (8 * c) * 33 + n;
        v4u o; o.x = pk2(s[0 * 33], s[1 * 33]); o.y = pk2(s[2 * 33], s[3 * 33]); o.z = pk2(s[4 * 33], s[5 * 33]); o.w = pk2(s[6 * 33], s[7 * 33]);
        *(v4u*)(WT + (size_t)(n0 + n) * K + k0 + 8 * c) = o; }
    LDS_WAIT(); asm volatile("" ::: "memory");
}
__device__ __forceinline__ void p0_prologue(Frame& F) {
    float* mods = (float*)(F.ws + WS_MODS);
    for (int it = blockIdx.x; it < 96; it += F.G) {
        const int l = it / 48, c0 = (it % 48) * 64;
        float* S = (float*)F.lds;
        for (int idx = F.tid; idx < 9216; idx += NWAVES * 64) { const int n = idx >> 10, k = idx & 1023; const float v = n == 0 ? F.in[7][k] : F.in[6][(n - 1) * 1024 + k]; S[idx] = siluf(v); }
        __syncthreads();
        const float* W = F.in[9] + (size_t)l * 1024 * 3072 + c0 + F.lane;
        float acc[9];
#pragma unroll
        for (int n = 0; n < 9; ++n) acc[n] = 0.f;
        const int k0 = F.wave * 128;
#pragma unroll 4
        for (int kk = 0; kk < 128; ++kk) { const float wv = W[(size_t)(k0 + kk) * 3072];
#pragma unroll
            for (int n = 0; n < 9; ++n) acc[n] += S[n * 1024 + k0 + kk] * wv; }
        float* red = S + 9216;
#pragma unroll
        for (int n = 0; n < 9; ++n) red[(F.wave * 9 + n) * 64 + F.lane] = acc[n];
        __syncthreads();
        for (int idx = F.tid; idx < 576; idx += NWAVES * 64) { const int n = idx >> 6, ln = idx & 63; float s = F.in[10][l * 3072 + c0 + ln];
#pragma unroll
            for (int w = 0; w < 8; ++w) s += red[(w * 9 + n) * 64 + ln];
            mods[(size_t)(l * 9 + n) * 3072 + c0 + ln] = s; }
        __syncthreads();
    }
    float* scr = (float*)(F.lds + F.wave * 16384);
    const int gw = F.vcu * NWAVES + F.wave, NGW = F.G * NWAVES;
    constexpr int I0 = 16 * 144, I1 = 16 * 32, I2 = 16 * 64, I3 = 16 * 32, I4 = 32 * 8;
    for (int it = gw; it < I0 + I1 + I2 + I3 + I4; it += NGW) {
        int r = it;
        if (r < I0) { p0_transpose_item(F.in[11], 1024, 4608, (bf16*)(F.ws + WS_WIE), scr, r, F.lane); continue; } r -= I0;
        if (r < I1) { p0_transpose_item(F.in[12], 1024, 1024, (bf16*)(F.ws + WS_WOE), scr, r, F.lane); continue; } r -= I1;
        if (r < I2) { p0_transpose_item(F.in[16], 1024, 2048, (bf16*)(F.ws + WS_WIO), scr, r, F.lane); continue; } r -= I2;
        if (r < I3) { p0_transpose_item(F.in[17], 1024, 1024, (bf16*)(F.ws + WS_WOO), scr, r, F.lane); continue; } r -= I3;
        const int mat = r >> 3;
        p0_transpose_item(F.in[20] + (size_t)mat * 16384, 128, 128, (bf16*)(F.ws + WS_GW) + (size_t)mat * 16384, scr, r & 7, F.lane);
    }
}
__device__ __forceinline__ void modnorm_rows(Frame& F, int layer, const float* xa, const float* xb) {
    const float* mods = (const float*)(F.ws + WS_MODS) + (size_t)layer * 9 * 3072;
    const float* gain = F.in[8] + layer * 1024;
    bf16* H = (bf16*)(F.ws + WS_H);
    const int gw = F.vcu * NWAVES + F.wave, NGW = F.G * NWAVES;
    for (int m = gw; m < M_ALL; m += NGW) {
        const int n = m < M_CTX ? 0 : 1 + ((m - M_CTX) >> 11);
        const f32x4* xr = (const f32x4*)(m < M_CTX ? xa + (size_t)m * DM : xb + (size_t)(m - M_CTX) * DM) + F.lane;
        const f32x4* sh = (const f32x4*)(mods + (size_t)n * 3072) + F.lane; const f32x4* sc = (const f32x4*)(mods + (size_t)n * 3072 + 1024) + F.lane;
        const f32x4* gp = (const f32x4*)gain + F.lane;
        f32x4 v[4]; float s = 0.f;
#pragma unroll
        for (int j = 0; j < 4; ++j) { v[j] = xr[64 * j]; s += (v[j].x * v[j].x + v[j].y * v[j].y) + (v[j].z * v[j].z + v[j].w * v[j].w); }
        const float rstd = 1.0f / sqrtf(wave_sum(s) * (1.0f / DM) + 1e-6f);
        unsigned long long* o8 = (unsigned long long*)(H + (size_t)m * DM) + F.lane;
#pragma unroll
        for (int j = 0; j < 4; ++j) { const f32x4 g = gp[64 * j], a = sc[64 * j], b = sh[64 * j]; const f32x4 o = v[j] * rstd * g * (1.0f + a) + b;
            o8[64 * j] = (unsigned long long)pk2(o.x, o.y) | ((unsigned long long)pk2(o.z, o.w) << 32); }
    }
}
__device__ __forceinline__ void hgrn_naive_item(Frame& F, int item) {
    const int s = item >> 3, h = (item >> 1) & 3, d = item & 1;
    const bool lat = s >= 16; const int T = lat ? 2048 : 256; const int row0 = lat ? M_CTX + (s - 16) * 2048 : s * 256;
    bf16* P = (bf16*)(F.ws + WS_PROJ);
    float* Lq = (float*)F.lds; float* Lf = Lq + 128; float* Lk = Lf + 128; float* Lv = Lk + 128; float* Lp = Lv + 128;
    const int tid = F.tid, dv = tid & 127, kq = tid >> 7;
    const int zcol = (d == 0 ? 512 : 1024) + h * 128;
    float S[32];
    if (lat) { const float* s0 = F.in[2] + ((size_t)(((s - 16) * 2 + d) * 4 + h)) * 16384;
#pragma unroll
        for (int i = 0; i < 32; ++i) S[i] = s0[(32 * kq + i) * 128 + dv]; }
    else {
#pragma unroll
        for (int i = 0; i < 32; ++i) S[i] = 0.f; }
    float lbv = 0.f;
    if (tid < 128) { const float l0 = F.in[13][(d * 2 + 0) * 512 + h * 128 + tid], l1 = F.in[13][(d * 2 + 1) * 512 + h * 128 + tid]; lbv = 1.0f / (1.0f + __expf(l1 - l0)); }
    __syncthreads();
    for (int tt = 0; tt < T; ++tt) {
        const int tok = d == 0 ? tt : T - 1 - tt; const size_t rb = (size_t)(row0 + tok) * EVEN_IN;
        if (tid < 128) { const float z = bf2f(P[rb + zcol + tid]); const float sg = sigmoidf(z);
            Lf[tid] = lbv + (1.0f - lbv) * sg; Lk[tid] = (1.0f - lbv) * (1.0f - sg); Lq[tid] = bf2f(P[rb + h * 128 + tid]); }
        else if (tid < 256) Lv[tid - 128] = bf2f(P[rb + 1536 + h * 128 + (tid - 128)]);
        __syncthreads();
        const float v = Lv[dv]; float part = 0.f;
#pragma unroll
        for (int i = 0; i < 32; ++i) { const int dk = 32 * kq + i; S[i] = Lf[dk] * S[i] + Lk[dk] * v; part += S[i] * Lq[dk]; }
        Lp[kq * 128 + dv] = part;
        __syncthreads();
        if (tid < 128) { const float o = (Lp[tid] + Lp[128 + tid]) + (Lp[256 + tid] + Lp[384 + tid]); P[rb + zcol + tid] = (bf16)f2bf(o); }
    }
    if (!lat) { float* so = F.out + OUT_HG + ((size_t)((s * 2 + d) * 4 + h)) * 16384;
#pragma unroll
        for (int i = 0; i < 32; ++i) so[(32 * kq + i) * 128 + dv] = S[i]; }
    __syncthreads();
}
__device__ __forceinline__ float dot64_bf(const float* qs, const bf16* kp) {
    float dot = 0.f;
    for (int e = 0; e < 8; ++e) { const v4u w = ((const v4u*)kp)[e]; const float* q = qs + 8 * e;
        dot += (q[0] * bflo(w.x) + q[1] * bfhi(w.x)) + (q[2] * bflo(w.y) + q[3] * bfhi(w.y)) + (q[4] * bflo(w.z) + q[5] * bfhi(w.z)) + (q[6] * bflo(w.w) + q[7] * bfhi(w.w)); }
    return dot;
}
__device__ __forceinline__ void attn_naive_item(Frame& F, int it) {
    const int m = it >> 3, head = it & 7, lane = F.lane;
    bf16* P = (bf16*)(F.ws + WS_PROJ);
    float* qs = (float*)(F.lds + F.wave * 2048); float* ps = qs + 64;
    qs[lane] = bf2f(P[(size_t)m * EVEN_IN + 2560 + head * 64 + lane]);
    LDS_WAIT(); asm volatile("" ::: "memory");
    float sc[6]; int nk;
    const bool lat = m >= M_CTX;
    int b = 0, r = 0, c = 0, rs = 0, wsx = 0;
    if (lat) { b = (m - M_CTX) >> 11; const int t = (m - M_CTX) & 2047; r = t >> 6; c = t & 63; rs = min(max(r - 4, 0), 24); wsx = min(max(c - 8, 0), 48); nk = 6; } else { b = m >> 8; nk = 4; }
#pragma unroll
    for (int i = 0; i < 6; ++i) {
        sc[i] = -1e30f;
        if (i < nk) {
            const int j = lane + 64 * i; float dot = 0.f, bias = 0.f;
            if (lat && i < 2) { const int kr = j >> 4, kc = j & 15; const int tk = (rs + kr) * 64 + wsx + kc;
                dot = dot64_bf(qs, P + (size_t)(M_CTX + b * 2048 + tk) * EVEN_IN + 3072 + head * 64);
                bias = F.in[15][(head * 15 + (rs + kr - r + 7)) * 31 + (wsx + kc - c + 15)]; }
            else if (lat) { const float* kp = F.in[3] + ((size_t)(b * 8 + head) * 256 + (j - 128)) * 64;
                for (int e = 0; e < 16; ++e) { const f32x4 kv = ((const f32x4*)kp)[e]; dot += (qs[4 * e] * kv.x + qs[4 * e + 1] * kv.y) + (qs[4 * e + 2] * kv.z + qs[4 * e + 3] * kv.w); } }
            else dot = dot64_bf(qs, P + (size_t)(b * 256 + j) * EVEN_IN + 3072 + head * 64);
            sc[i] = dot * 0.125f + bias;
        }
    }
    float mx = sc[0];
#pragma unroll
    for (int i = 1; i < 6; ++i) mx = fmaxf(mx, sc[i]);
#pragma unroll
    for (int o = 1; o < 64; o <<= 1) mx = fmaxf(mx, __shfl_xor(mx, o));
    float sum = 0.f;
#pragma unroll
    for (int i = 0; i < 6; ++i) { sc[i] = (i < nk) ? __expf(sc[i] - mx) : 0.f; sum += sc[i]; }
    sum = wave_sum(sum); const float inv = 1.0f / sum;
#pragma unroll
    for (int i = 0; i < 6; ++i) if (i < nk) ps[lane + 64 * i] = sc[i] * inv;
    LDS_WAIT(); asm volatile("" ::: "memory");
    float o = 0.f;
    if (lat) {
        for (int j = 0; j < 128; ++j) { const int kr = j >> 4, kc = j & 15; const int tk = (rs + kr) * 64 + wsx + kc;
            o += ps[j] * bf2f(P[(size_t)(M_CTX + b * 2048 + tk) * EVEN_IN + 3584 + head * 64 + lane]); }
        const float* vp = F.in[4] + ((size_t)(b * 8 + head) * 256) * 64 + lane;
        for (int j = 0; j < 256; ++j) o += ps[128 + j] * vp[(size_t)j * 64];
    } else {
        for (int j = 0; j < 256; ++j) o += ps[j] * bf2f(P[(size_t)(b * 256 + j) * EVEN_IN + 3584 + head * 64 + lane]);
    }
    P[(size_t)m * EVEN_IN + 2560 + head * 64 + lane] = (bf16)f2bf(o);
    LDS_WAIT(); asm volatile("" ::: "memory");
}
constexpr size_t WS_RGF = WS_PROJ + 80 * MiB, WS_RGB = WS_PROJ + 120 * MiB;
__device__ __forceinline__ void rg_naive_item(Frame& F, int item) {
    const int s = item >> 4, hb = (item >> 1) & 7, d = item & 1;
    const bool lat = s >= 16; const int T = lat ? 2048 : 256; const int row0 = lat ? M_CTX + (s - 16) * 2048 : s * 256;
    const bf16* P2 = (const bf16*)(F.ws + WS_PROJ);
    bf16* O = (bf16*)(F.ws + (d == 0 ? WS_RGF : WS_RGB));
    float* XB = (float*)F.lds; float* XC = XB + 19 * 128; float* GG = XC + 16 * 128;
    const int tid = F.tid;
    float hst = 0.f, sp = 0.f;
    if (tid < 128) { if (lat) hst = F.in[5][((s - 16) * 2 + d) * 1024 + hb * 128 + tid]; const float lam = F.in[22][d * 1024 + hb * 128 + tid]; sp = log1pf(__expf(-lam)); }
    for (int k = 0; k < T / 16; ++k) {
        const int tb = d == 0 ? 16 * k : T - 16 * (k + 1);
        for (int idx = tid; idx < 19 * 128; idx += NWAVES * 64) { const int hr = idx >> 7, ch = idx & 127, tok = tb + hr - 2;
            XB[idx] = (tok >= 0 && tok < T) ? bf2f(P2[(size_t)(row0 + tok) * ODD_IN + hb * 128 + ch]) : 0.f; }
        __syncthreads();
        for (int idx = tid; idx < 16 * 128; idx += NWAVES * 64) { const int t = idx >> 7, ch = idx & 127; float a = F.in[19][hb * 128 + ch];
#pragma unroll
            for (int j = 0; j < 4; ++j) a += F.in[18][j * 1024 + hb * 128 + ch] * XB[(t + j) * 128 + ch];
            XC[idx] = a; }
        __syncthreads();
        { const int g = tid >> 8, th = (tid >> 7) & 1, j = tid & 127;
          const float* w = F.in[20] + ((size_t)((d * 2 + g) * 8 + hb) * 128) * 128 + j;
          float acc[8];
#pragma unroll
          for (int t = 0; t < 8; ++t) acc[t] = 0.f;
          for (int i = 0; i < 128; ++i) { const float wv = w[(size_t)i * 128];
#pragma unroll
              for (int t = 0; t < 8; ++t) acc[t] += XC[(th * 8 + t) * 128 + i] * wv; }
          const float gb = F.in[21][(d * 2 + g) * 1024 + hb * 128 + j];
#pragma unroll
          for (int t = 0; t < 8; ++t) GG[(g * 16 + th * 8 + t) * 128 + j] = sigmoidf(acc[t] + gb); }
        __syncthreads();
        if (tid < 128) {
            for (int tt = 0; tt < 16; ++tt) { const int t = d == 0 ? tt : 15 - tt;
                const float rr = GG[t * 128 + tid], ii = GG[(16 + t) * 128 + tid];
                const float la = -8.0f * rr * sp; const float a = __expf(la); const float u = sqrtf(-expm1f(2.0f * la)) * (ii * XC[t * 128 + tid]);
                hst = a * hst + u;
                O[(size_t)(row0 + tb + t) * DM + hb * 128 + tid] = (bf16)f2bf(hst); } }
        __syncthreads();
    }
    if (!lat && tid < 128) F.out[OUT_RG + (s * 2 + d) * 1024 + hb * 128 + tid] = hst;
}
__device__ __forceinline__ void gate_even_rows(Frame& F) {
    const bf16* P = (const bf16*)(F.ws + WS_PROJ); bf16* Y = (bf16*)(F.ws + WS_H);
    const int gw = F.vcu * NWAVES + F.wave, NGW = F.G * NWAVES, lane = F.lane;
    const f32x4 g0 = ((const f32x4*)F.in[14])[lane * 2], g1 = ((const f32x4*)F.in[14])[lane * 2 + 1];
    const float gain[8] = {g0.x, g0.y, g0.z, g0.w, g1.x, g1.y, g1.z, g1.w};
    for (int m = gw; m < M_ALL; m += NGW) {
        const bf16* pr = P + (size_t)m * EVEN_IN + lane * 8;
        const v4u wf = *(const v4u*)(pr + 512), wb = *(const v4u*)(pr + 1024), wga = *(const v4u*)(pr + 2048), wo = *(const v4u*)(pr + 2560), wgb = *(const v4u*)(pr + 4096);
        float o[8], ga[8], ob[8], gb[8];
#pragma unroll
        for (int e = 0; e < 4; ++e) { o[2 * e] = bflo(wf[e]) + bflo(wb[e]); o[2 * e + 1] = bfhi(wf[e]) + bfhi(wb[e]); ga[2 * e] = bflo(wga[e]); ga[2 * e + 1] = bfhi(wga[e]);
            ob[2 * e] = bflo(wo[e]); ob[2 * e + 1] = bfhi(wo[e]); gb[2 * e] = bflo(wgb[e]); gb[2 * e + 1] = bfhi(wgb[e]); }
        float ss = 0.f;
#pragma unroll
        for (int e = 0; e < 8; ++e) ss += o[e] * o[e];
        ss += __shfl_xor(ss, 1); ss += __shfl_xor(ss, 2); ss += __shfl_xor(ss, 4); ss += __shfl_xor(ss, 8);
        const float rstd = 1.0f / sqrtf(ss * (1.0f / 128.0f) + 1e-6f);
        float ya[8], yb[8];
#pragma unroll
        for (int e = 0; e < 8; ++e) { ya[e] = o[e] * rstd * gain[e] * siluf(ga[e]); yb[e] = ob[e] * siluf(gb[e]); }
        v4u wa, wbo;
#pragma unroll
        for (int e = 0; e < 4; ++e) { wa[e] = pk2(ya[2 * e], ya[2 * e + 1]); wbo[e] = pk2(yb[2 * e], yb[2 * e + 1]); }
        bf16* yr = Y + (size_t)m * DM + lane * 8;
        *(v4u*)yr = wa; *(v4u*)(yr + 512) = wbo;
    }
}
__device__ __forceinline__ void rg_combine_rows(Frame& F) {
    const bf16* P2 = (const bf16*)(F.ws + WS_PROJ); const bf16* OF = (const bf16*)(F.ws + WS_RGF); const bf16* OB = (const bf16*)(F.ws + WS_RGB); bf16* Y = (bf16*)(F.ws + WS_H);
    const int gw = F.vcu * NWAVES + F.wave, NGW = F.G * NWAVES, lane = F.lane;
    for (int m = gw; m < M_ALL; m += NGW) {
#pragma unroll
        for (int part = 0; part < 2; ++part) { const int c0 = part * 512 + lane * 8;
            const v4u a = *(const v4u*)(OF + (size_t)m * DM + c0), b = *(const v4u*)(OB + (size_t)m * DM + c0), g = *(const v4u*)(P2 + (size_t)m * ODD_IN + 1024 + c0);
            v4u w;
#pragma unroll
            for (int e = 0; e < 4; ++e) w[e] = pk2((bflo(a[e]) + bflo(b[e])) * siluf(bflo(g[e])), (bfhi(a[e]) + bfhi(b[e])) * siluf(bfhi(g[e])));
            *(v4u*)(Y + (size_t)m * DM + c0) = w; }
    }
}
__device__ __forceinline__ void final_norm_rows(Frame& F) {
    const int gw = F.vcu * NWAVES + F.wave, NGW = F.G * NWAVES;
    const f32x4* gp = (const f32x4*)F.in[23] + F.lane;
    for (int m = gw; m < M_ALL; m += NGW) {
        f32x4* xr = (f32x4*)(F.out + (size_t)m * DM) + F.lane;
        f32x4 v[4]; float s = 0.f;
#pragma unroll
        for (int j = 0; j < 4; ++j) { v[j] = xr[64 * j]; s += (v[j].x * v[j].x + v[j].y * v[j].y) + (v[j].z * v[j].z + v[j].w * v[j].w); }
        const float rstd = 1.0f / sqrtf(wave_sum(s) * (1.0f / DM) + 1e-6f);
#pragma unroll
        for (int j = 0; j < 4; ++j) xr[64 * j] = v[j] * rstd * gp[64 * j];
    }
}
typedef float f32x2_t __attribute__((ext_vector_type(2))); typedef __bf16 bf16x2_t __attribute__((ext_vector_type(2)));
__device__ __forceinline__ unsigned cvtpk(float lo, float hi) { f32x2_t v = {lo, hi}; bf16x2_t b = __builtin_convertvector(v, bf16x2_t); return __builtin_bit_cast(unsigned, b); }
#define MFMA32(a, b, c) __builtin_amdgcn_mfma_f32_32x32x16_bf16((a), (b), (c), 0, 0, 0)
template <int ST> __device__ __forceinline__ bf16x8 pack8(const f32x16& x) {
    v4u p; p.x = cvtpk(x[8 * ST], x[8 * ST + 1]); p.y = cvtpk(x[8 * ST + 2], x[8 * ST + 3]); p.z = cvtpk(x[8 * ST + 4], x[8 * ST + 5]); p.w = cvtpk(x[8 * ST + 6], x[8 * ST + 7]);
    return __builtin_bit_cast(bf16x8, p);
}
__device__ __forceinline__ bf16x8 cat4(s16x4 lo, s16x4 hi) { return __builtin_shufflevector(lo, hi, 0, 1, 2, 3, 4, 5, 6, 7); }
constexpr int HG_QD = 0, HG_KI = 8704, HG_KDT = 17408, HG_VT = 27648, HG_DEC = 37888, HG_BUF = 38400;
__device__ __forceinline__ void hgrn_mfma_item(Frame& F, int item) {
    const int s = item >> 3, h = (item >> 1) & 3, d = item & 1;
    const bool lat = s >= 16; const int T = lat ? 2048 : 256; const int row0 = lat ? M_CTX + (s - 16) * 2048 : s * 256; const int nch = T / 32;
    bf16* P = (bf16*)(F.ws + WS_PROJ);
    LAS unsigned char* L = (LAS unsigned char*)F.lds;
    const int zcol = (d == 0 ? 512 : 1024) + h * 128;
    const int lane = F.lane, r = lane & 31, hh = lane >> 5;
    if (F.wave >= 4) {
        const int pw = F.wave - 4, dk = 32 * pw + r;
        const float l0 = F.in[13][(d * 2 + 0) * 512 + h * 128 + dk], l1 = F.in[13][(d * 2 + 1) * 512 + h * 128 + dk];
        const float lbv = 1.0f / (1.0f + __expf(l1 - l0)), omlb = 1.0f - lbv;
        unsigned short zr[16], qr[16], vr[16];
#define HG_LOAD(n) do { _Pragma("unroll") for (int ii = 0; ii < 16; ++ii) { const int i = 16 * hh + ii; const int tok = d == 0 ? 32 * (n) + i : T - 1 - (32 * (n) + i); \
            const bf16* pr = P + (size_t)(row0 + tok) * EVEN_IN; zr[ii] = pr[zcol + dk]; qr[ii] = pr[h * 128 + dk]; vr[ii] = pr[1536 + h * 128 + dk]; } } while (0)
        HG_LOAD(0);
        for (int n = 0; n <= nch; ++n) {
            if (n < nch) {
                LAS unsigned char* B = L + (n & 1) * HG_BUF;
                float lf[16], kk[16]; float tot = 0.f;
#pragma unroll
                for (int ii = 0; ii < 16; ++ii) { const float z = bf2f(zr[ii]); const float sg = sigmoidf(z); const float f = lbv + omlb * sg; lf[ii] = __logf(f); kk[ii] = omlb * (1.0f - sg); tot += lf[ii]; }
                const float other = __shfl_xor(tot, 32);
                const float bend = tot + other; float b = hh ? other : 0.f;
                unsigned kd[8], vv[8];
#pragma unroll
                for (int ii = 0; ii < 16; ++ii) { b += lf[ii]; const int i = 16 * hh + ii;
                    const float qd = bf2f(qr[ii]) * __expf(b), ki = kk[ii] * __expf(-b), kdv = kk[ii] * __expf(bend - b);
                    *(LAS unsigned short*)(B + HG_QD + i * 272 + dk * 2) = (unsigned short)f2bf(qd);
                    *(LAS unsigned short*)(B + HG_KI + i * 272 + dk * 2) = (unsigned short)f2bf(ki);
                    if (ii & 1) { kd[ii >> 1] |= f2bf(kdv) << 16; vv[ii >> 1] |= (unsigned)vr[ii] << 16; } else { kd[ii >> 1] = f2bf(kdv); vv[ii >> 1] = vr[ii]; } }
                *(LAS v4u*)(B + HG_KDT + dk * 80 + hh * 32) = (v4u){kd[0], kd[1], kd[2], kd[3]}; *(LAS v4u*)(B + HG_KDT + dk * 80 + hh * 32 + 16) = (v4u){kd[4], kd[5], kd[6], kd[7]};
                *(LAS v4u*)(B + HG_VT + dk * 80 + hh * 32) = (v4u){vv[0], vv[1], vv[2], vv[3]}; *(LAS v4u*)(B + HG_VT + dk * 80 + hh * 32 + 16) = (v4u){vv[4], vv[5], vv[6], vv[7]};
                if (hh == 0) *(LAS float*)(B + HG_DEC + dk * 4) = __expf(bend);
                if (n + 1 < nch) HG_LOAD(n + 1);
            }
            __syncthreads();
        }
#undef HG_LOAD
    } else {
        const int w = F.wave, dvc = 32 * w + r;
        f32x16 S[4];
        if (lat) { const float* s0 = F.in[2] + ((size_t)(((s - 16) * 2 + d) * 4 + h)) * 16384;
#pragma unroll
            for (int i = 0; i < 4; ++i)
#pragma unroll
                for (int g = 0; g < 16; ++g) S[i][g] = s0[(32 * i + (g & 3) + 8 * (g >> 2) + 4 * hh) * 128 + dvc]; }
        else {
#pragma unroll
            for (int i = 0; i < 4; ++i)
#pragma unroll
                for (int g = 0; g < 16; ++g) S[i][g] = 0.f; }
        __syncthreads();
        for (int n = 0; n < nch; ++n) {
            LAS unsigned char* B = L + (n & 1) * HG_BUF;
            f32x16 X;
#pragma unroll
            for (int g = 0; g < 16; ++g) X[g] = 0.f;
#pragma unroll
            for (int st = 0; st < 8; ++st) { const bf16x8 a = *(LAS bf16x8*)(B + HG_KI + r * 272 + (16 * st + 8 * hh) * 2), b = *(LAS bf16x8*)(B + HG_QD + r * 272 + (16 * st + 8 * hh) * 2); X = MFMA32(a, b, X); }
#pragma unroll
            for (int g = 0; g < 16; ++g) { const int sr = (g & 3) + 8 * (g >> 2) + 4 * hh; X[g] = sr <= r ? X[g] : 0.f; }
            const bf16x8 xa0 = pack8<0>(X), xa1 = pack8<1>(X);
            f32x16 O;
#pragma unroll
            for (int g = 0; g < 16; ++g) O[g] = 0.f;
            { const LAS unsigned char* vt = B + HG_VT + dvc * 80 + 8 * hh;
              O = MFMA32(xa0, cat4(*(const LAS s16x4*)(vt), *(const LAS s16x4*)(vt + 16)), O);
              O = MFMA32(xa1, cat4(*(const LAS s16x4*)(vt + 32), *(const LAS s16x4*)(vt + 48)), O); }
#pragma unroll
            for (int i = 0; i < 4; ++i) { const LAS unsigned char* qd = B + HG_QD + r * 272 + (32 * i) * 2 + 8 * hh;
                O = MFMA32(cat4(*(const LAS s16x4*)(qd), *(const LAS s16x4*)(qd + 16)), pack8<0>(S[i]), O);
                O = MFMA32(cat4(*(const LAS s16x4*)(qd + 32), *(const LAS s16x4*)(qd + 48)), pack8<1>(S[i]), O); }
#pragma unroll
            for (int g = 0; g < 16; ++g) { const int t = (g & 3) + 8 * (g >> 2) + 4 * hh; const int tok = d == 0 ? 32 * n + t : T - 1 - (32 * n + t);
                P[(size_t)(row0 + tok) * EVEN_IN + zcol + dvc] = (bf16)f2bf(O[g]); }
#pragma unroll
            for (int i = 0; i < 4; ++i) {
#pragma unroll
                for (int g = 0; g < 16; ++g) S[i][g] *= *(const LAS float*)(B + HG_DEC + (32 * i + (g & 3) + 8 * (g >> 2) + 4 * hh) * 4);
#pragma unroll
                for (int st = 0; st < 2; ++st) { const bf16x8 a = *(const LAS bf16x8*)(B + HG_KDT + (32 * i + r) * 80 + (16 * st + 8 * hh) * 2), b = *(const LAS bf16x8*)(B + HG_VT + dvc * 80 + (16 * st + 8 * hh) * 2); S[i] = MFMA32(a, b, S[i]); } }
            __syncthreads();
        }
        if (!lat) { float* so = F.out + OUT_HG + ((size_t)((s * 2 + d) * 4 + h)) * 16384;
#pragma unroll
            for (int i = 0; i < 4; ++i)
#pragma unroll
                for (int g = 0; g < 16; ++g) so[(32 * i + (g & 3) + 8 * (g >> 2) + 4 * hh) * 128 + dvc] = S[i][g]; }
    }
}
#define MFMA16(a, b, c) __builtin_amdgcn_mfma_f32_16x16x32_bf16((a), (b), (c), 0, 0, 0)
typedef short v4i16_t __attribute__((ext_vector_type(4)));
__device__ __forceinline__ s16x4 vtr(const LAS unsigned char* p) { return __builtin_bit_cast(s16x4, __builtin_amdgcn_ds_read_tr16_b64_v4i16((LAS v4i16_t*)p)); }
__device__ __forceinline__ bf16x8 pack44(const f32x4& a, const f32x4& b) { v4u p; p.x = cvtpk(a[0], a[1]); p.y = cvtpk(a[2], a[3]); p.z = cvtpk(b[0], b[1]); p.w = cvtpk(b[2], b[3]); return __builtin_bit_cast(bf16x8, p); }
constexpr int AT_VL = 0, AT_KC = 73728, AT_VC = AT_KC + 36864, AT_BT = AT_VC + 32768, AT_END = AT_BT + 2048;
static_assert(AT_END <= MISC_OFF, "attention LDS map");
template <bool LOCAL> __device__ __forceinline__ void attn_mfma_item(Frame& F, int item) {
    LAS unsigned char* L = (LAS unsigned char*)F.lds;
    bf16* P = (bf16*)(F.ws + WS_PROJ);
    const int tid = F.tid, lane = F.lane, fr = lane & 15, fq = lane >> 4, w = F.wave;
    int b, head, rp = 0, half = 0, rs0 = 0;
    if (LOCAL) { b = item >> 7; head = (item >> 4) & 7; rp = item & 15; rs0 = min(max(2 * rp - 4, 0), 24); }
    else { b = item >> 4; head = (item >> 1) & 7; half = item & 1; }
    if (LOCAL) {
        const int nrows = min(9, 32 - rs0);
        for (int c = tid; c < nrows * 512; c += NWAVES * 64) { const int key = c >> 3, ch = c & 7;
            *(LAS v4u*)(L + AT_VL + key * 128 + ch * 16) = *(const v4u*)(P + (size_t)(M_CTX + b * 2048 + rs0 * 64 + key) * EVEN_IN + 3584 + head * 64 + ch * 8); }
        const float* kc = F.in[3] + (size_t)(b * 8 + head) * 16384; const float* vc = F.in[4] + (size_t)(b * 8 + head) * 16384;
        for (int c = tid; c < 2048; c += NWAVES * 64) { const int key = c >> 3, ch = c & 7;
            const f32x4 a0 = *(const f32x4*)(kc + key * 64 + ch * 8), a1 = *(const f32x4*)(kc + key * 64 + ch * 8 + 4);
            *(LAS v4u*)(L + AT_KC + key * 144 + ch * 16) = (v4u){pk2(a0.x, a0.y), pk2(a0.z, a0.w), pk2(a1.x, a1.y), pk2(a1.z, a1.w)};
            const f32x4 b0 = *(const f32x4*)(vc + key * 64 + ch * 8), b1 = *(const f32x4*)(vc + key * 64 + ch * 8 + 4);
            *(LAS v4u*)(L + AT_VC + key * 128 + ch * 16) = (v4u){pk2(b0.x, b0.y), pk2(b0.z, b0.w), pk2(b1.x, b1.y), pk2(b1.z, b1.w)}; }
        for (int i = tid; i < 465; i += NWAVES * 64) ((LAS float*)(L + AT_BT))[i] = F.in[15][head * 465 + i];
    } else {
        for (int c = tid; c < 2048; c += NWAVES * 64) { const int key = c >> 3, ch = c & 7; const bf16* pr = P + (size_t)(b * 256 + key) * EVEN_IN + head * 64 + ch * 8;
            *(LAS v4u*)(L + AT_KC + key * 144 + ch * 16) = *(const v4u*)(pr + 3072); *(LAS v4u*)(L + AT_VC + key * 128 + ch * 16) = *(const v4u*)(pr + 3584); }
    }
    const int ri = w >> 2, jb = w & 3, r = 2 * rp + ri;
    const int qbase = LOCAL ? M_CTX + b * 2048 + r * 64 + 16 * jb : b * 256 + half * 128 + 16 * w;
    const bf16* qp = P + (size_t)(qbase + fr) * EVEN_IN + 2560 + head * 64 + 8 * fq;
    const bf16x8 qf0 = *(const bf16x8*)qp, qf1 = *(const bf16x8*)(qp + 32);
    __syncthreads();
    const int trow = fr >> 2, tcol = (fr & 3) * 8;
    f32x4 O1[4];
#pragma unroll
    for (int dt = 0; dt < 4; ++dt) O1[dt] = (f32x4){0.f, 0.f, 0.f, 0.f};
    float mx1 = -1e30f, l1 = 0.f;
    {
        f32x4 sc[16];
#pragma unroll
        for (int kt = 0; kt < 16; ++kt) { const LAS unsigned char* kp = L + AT_KC + (16 * kt + fr) * 144 + 16 * fq;
            f32x4 acc = {0.f, 0.f, 0.f, 0.f}; acc = MFMA16(*(const LAS bf16x8*)kp, qf0, acc); acc = MFMA16(*(const LAS bf16x8*)(kp + 64), qf1, acc);
            acc = acc * 0.125f; sc[kt] = acc; mx1 = fmaxf(fmaxf(mx1, fmaxf(acc[0], acc[1])), fmaxf(acc[2], acc[3])); }
        mx1 = fmaxf(mx1, __shfl_xor(mx1, 16)); mx1 = fmaxf(mx1, __shfl_xor(mx1, 32));
#pragma unroll
        for (int kt = 0; kt < 16; ++kt)
#pragma unroll
            for (int e = 0; e < 4; ++e) { const float p = __expf(sc[kt][e] - mx1); sc[kt][e] = p; l1 += p; }
        l1 += __shfl_xor(l1, 16); l1 += __shfl_xor(l1, 32);
#pragma unroll
        for (int c = 0; c < 8; ++c) { const bf16x8 pa = pack44(sc[2 * c], sc[2 * c + 1]);
            const LAS unsigned char* v0 = L + AT_VC + (32 * c + 4 * fq + trow) * 128 + tcol;
#pragma unroll
            for (int dt = 0; dt < 4; ++dt) O1[dt] = MFMA16(pa, cat4(vtr(v0 + dt * 32), vtr(v0 + 16 * 128 + dt * 32)), O1[dt]); }
    }
    float f1 = 1.0f / l1, f2 = 0.f;
    f32x4 O2[4];
#pragma unroll
    for (int dt = 0; dt < 4; ++dt) O2[dt] = (f32x4){0.f, 0.f, 0.f, 0.f};
    if (LOCAL) {
        const int rs = min(max(r - 4, 0), 24), band = jb == 0 ? 0 : (jb == 1 ? 8 : (jb == 2 ? 24 : 32));
        const int qc = 16 * jb + fr, wsx = min(max(qc - 8, 0), 48);
        f32x4 sl[16]; float mx2 = -1e30f, l2 = 0.f;
#pragma unroll
        for (int kr = 0; kr < 8; ++kr)
#pragma unroll
            for (int hf = 0; hf < 2; ++hf) { const int tok = (rs + kr) * 64 + band + 16 * hf + fr;
                const bf16* kp = P + (size_t)(M_CTX + b * 2048 + tok) * EVEN_IN + 3072 + head * 64 + 8 * fq;
                f32x4 acc = {0.f, 0.f, 0.f, 0.f}; acc = MFMA16(*(const bf16x8*)kp, qf0, acc); acc = MFMA16(*(const bf16x8*)(kp + 32), qf1, acc);
                const LAS float* bt = (const LAS float*)(L + AT_BT) + (rs + kr - r + 7) * 31;
#pragma unroll
                for (int e = 0; e < 4; ++e) { const int kc = band + 16 * hf + 4 * fq + e; const bool valid = kc >= wsx && kc < wsx + 16;
                    const float bias = bt[min(max(kc - qc + 15, 0), 30)];
                    acc[e] = valid ? acc[e] * 0.125f + bias : -1e30f; mx2 = fmaxf(mx2, acc[e]); }
                sl[kr * 2 + hf] = acc; }
        mx2 = fmaxf(mx2, __shfl_xor(mx2, 16)); mx2 = fmaxf(mx2, __shfl_xor(mx2, 32));
#pragma unroll
        for (int kt = 0; kt < 16; ++kt)
#pragma unroll
            for (int e = 0; e < 4; ++e) { const float p = __expf(sl[kt][e] - mx2); sl[kt][e] = p; l2 += p; }
        l2 += __shfl_xor(l2, 16); l2 += __shfl_xor(l2, 32);
#pragma unroll
        for (int kr = 0; kr < 8; ++kr) { const bf16x8 pa = pack44(sl[2 * kr], sl[2 * kr + 1]);
            const LAS unsigned char* v0 = L + AT_VL + ((rs + kr - rs0) * 64 + band + 4 * fq + trow) * 128 + tcol;
#pragma unroll
            for (int dt = 0; dt < 4; ++dt) O2[dt] = MFMA16(pa, cat4(vtr(v0 + dt * 32), vtr(v0 + 16 * 128 + dt * 32)), O2[dt]); }
        const float m = fmaxf(mx1, mx2), a1 = __expf(mx1 - m), a2 = __expf(mx2 - m), linv = 1.0f / (l1 * a1 + l2 * a2);
        f1 = a1 * linv; f2 = a2 * linv;
    }
#pragma unroll
    for (int e = 0; e < 4; ++e) { const float g1 = __shfl(f1, 4 * fq + e), g2 = __shfl(f2, 4 * fq + e);
        bf16* op = P + (size_t)(qbase + 4 * fq + e) * EVEN_IN + 2560 + head * 64 + fr;
#pragma unroll
        for (int dt = 0; dt < 4; ++dt) op[16 * dt] = (bf16)f2bf(O1[dt][e] * g1 + O2[dt][e] * g2); }
    __syncthreads();
}
constexpr int RG_XC = 0, RG_XCF = 17408, RG_HB = 50176, RG_CIN = 115712, RG_END = 125952;
__device__ __forceinline__ float rcpf_(float x) { return __builtin_amdgcn_rcpf(x); }
template <bool APPLY> __device__ __forceinline__ void rg_phase(Frame& F) {
    LAS unsigned char* L = (LAS unsigned char*)F.lds;
    const bf16* P2 = (const bf16*)(F.ws + WS_PROJ);
    float* AGG = (float*)(F.ws + WS_AGG);
    const int bx = blockIdx.x, hb = bx & 7, t0i = bx >> 3;
    if (F.G != 256) return;
    const int tid = F.tid, lane = F.lane, r = lane & 31, hh = lane >> 5, w = F.wave, d = w >> 2, jq = w & 3;
    const int chl = 32 * jq + r, ch = hb * 128 + chl;
    if (APPLY) {
        for (int idx = tid; idx < 10 * 256; idx += NWAVES * 64) {
            const int k = idx >> 8, dd = (idx >> 7) & 1, c = idx & 127, ti = t0i + 32 * k;
            const bool lat = ti >= 64; const int first = lat ? 64 + ((ti - 64) & ~31) : (ti & ~3), nts = lat ? 32 : 4, pos = ti - first;
            const int cnt = dd == 0 ? pos : nts - 1 - pos;
            float st = lat ? F.in[5][(((ti - 64) >> 5) * 2 + dd) * 1024 + hb * 128 + c] : 0.f;
            float av[31], uv[31];
#pragma unroll
            for (int j = 0; j < 31; ++j) { const bool ok = j < cnt; const int tj = ok ? (dd == 0 ? first + j : first + nts - 1 - j) : ti;
                const float2 v = *(const float2*)(AGG + ((size_t)(tj * 2 + dd) * 1024 + hb * 128 + c) * 2); av[j] = ok ? v.x : 1.0f; uv[j] = ok ? v.y : 0.0f; }
#pragma unroll
            for (int j = 0; j < 31; ++j) st = av[j] * st + uv[j];
            *(LAS float*)(L + RG_CIN + ((k * 2 + dd) * 128 + c) * 4) = st;
        }
    }
    const float gb0 = F.in[21][(d * 2 + 0) * 1024 + ch], gb1 = F.in[21][(d * 2 + 1) * 1024 + ch];
    const float sp8 = -8.0f * log1pf(__expf(-F.in[22][d * 1024 + ch]));
    const int cc = tid & 127, tq = tid >> 7;
    const float cw0 = F.in[18][0 * 1024 + hb * 128 + cc], cw1 = F.in[18][1 * 1024 + hb * 128 + cc], cw2 = F.in[18][2 * 1024 + hb * 128 + cc], cw3 = F.in[18][3 * 1024 + hb * 128 + cc], cbv = F.in[19][hb * 128 + cc];
    for (int k = 0; k < 10; ++k) {
        const int ti = t0i + 32 * k; const int rowb = ti * 64;
        const bool lat = ti >= 64; const int pos = lat ? ((ti - 64) & 31) : (ti & 3), nts = lat ? 32 : 4;
        bf16x8 Bw[2][8];
#pragma unroll
        for (int g = 0; g < 2; ++g)
#pragma unroll
            for (int st = 0; st < 8; ++st) Bw[g][st] = *(const bf16x8*)((const bf16*)(F.ws + WS_GW) + (size_t)((d * 2 + g) * 8 + hb) * 16384 + chl * 128 + 16 * st + 8 * hh);
        { const bf16* xp = P2 + (size_t)(rowb + 16 * tq) * ODD_IN + hb * 128 + cc;
          const bool lo_ok = !(pos == 0 && tq == 0), hi_ok = !(pos == nts - 1 && tq == 3);
          float xm2 = lo_ok ? bf2f(xp[-2 * ODD_IN]) : 0.f, xm1 = lo_ok ? bf2f(xp[-1 * ODD_IN]) : 0.f, x0 = bf2f(xp[0]);
#pragma unroll
          for (int t = 0; t < 16; ++t) { const float x1 = (t < 15 || hi_ok) ? bf2f(xp[(size_t)(t + 1) * ODD_IN]) : 0.f;
              const float xc = cbv + cw0 * xm2 + cw1 * xm1 + cw2 * x0 + cw3 * x1;
              *(LAS unsigned short*)(L + RG_XC + (16 * tq + t) * 272 + cc * 2) = (unsigned short)f2bf(xc);
              *(LAS float*)(L + RG_XCF + ((16 * tq + t) * 128 + cc) * 4) = xc;
              xm2 = xm1; xm1 = x0; x0 = x1; } }
        __syncthreads();
        f32x16 acc[2][2];
#pragma unroll
        for (int g = 0; g < 2; ++g)
#pragma unroll
            for (int mt = 0; mt < 2; ++mt)
#pragma unroll
                for (int q = 0; q < 16; ++q) acc[g][mt][q] = 0.f;
#pragma unroll
        for (int st = 0; st < 8; ++st)
#pragma unroll
            for (int mt = 0; mt < 2; ++mt) { const bf16x8 a = *(const LAS bf16x8*)(L + RG_XC + (32 * mt + r) * 272 + (16 * st + 8 * hh) * 2);
                acc[0][mt] = MFMA32(a, Bw[0][st], acc[0][mt]); acc[1][mt] = MFMA32(a, Bw[1][st], acc[1][mt]); }
#pragma unroll
        for (int mt = 0; mt < 2; ++mt)
#pragma unroll
            for (int q = 0; q < 16; ++q) { const int t = 32 * mt + (q & 3) + 8 * (q >> 2) + 4 * hh;
                const float rr = rcpf_(1.0f + __expf(-(acc[0][mt][q] + gb0))), ii = rcpf_(1.0f + __expf(-(acc[1][mt][q] + gb1)));
                const float la = sp8 * rr, a = __expf(la), x2 = 2.0f * la;
                const float em_s = -x2 * (1.0f + x2 * (0.5f + x2 * (0.16666667f + x2 * (0.041666668f + x2 * 0.008333334f)))), em = x2 > -0.2f ? em_s : 1.0f - a * a;
                acc[0][mt][q] = a; acc[1][mt][q] = sqrtf(em) * (ii * *(const LAS float*)(L + RG_XCF + (t * 128 + chl) * 4)); }
        float Ag[8], Ug[8];
#pragma unroll
        for (int mt = 0; mt < 2; ++mt)
#pragma unroll
            for (int G = 0; G < 4; ++G) { float pa = 1.f, hs = 0.f;
#pragma unroll
                for (int e0 = 0; e0 < 4; ++e0) { const int e = d == 0 ? e0 : 3 - e0; const float a = acc[0][mt][4 * G + e], u = acc[1][mt][4 * G + e]; hs = a * hs + u; pa *= a; }
                Ag[4 * mt + G] = pa; Ug[4 * mt + G] = hs; }
        float cin = 0.f;
        if (APPLY) cin = *(const LAS float*)(L + RG_CIN + ((k * 2 + d) * 128 + chl) * 4);
        float state = cin, ptot = 1.f, cown[8];
#pragma unroll
        for (int k0 = 0; k0 < 8; ++k0) { const int kk = d == 0 ? k0 : 7 - k0;
            const float pA = __shfl_xor(Ag[kk], 32), pU = __shfl_xor(Ug[kk], 32);
            const bool ownfirst = (d == 0) ? (hh == 0) : (hh == 1);
            const float A1 = ownfirst ? Ag[kk] : pA, U1 = ownfirst ? Ug[kk] : pU, A2 = ownfirst ? pA : Ag[kk], U2 = ownfirst ? pU : Ug[kk];
            const float s1 = A1 * state + U1; cown[kk] = ownfirst ? state : s1; state = A2 * s1 + U2; ptot *= A1 * A2; }
        if (!APPLY) { if (hh == 0) *(float2*)(AGG + ((size_t)(ti * 2 + d) * 1024 + ch) * 2) = make_float2(ptot, state); }
        else {
#pragma unroll
            for (int mt = 0; mt < 2; ++mt)
#pragma unroll
                for (int G = 0; G < 4; ++G) { float hs = cown[4 * mt + G];
#pragma unroll
                    for (int e0 = 0; e0 < 4; ++e0) { const int e = d == 0 ? e0 : 3 - e0; hs = acc[0][mt][4 * G + e] * hs + acc[1][mt][4 * G + e];
                        const int t = 32 * mt + 8 * G + 4 * hh + e; *(LAS float*)(L + RG_HB + ((d * 64 + t) * 128 + chl) * 4) = hs; } }
            if (!lat && hh == 0 && ((d == 0 && pos == nts - 1) || (d == 1 && pos == 0))) F.out[OUT_RG + ((ti >> 2) * 2 + d) * 1024 + ch] = state;
            __syncthreads();
#pragma unroll
            for (int it = 0; it < 2; ++it) { const int cidx = tid + it * 512, t = cidx >> 4, c8 = (cidx & 15) * 8;
                const v4u gw = *(const v4u*)(P2 + (size_t)(rowb + t) * ODD_IN + 1024 + hb * 128 + c8);
                const f32x4 f0 = *(const LAS f32x4*)(L + RG_HB + (t * 128 + c8) * 4), f1 = *(const LAS f32x4*)(L + RG_HB + (t * 128 + c8 + 4) * 4);
                const f32x4 b0 = *(const LAS f32x4*)(L + RG_HB + ((64 + t) * 128 + c8) * 4), b1 = *(const LAS f32x4*)(L + RG_HB + ((64 + t) * 128 + c8 + 4) * 4);
                v4u o; o.x = pk2((f0.x + b0.x) * siluf(bflo(gw.x)), (f0.y + b0.y) * siluf(bfhi(gw.x))); o.y = pk2((f0.z + b0.z) * siluf(bflo(gw.y)), (f0.w + b0.w) * siluf(bfhi(gw.y)));
                o.z = pk2((f1.x + b1.x) * siluf(bflo(gw.z)), (f1.y + b1.y) * siluf(bfhi(gw.z))); o.w = pk2((f1.z + b1.z) * siluf(bflo(gw.w)), (f1.w + b1.w) * siluf(bfhi(gw.w)));
                *(v4u*)((bf16*)(F.ws + WS_H) + (size_t)(rowb + t) * DM + hb * 128 + c8) = o; }
        }
        if (!APPLY) __syncthreads();
    }
    __syncthreads();
}
struct Args { const float* in[24]; float* out; unsigned char* ws; int ph_lo, ph_hi; };
__global__ void __launch_bounds__(NWAVES * 64, 2) mega_fwd(Args args) {
    extern __shared__ __attribute__((aligned(16))) unsigned char lds[];
    Frame F;
    F.lds = lds;
    F.MISC = (volatile LAS unsigned*)((LAS unsigned char*)lds + MISC_OFF);
    F.tid = threadIdx.x; F.lane = F.tid & 63; F.wave = __builtin_amdgcn_readfirstlane(F.tid >> 6);
    F.G = gridDim.x; { const int bx = blockIdx.x; F.vcu = (F.G % 8 == 0) ? (bx % 8) * (F.G / 8) + bx / 8 : bx; }
    F.ws = args.ws; F.out = args.out; F.ctl = (gu32*)(args.ws + WS_CTL);
#pragma unroll
    for (int i = 0; i < 24; ++i) F.in[i] = args.in[i];
    for (int u = F.tid; u < (LDS_BYTES - MISC_OFF) / 4; u += NWAVES * 64) ((LAS unsigned*)((LAS unsigned char*)lds + MISC_OFF))[u] = 0u;
    __syncthreads();
    const int lo = args.ph_lo, hi = args.ph_hi;
    const bool one = (lo == 0 && hi == NPHASE);
    XcdBarrier bar; bar.bar = (unsigned*)(F.ctl + CW_BAR); bar.x = 0; bar.st = nullptr;
    if (one) bar = xcd_barrier_post((unsigned*)(F.ctl + CW_BAR), F.MISC + 8);
#define IN(k) (lo <= (k) && (k) < hi)
#define GRID_BAR(k) do { if (IN(k) && IN((k) + 1)) xcd_barrier(bar); } while (0)
    LAS unsigned char* ring = (LAS unsigned char*)lds;

    if (IN(0)) { p0_prologue(F); GRID_BAR(0); }
    if (IN(1)) { modnorm_rows(F, 0, F.in[0], F.in[1]); GRID_BAR(1); }
    if (IN(2)) {
        pg8::Gemm g{(const bf16*)(F.ws + WS_H), (const bf16*)(F.ws + WS_WIE), M_ALL, EVEN_IN, DM}; pg8::StaticOrder S; S.init(M_ALL, EVEN_IN, F.G, (int)blockIdx.x);
        pg8::EpiProj E{(bf16*)(F.ws + WS_PROJ), EVEN_IN, F.out + OUT_K};
        pg8::gemm_phase<pg8::EpiProj, pg8::StaticOrder, true, true>(ring, g, S, E);
        GRID_BAR(2);
    }
    if (IN(3)) {
        for (;;) {
            if (F.tid == 0) F.MISC[16] = __hip_atomic_fetch_add((unsigned*)(F.ctl + CW_QUEUE), 1u, __ATOMIC_RELAXED, __HIP_MEMORY_SCOPE_AGENT);
            __syncthreads();
            const int qi = (int)F.MISC[16];
            __syncthreads();
            if (qi >= 64 + 1024 + 128 + 256) break;
            if (qi < 64) hgrn_mfma_item(F, 128 + qi);
            else if (qi < 64 + 1024) attn_mfma_item<true>(F, qi - 64);
            else if (qi < 64 + 1024 + 128) hgrn_mfma_item(F, qi - (64 + 1024));
            else attn_mfma_item<false>(F, qi - (64 + 1024 + 128));
        }
        GRID_BAR(3);
    }
    if (IN(4)) { gate_even_rows(F); GRID_BAR(4); }
    if (IN(5)) {
        pg8::Gemm g{(const bf16*)(F.ws + WS_H), (const bf16*)(F.ws + WS_WOE), M_ALL, DM, DM}; pg8::StaticOrder S; S.init(M_ALL, DM, F.G, (int)blockIdx.x);
        pg8::EpiRes E{F.in[0], F.in[1], F.out, (const float*)(F.ws + WS_MODS) + 2048};
        pg8::gemm_phase<pg8::EpiRes, pg8::StaticOrder, true, true>(ring, g, S, E);
        GRID_BAR(5);
    }
    if (IN(6)) { modnorm_rows(F, 1, F.out, F.out + (size_t)M_CTX * DM); GRID_BAR(6); }
    if (IN(7)) {
        pg8::Gemm g{(const bf16*)(F.ws + WS_H), (const bf16*)(F.ws + WS_WIO), M_ALL, ODD_IN, DM}; pg8::StaticOrder S; S.init(M_ALL, ODD_IN, F.G, (int)blockIdx.x);
        pg8::EpiProj E{(bf16*)(F.ws + WS_PROJ), ODD_IN, nullptr};
        pg8::gemm_phase<pg8::EpiProj, pg8::StaticOrder, true, true>(ring, g, S, E);
        GRID_BAR(7);
    }
    if (IN(8)) { rg_phase<false>(F); GRID_BAR(8); }
    if (IN(9)) { rg_phase<true>(F); GRID_BAR(9); }
    if (IN(10)) {
        pg8::Gemm g{(const bf16*)(F.ws + WS_H), (const bf16*)(F.ws + WS_WOO), M_ALL, DM, DM}; pg8::StaticOrder S; S.init(M_ALL, DM, F.G, (int)blockIdx.x);
        pg8::EpiRes E{F.out, F.out + (size_t)M_CTX * DM, F.out, (const float*)(F.ws + WS_MODS) + 9 * 3072 + 2048};
        pg8::gemm_phase<pg8::EpiRes, pg8::StaticOrder, true, true>(ring, g, S, E);
        GRID_BAR(10);
    }
    if (IN(11)) { final_norm_rows(F); }

#undef IN
#undef GRID_BAR
}

extern "C" void kernel_launch(void* const* d_in, const int* in_sizes, int n_in, void* d_out, int out_size, void* d_ws, size_t ws_size, hipStream_t stream) {
    static int grid = 0;
    if (grid == 0) {
        if (n_in != 24 || out_size != (int)OUT_TOTAL || ws_size < WS_END) { fprintf(stderr, "kernel_launch: unexpected shapes (n_in %d out %d ws %zu)\n", n_in, out_size, ws_size); grid = -1; return; }
        int dev = 0, cus = 0, per_cu = 0;
        if (hipGetDevice(&dev) != hipSuccess || hipDeviceGetAttribute(&cus, hipDeviceAttributeMultiprocessorCount, dev) != hipSuccess) { grid = -1; return; }
        if (hipFuncSetAttribute((const void*)mega_fwd, hipFuncAttributeMaxDynamicSharedMemorySize, LDS_BYTES) != hipSuccess) { fprintf(stderr, "kernel_launch: hipFuncSetAttribute failed\n"); grid = -1; return; }
        if (hipOccupancyMaxActiveBlocksPerMultiprocessor(&per_cu, (const void*)mega_fwd, NWAVES * 64, LDS_BYTES) != hipSuccess || per_cu < 1) { fprintf(stderr, "kernel_launch: occupancy query says %d\n", per_cu); }
        (void)hipGetLastError();
        grid = cus;
    }
    if (grid < 0) return;
    (void)hipMemsetAsync((char*)d_ws + WS_CTL, 0, CTL_ZERO_BYTES, stream);
    Args a{};
    for (int i = 0; i < 24; ++i) a.in[i] = (const float*)d_in[i];
    a.out = (float*)d_out; a.ws = (unsigned char*)d_ws;
#if defined(MK_PER_PHASE)
    for (int p = 0; p < NPHASE; ++p) { a.ph_lo = p; a.ph_hi = p + 1; hipLaunchKernelGGL(mega_fwd, dim3(grid), dim3(NWAVES * 64), LDS_BYTES, stream, a); }
#else
    a.ph_lo = 0; a.ph_hi = NPHASE;
    hipLaunchKernelGGL(mega_fwd, dim3(grid), dim3(NWAVES * 64), LDS_BYTES, stream, a);
#endif
}
```

```cpp
#include <hip/hip_runtime.h>
#include <cstdio>
#include <cstdint>
namespace pg8 {
#define PG8_LAS __attribute__((address_space(3)))
typedef unsigned short bf16_t;
typedef short bf16x8 __attribute__((ext_vector_type(8)));
typedef float f32x4 __attribute__((ext_vector_type(4)));
typedef unsigned u32x4 __attribute__((ext_vector_type(4)));
constexpr int BM = 256, BK = 64, HALF = 128, HTB = HALF * BK * 2  , STAGE_BYTES = 8 * HTB, NXCD = 8, WGM = 8;

__host__ __device__ __forceinline__ int lds_byte(int r, int c) { const int st = (r >> 4) * 2 + (c >> 5), rr = r & 15, cc = c & 31, ob = rr * 64 + cc * 2; return st * 1024 + (ob ^ (((ob >> 9) & 1) << 5)); }
__host__ __device__ __forceinline__ void stage_rc(int b, int& R, int& C) { const int st = b / 1024, sb = b % 1024, swz = sb ^ (((sb >> 9) & 1) << 5); R = (st >> 1) * 16 + swz / 64; C = (st & 1) * 32 + (swz % 64) / 2; }
__host__ __device__ __forceinline__ int perm32(int rho) { const int n = rho >> 4, i = rho & 15; return 8 * (i >> 2) + 4 * n + (i & 3); }

struct Unit { int pm, pn; };
struct Gemm { const bf16_t* A; const bf16_t* Bt; int M, N, K; };

struct StaticOrder {
    int nM, nN, nwg, G, c;
    __host__ __device__ void init(int M, int N, int G_, int c_) { nM = M / BM; nN = N / BM; nwg = nM * nN; G = G_; c = c_; }
    __host__ __device__ bool next(int i, Unit& u) const {
        const long L = (long)i * G + c; if (L >= nwg) return false;
        int wgid = (int)L; { const int q = nwg / NXCD, r = nwg % NXCD, xcd = wgid % NXCD, off = wgid / NXCD; wgid = (xcd < r ? xcd * (q + 1) : r * (q + 1) + (xcd - r) * q) + off; }
        const int nig = WGM * nN, gid = wgid / nig, fm = gid * WGM, gsz = (nM - fm) < WGM ? (nM - fm) : WGM;
        u.pm = fm + ((wgid % nig) % gsz); u.pn = (wgid % nig) / gsz; return true;
    }
    __device__ __forceinline__ void a_ready(const Unit&) const {}
    __device__ __forceinline__ void done(const Unit&) const {}
};

__device__ __forceinline__ unsigned cvt_pk_bf16(float lo, float hi) { unsigned r; asm volatile("v_cvt_pk_bf16_f32 %0, %1, %2" : "=v"(r) : "v"(lo), "v"(hi)); return r; }
typedef float f32x2 __attribute__((ext_vector_type(2)));
struct EpiProj {
    static constexpr bool PERM = true, AFTER_DRAIN = false;
    bf16_t* O; int ldc; float* kv;
    __device__ __forceinline__ void operator()(const f32x4 (&acc)[2][2][4][2], const Unit& u, int wr, int wc, int fr, int fq) const {
        const int row0 = u.pm * BM + wr * 64 + fr; const int col0 = u.pn * BM + wc * 32 + 8 * fq;
        const bool dokv = (kv != nullptr) && u.pm < 16 && u.pn >= 12 && u.pn < 16;
#pragma unroll
        for (int ai = 0; ai < 2; ++ai)
#pragma unroll
            for (int m = 0; m < 4; ++m) { bf16_t* rowp = O + (size_t)(row0 + ai * HALF + m * 16) * ldc + col0;
#pragma unroll
                for (int bj = 0; bj < 2; ++bj) { const f32x4 v0 = acc[ai][bj][m][0], v1 = acc[ai][bj][m][1];
                    u32x4 w; w.x = cvt_pk_bf16(v0[0], v0[1]); w.y = cvt_pk_bf16(v0[2], v0[3]); w.z = cvt_pk_bf16(v1[0], v1[1]); w.w = cvt_pk_bf16(v1[2], v1[3]);
                    *(u32x4*)(rowp + bj * HALF) = w;
                    if (dokv) { const int cc = col0 + bj * HALF - 3072, which = cc >> 9, c2 = cc & 511, head = c2 >> 6, d = c2 & 63, t = wr * 64 + fr + ai * HALF + m * 16;
                        float* p = kv + (size_t)which * 2097152 + ((size_t)(u.pm * 8 + head) * 256 + t) * 64 + d; *(f32x4*)p = v0; *(f32x4*)(p + 4) = v1; } } }
    }
};
struct EpiRes {
    static constexpr bool PERM = false, AFTER_DRAIN = false;
    const float* base0; const float* base1; float* out; const float* gate;
    __device__ __forceinline__ void operator()(const f32x4 (&acc)[2][2][4][2], const Unit& u, int wr, int wc, int fr, int fq) const {
        const int nidx = u.pm < 16 ? 0 : 1 + ((u.pm - 16) >> 3);
        const float* gp = gate + (size_t)nidx * 3072;
        const int col0 = u.pn * BM + wc * 32 + 4 * fq;
        f32x4 gv[2][2];
#pragma unroll
        for (int bj = 0; bj < 2; ++bj)
#pragma unroll
            for (int n = 0; n < 2; ++n) gv[bj][n] = *(const f32x4*)(gp + col0 + bj * HALF + n * 16);
#pragma unroll
        for (int ai = 0; ai < 2; ++ai)
#pragma unroll
            for (int m = 0; m < 4; ++m) { const int row = u.pm * BM + ai * HALF + wr * 64 + m * 16 + fr;
                const float* bp = (row < 4096 ? base0 + (size_t)row * 1024 : base1 + (size_t)(row - 4096) * 1024) + col0;
                float* op = out + (size_t)row * 1024 + col0;
#pragma unroll
                for (int bj = 0; bj < 2; ++bj)
#pragma unroll
                    for (int n = 0; n < 2; ++n) { const f32x4 b = *(const f32x4*)(bp + bj * HALF + n * 16); *(f32x4*)(op + bj * HALF + n * 16) = b + gv[bj][n] * acc[ai][bj][m][n]; } }
    }
};
template <class Epi, class Sched, bool ALIGN_EPI = false, bool SP2 = false>
__device__ __forceinline__ void gemm_phase(PG8_LAS unsigned char* lds, const Gemm g, const Sched& S, const Epi& E) {
    const int tid = threadIdx.x, wid = __builtin_amdgcn_readfirstlane(tid >> 6), lane = tid & 63, wr = wid >> 2, wc = wid & 3, fr = lane & 15, fq = lane >> 4;
    const int K = g.K, nt = K / BK;
    unsigned voffA[2], voffB[2];
#pragma unroll
    for (int i = 0; i < 2; ++i) { int R, C; stage_rc(tid * 16 + i * 8192, R, C); const int Rb = Epi::PERM ? ((R & ~31) + perm32(R & 31)) : R;
        voffA[i] = (unsigned)(R * K + C) * 2u; voffB[i] = (unsigned)(Rb * K + C) * 2u; }
    const size_t kstep = (size_t)(BK * 2);
    const size_t hstep = (size_t)HALF * K * 2;
    const size_t tstep = 2 * hstep;
    const unsigned ldsw = (unsigned)wid * 1024u;
    const int aoff = lds_byte(wr * 64 + fr, fq * 8), boff = lds_byte(wc * 32 + fr, fq * 8);
#define PG8_SA(b, h) (((b) * 2 + (h)) * HTB)
#define PG8_SB(b, h) ((4 + (b) * 2 + (h)) * HTB)
#define PG8_STAGE(bufoff, gbase, voff) do { _Pragma("unroll") for (int _i = 0; _i < 2; ++_i) \
        __builtin_amdgcn_global_load_lds((const unsigned*)((const char*)(gbase) + (voff)[_i]), (PG8_LAS unsigned*)(lds + (bufoff) + ldsw + _i * 8192), 16, 0, 0); } while (0)
#define PG8_LDA(dst, b, h) do { _Pragma("unroll") for (int m = 0; m < 4; ++m) _Pragma("unroll") for (int k = 0; k < 2; ++k) dst[m][k] = *(const PG8_LAS bf16x8*)(lds + PG8_SA(b, h) + aoff + m * 2048 + k * 1024); } while (0)
#define PG8_LDB(dst, b, h) do { _Pragma("unroll") for (int n = 0; n < 2; ++n) _Pragma("unroll") for (int k = 0; k < 2; ++k) dst[n][k] = *(const PG8_LAS bf16x8*)(lds + PG8_SB(b, h) + boff + n * 2048 + k * 1024); } while (0)
#define PG8_MMA(ai, bj, At, Bt) do { __builtin_amdgcn_s_setprio(1); _Pragma("unroll") for (int m = 0; m < 4; ++m) _Pragma("unroll") for (int n = 0; n < 2; ++n) _Pragma("unroll") for (int k = 0; k < 2; ++k) \
        acc[ai][bj][m][n] = __builtin_amdgcn_mfma_f32_16x16x32_bf16(Bt[n][k], At[m][k], acc[ai][bj][m][n], 0, 0, 0); __builtin_amdgcn_s_setprio(0); } while (0)
#define PG8_WAIT_V(n) asm volatile("s_waitcnt vmcnt(" #n ")" ::: "memory")
#define PG8_WAIT_L(n) asm volatile("s_waitcnt lgkmcnt(" #n ")" ::: "memory")
#define PG8_BAR __builtin_amdgcn_s_barrier()
#define PG8_SCHED __builtin_amdgcn_sched_barrier(0)
    Unit cur, nxt; int ui = 0;
    if (!S.next(0, cur)) return;
    f32x4 acc[2][2][4][2];
#pragma unroll
    for (int a = 0; a < 2; ++a)
#pragma unroll
        for (int b = 0; b < 2; ++b)
#pragma unroll
            for (int m = 0; m < 4; ++m)
#pragma unroll
                for (int n = 0; n < 2; ++n) acc[a][b][m][n] = (f32x4){0.f, 0.f, 0.f, 0.f};
    bf16x8 At[4][2], B0[2][2], B1[2][2];
    const char* cA = (const char*)g.A + (size_t)cur.pm * tstep; const char* cB = (const char*)g.Bt + (size_t)cur.pn * tstep;
    S.a_ready(cur);
    if constexpr (SP2) {
        PG8_STAGE(PG8_SB(0, 0), cB, voffB); PG8_STAGE(PG8_SB(0, 1), cB + hstep, voffB); PG8_STAGE(PG8_SA(0, 0), cA, voffA); PG8_STAGE(PG8_SA(0, 1), cA + hstep, voffA);
        if (wr == 1) PG8_BAR;
        PG8_WAIT_V(2); PG8_BAR;
        PG8_STAGE(PG8_SB(1, 0), cB + kstep, voffB); PG8_STAGE(PG8_SA(1, 0), cA + kstep, voffA); PG8_STAGE(PG8_SB(1, 1), cB + hstep + kstep, voffB);
        PG8_WAIT_V(6); PG8_BAR;
    } else {
        PG8_STAGE(PG8_SB(0, 0), cB, voffB); PG8_STAGE(PG8_SA(0, 0), cA, voffA); PG8_STAGE(PG8_SB(0, 1), cB + hstep, voffB); PG8_STAGE(PG8_SA(0, 1), cA + hstep, voffA);
        if (wr == 1) PG8_BAR;
        PG8_WAIT_V(4); PG8_BAR;
        PG8_STAGE(PG8_SB(1, 0), cB + kstep, voffB); PG8_STAGE(PG8_SA(1, 0), cA + kstep, voffA); PG8_STAGE(PG8_SB(1, 1), cB + hstep + kstep, voffB);
        PG8_WAIT_V(6); PG8_BAR;
    }
    for (;;) {
        const bool has_next = S.next(ui + 1, nxt);
        const char* nA = has_next ? (const char*)g.A + (size_t)nxt.pm * tstep : cA; const char* nB = has_next ? (const char*)g.Bt + (size_t)nxt.pn * tstep : cB;
        for (int t = 0; t < nt; t += 2) {
            const bool last = (t == nt - 2);
            const char* a1 = cA + (size_t)(t + 1) * kstep;
            const char* a2 = last ? nA : cA + (size_t)(t + 2) * kstep; const char* b2 = last ? nB : cB + (size_t)(t + 2) * kstep;
            const char* a3 = a2 + kstep; const char* b3 = b2 + kstep;
            if (last && has_next) S.a_ready(nxt);
            if constexpr (SP2) {
            PG8_LDB(B0, 0, 0); PG8_LDB(B1, 0, 1); PG8_SCHED; PG8_LDA(At, 0, 0); PG8_STAGE(PG8_SA(1, 1), a1 + hstep, voffA);
            PG8_WAIT_V(8); PG8_WAIT_L(0); PG8_BAR; PG8_MMA(0, 0, At, B0); PG8_MMA(0, 1, At, B1); PG8_BAR; PG8_SCHED;
            PG8_LDA(At, 0, 1); PG8_STAGE(PG8_SB(0, 0), b2, voffB); PG8_STAGE(PG8_SB(0, 1), b2 + hstep, voffB); PG8_STAGE(PG8_SA(0, 0), a2, voffA);
            PG8_WAIT_V(8); PG8_WAIT_L(0); PG8_BAR; PG8_MMA(1, 0, At, B0); PG8_MMA(1, 1, At, B1); PG8_BAR; PG8_SCHED;
            PG8_LDB(B0, 1, 0); PG8_LDB(B1, 1, 1); PG8_SCHED; PG8_LDA(At, 1, 0); PG8_STAGE(PG8_SA(0, 1), a2 + hstep, voffA);
            PG8_WAIT_V(8); PG8_WAIT_L(0); PG8_BAR; PG8_MMA(0, 0, At, B0); PG8_MMA(0, 1, At, B1); PG8_BAR; PG8_SCHED;
            PG8_LDA(At, 1, 1); PG8_STAGE(PG8_SB(1, 0), b3, voffB); PG8_STAGE(PG8_SB(1, 1), b3 + hstep, voffB); PG8_STAGE(PG8_SA(1, 0), a3, voffA);
            PG8_WAIT_V(8); PG8_WAIT_L(0); PG8_BAR; PG8_MMA(1, 0, At, B0); PG8_MMA(1, 1, At, B1); PG8_BAR; PG8_SCHED;
            } else {
            PG8_LDB(B0, 0, 0); PG8_SCHED; PG8_LDA(At, 0, 0); PG8_STAGE(PG8_SA(1, 1), a1 + hstep, voffA);
            PG8_WAIT_L(8); PG8_BAR; PG8_WAIT_L(0); PG8_MMA(0, 0, At, B0); PG8_BAR; PG8_SCHED;
            PG8_LDB(B1, 0, 1); PG8_STAGE(PG8_SB(0, 0), b2, voffB);
            PG8_BAR; PG8_WAIT_L(0); PG8_MMA(0, 1, At, B1); PG8_BAR;
            PG8_LDA(At, 0, 1); PG8_STAGE(PG8_SA(0, 0), a2, voffA);
            PG8_BAR; PG8_WAIT_L(0); PG8_MMA(1, 0, At, B0); PG8_BAR; PG8_SCHED;
            PG8_STAGE(PG8_SB(0, 1), b2 + hstep, voffB);
            PG8_WAIT_V(6); PG8_BAR; PG8_MMA(1, 1, At, B1); PG8_BAR;
            PG8_LDB(B0, 1, 0); PG8_SCHED; PG8_LDA(At, 1, 0); PG8_STAGE(PG8_SA(0, 1), a2 + hstep, voffA);
            PG8_WAIT_L(8); PG8_BAR; PG8_WAIT_L(0); PG8_MMA(0, 0, At, B0); PG8_BAR; PG8_SCHED;
            PG8_LDB(B1, 1, 1); PG8_STAGE(PG8_SB(1, 0), b3, voffB);
            PG8_BAR; PG8_WAIT_L(0); PG8_MMA(0, 1, At, B1); PG8_BAR;
            PG8_LDA(At, 1, 1); PG8_STAGE(PG8_SA(1, 0), a3, voffA);
            PG8_BAR; PG8_WAIT_L(0); PG8_MMA(1, 0, At, B0); PG8_BAR; PG8_SCHED;
            PG8_STAGE(PG8_SB(1, 1), b3 + hstep, voffB);
            PG8_WAIT_V(6); PG8_BAR; PG8_MMA(1, 1, At, B1); PG8_BAR;
            }
        }
        if constexpr (ALIGN_EPI) { if (wr == 0) PG8_BAR; }
        if constexpr (!Epi::AFTER_DRAIN) { E(acc, cur, wr, wc, fr, fq); S.done(cur); }
        if (!has_next) break;
#pragma unroll
        for (int a = 0; a < 2; ++a)
#pragma unroll
            for (int b = 0; b < 2; ++b)
#pragma unroll
                for (int m = 0; m < 4; ++m)
#pragma unroll
                    for (int n = 0; n < 2; ++n) acc[a][b][m][n] = (f32x4){0.f, 0.f, 0.f, 0.f};
        cur = nxt; cA = nA; cB = nB; ++ui;
        if constexpr (ALIGN_EPI) { if (wr == 1) PG8_BAR; }
    }
    PG8_WAIT_V(0);
    if constexpr (!ALIGN_EPI) { if (wr == 0) PG8_BAR; }
    PG8_BAR;
    if constexpr (Epi::AFTER_DRAIN) { E.fused(acc, cur, wr, wc, fr, fq, lds, wid, lane); S.done(cur); }
#undef PG8_SA
#undef PG8_SB
#undef PG8_STAGE
#undef PG8_LDA
#undef PG8_LDB
#undef PG8_MMA
#undef PG8_WAIT_V
#undef PG8_WAIT_L
#undef PG8_BAR
#undef PG8_SCHED
}
}
constexpr int NWAVES = 8;
constexpr int DM = 1024, M_CTX = 4096, M_LAT = 16384, M_ALL = 20480, EVEN_IN = 4608, ODD_IN = 2048;
constexpr size_t MiB = 1u << 20;
constexpr size_t WS_CTL = 0, CTL_ZERO_BYTES = 1 * MiB;
constexpr size_t WS_MODS = 1 * MiB;
constexpr size_t WS_WIE = 2 * MiB, WS_WOE = 11 * MiB, WS_WIO = 13 * MiB, WS_WOO = 17 * MiB, WS_GW = 19 * MiB;
constexpr size_t WS_AGG = 20 * MiB;
constexpr size_t WS_H = 26 * MiB;
constexpr size_t WS_PROJ = 66 * MiB;
constexpr size_t WS_END = 246 * MiB;
constexpr size_t OUT_Y = 0, OUT_HG = 20971520, OUT_K = 23068672, OUT_V = 25165824, OUT_RG = 27262976, OUT_TOTAL = 27295744;
constexpr int CW_TMO = 0, CW_CODE = 1, CW_BAR = 4096, CW_QUEUE = 16384;
constexpr int RING_BYTES = 131072;
constexpr int LDS_BYTES = 162816, MISC_OFF = LDS_BYTES - 512;
constexpr int NPHASE = 12;

#define GAS __attribute__((address_space(1)))
#define LAS __attribute__((address_space(3)))
typedef unsigned short bf16;
typedef unsigned v4u __attribute__((ext_vector_type(4)));
typedef unsigned v2u __attribute__((ext_vector_type(2)));
typedef float f32x4 __attribute__((ext_vector_type(4)));
typedef float f32x16 __attribute__((ext_vector_type(16)));
typedef short bf16x8 __attribute__((ext_vector_type(8)));
typedef short s16x4 __attribute__((ext_vector_type(4)));
typedef GAS unsigned gu32;
#define RLX_AGENT __ATOMIC_RELAXED, __HIP_MEMORY_SCOPE_AGENT
#define LDS_WAIT() asm volatile("s_waitcnt lgkmcnt(0)" ::: "memory")
#define VM_WAIT() asm volatile("s_waitcnt vmcnt(0)" ::: "memory")
__device__ __forceinline__ unsigned f2bf(float f) { unsigned u = __builtin_bit_cast(unsigned, f); return (u + 0x7fffu + ((u >> 16) & 1u)) >> 16; }
__device__ __forceinline__ unsigned pk2(float lo, float hi) { return f2bf(lo) | (f2bf(hi) << 16); }
__device__ __forceinline__ float bf2f(unsigned b) { return __builtin_bit_cast(float, b << 16); }
__device__ __forceinline__ float bflo(unsigned w) { return __builtin_bit_cast(float, w << 16); }
__device__ __forceinline__ float bfhi(unsigned w) { return __builtin_bit_cast(float, w & 0xffff0000u); }
__device__ __forceinline__ float fexp(float x) { return __builtin_amdgcn_exp2f(x * 1.4426950408889634f); }
__device__ __forceinline__ float flog(float x) { return __builtin_amdgcn_logf(x) * 0.6931471805599453f; }
__device__ __forceinline__ float rcpf_(float x) { return __builtin_amdgcn_rcpf(x); }
__device__ __forceinline__ float sigmoidf(float x) { return rcpf_(1.0f + fexp(-x)); }
__device__ __forceinline__ float siluf(float x) { return x * rcpf_(1.0f + fexp(-x)); }
#define XB_TMO      128
#define XB_XCNT(j)  (256  + 64 * (j))
#define XB_XSUB(j)  (1280 + 64 * (j))
#define XB_XGEN(j)  (2304 + 64 * (j))
#define XB_TOP      3328
#define XB_TOPGEN   3392
#define XCD_BAR_WORDS 3456
#define XB_SPIN_CAP (1u << 18)

__device__ __forceinline__ unsigned xb_ld(unsigned* p)              { return __hip_atomic_load(p, __ATOMIC_RELAXED, __HIP_MEMORY_SCOPE_AGENT); }
__device__ __forceinline__ unsigned xb_add(unsigned* p, unsigned v) { return __hip_atomic_fetch_add(p, v, __ATOMIC_RELAXED, __HIP_MEMORY_SCOPE_AGENT); }
__device__ __forceinline__ unsigned xb_xcc_id() { return (unsigned)__builtin_amdgcn_s_getreg((3 << 11) | 20) & 0xFu; }
#define XB_SPIN(cond, bar) do { unsigned _sp = 0; while (cond) { __builtin_amdgcn_s_sleep(1); \
    if ((++_sp & 255u) == 0u) { if (xb_ld(&(bar)[XB_TMO])) break; if (_sp > XB_SPIN_CAP) { atomicAdd(&(bar)[XB_TMO], 1u); break; } } } } while (0)

struct XcdBarrier {
    unsigned* bar; unsigned x;
    volatile LAS unsigned* st;
};

__device__ __forceinline__ XcdBarrier xcd_barrier_post(unsigned* bar, volatile LAS unsigned* st) {
    XcdBarrier b; b.bar = bar; b.x = xb_xcc_id(); b.st = st;
    if (threadIdx.x == 0) (void)xb_add(&bar[XB_XCNT(b.x)], 1u);
    return b;
}
__device__ __forceinline__ void xcd_barrier_complete(unsigned* bar, unsigned x, unsigned& nloc, unsigned& nx) {
    const unsigned G = gridDim.x * gridDim.y * gridDim.z;
    unsigned sum, cnt, mine, sp = 0u;
    for (;;) {
        sum = 0u; cnt = 0u; mine = 0u;
#pragma unroll
        for (unsigned j = 0; j < 16; ++j) { const unsigned c = xb_ld(&bar[XB_XCNT(j)]); sum += c; cnt += (c > 0u) ? 1u : 0u; mine = (j == x) ? c : mine; }
        if (sum == G) break;
        __builtin_amdgcn_s_sleep(1);
        if ((++sp & 255u) == 0u) { if (xb_ld(&bar[XB_TMO])) break; if (sp > XB_SPIN_CAP) { atomicAdd(&bar[XB_TMO], 1u); break; } }
    }
    nloc = mine > 0u ? mine : 1u; nx = cnt > 0u ? cnt : 1u;
}

__device__ __forceinline__ void xcd_barrier(const XcdBarrier& b) {
    asm volatile("s_waitcnt vmcnt(0)" ::: "memory");
    __syncthreads();
    if (threadIdx.x == 0) {
        unsigned* bar = b.bar;
        __builtin_amdgcn_s_waitcnt(0);
        unsigned nloc = b.st[0], nx = b.st[1];
        if (nloc == 0u) { xcd_barrier_complete(bar, b.x, nloc, nx); b.st[0] = nloc; b.st[1] = nx; }
        const unsigned old = xb_add(&bar[XB_XSUB(b.x)], 1u);
        const unsigned gen = old / nloc;
        if (old + 1u == (gen + 1u) * nloc) {
            __builtin_amdgcn_fence(__ATOMIC_RELEASE, "agent");
            asm volatile("s_waitcnt vmcnt(0)" ::: "memory");
            const unsigned og = xb_add(&bar[XB_TOP], 1u);
            const unsigned tg = og / nx;
            if (og + 1u == (tg + 1u) * nx) xb_add(&bar[XB_TOPGEN], 1u);
            else XB_SPIN(xb_ld(&bar[XB_TOPGEN]) == tg, bar);
            __builtin_amdgcn_fence(__ATOMIC_ACQUIRE, "agent");
            xb_add(&bar[XB_XGEN(b.x)], 1u);
            asm volatile("s_waitcnt vmcnt(0)" ::: "memory");
        } else {
            XB_SPIN(xb_ld(&bar[XB_XGEN(b.x)]) == gen, bar);
            __builtin_amdgcn_fence(__ATOMIC_ACQUIRE, "agent");
            asm volatile("s_waitcnt vmcnt(0)" ::: "memory");
        }
    }
    __syncthreads();
}
struct Frame {
    unsigned char* lds;
    volatile LAS unsigned* MISC;
    gu32* ctl;
    int tid, lane, wave, vcu, G;
    const float* in[24];
    float* out; unsigned char* ws;
};
__device__ __forceinline__ float wave_sum(float v) {
#pragma unroll
    for (int o = 1; o < 64; o <<= 1) v += __shfl_xor(v, o);
    return v;
}
__device__ __forceinline__ void p0_transpose_item(const float* W, int K, int N, bf16* WT, float* scr, int item, int lane) {
    const int nblk = N / 32, kb = item / nblk, nb = item % nblk, k0 = 64 * kb, n0 = 32 * nb;
#pragma unroll 8
    for (int i = 0; i < 32; ++i) { const int kk = 2 * i + (lane >> 5); scr[kk * 33 + (lane & 31)] = W[(size_t)(k0 + kk) * N + n0 + (lane & 31)]; }
    LDS_WAIT(); asm volatile("" ::: "memory");
    const int c = lane & 7;
#pragma unroll
    for (int j = 0; j < 4; ++j) { const int n = (lane >> 3) + 8 * j; const float* s = scr + (8 * c) * 33 + n;
        v4u o; o.x = pk2(s[0 * 33], s[1 * 33]); o.y = pk2(s[2 * 33], s[3 * 33]); o.z = pk2(s[4 * 33], s[5 * 33]); o.w = pk2(s[6 * 33], s[7 * 33]);
        *(v4u*)(WT + (size_t)(n0 + n) * K + k0 + 8 * c) = o; }
    LDS_WAIT(); asm volatile("" ::: "memory");
}
__device__ __forceinline__ void p0_prologue(Frame& F) {
    float* mods = (float*)(F.ws + WS_MODS);
    for (int it = blockIdx.x; it < 96; it += F.G) {
        const int l = it / 48, c0 = (it % 48) * 64;
        float* S = (float*)F.lds;
        for (int idx = F.tid; idx < 9216; idx += NWAVES * 64) { const int n = idx >> 10, k = idx & 1023; const float v = n == 0 ? F.in[7][k] : F.in[6][(n - 1) * 1024 + k]; S[idx] = siluf(v); }
        __syncthreads();
        const float* W = F.in[9] + (size_t)l * 1024 * 3072 + c0 + F.lane;
        float acc[9];
#pragma unroll
        for (int n = 0; n < 9; ++n) acc[n] = 0.f;
        const int k0 = F.wave * 128;
#pragma unroll 4
        for (int kk = 0; kk < 128; ++kk) { const float wv = W[(size_t)(k0 + kk) * 3072];
#pragma unroll
            for (int n = 0; n < 9; ++n) acc[n] += S[n * 1024 + k0 + kk] * wv; }
        float* red = S + 9216;
#pragma unroll
        for (int n = 0; n < 9; ++n) red[(F.wave * 9 + n) * 64 + F.lane] = acc[n];
        __syncthreads();
        for (int idx = F.tid; idx < 576; idx += NWAVES * 64) { const int n = idx >> 6, ln = idx & 63; float s = F.in[10][l * 3072 + c0 + ln];
#pragma unroll
            for (int w = 0; w < 8; ++w) s += red[(w * 9 + n) * 64 + ln];
            mods[(size_t)(l * 9 + n) * 3072 + c0 + ln] = s; }
        __syncthreads();
    }
    float* scr = (float*)(F.lds + F.wave * 16384);
    const int gw = F.vcu * NWAVES + F.wave, NGW = F.G * NWAVES;
    constexpr int I0 = 16 * 144, I1 = 16 * 32, I2 = 16 * 64, I3 = 16 * 32, I4 = 32 * 8;
    for (int it = gw; it < I0 + I1 + I2 + I3 + I4; it += NGW) {
        int r = it;
        if (r < I0) { p0_transpose_item(F.in[11], 1024, 4608, (bf16*)(F.ws + WS_WIE), scr, r, F.lane); continue; } r -= I0;
        if (r < I1) { p0_transpose_item(F.in[12], 1024, 1024, (bf16*)(F.ws + WS_WOE), scr, r, F.lane); continue; } r -= I1;
        if (r < I2) { p0_transpose_item(F.in[16], 1024, 2048, (bf16*)(F.ws + WS_WIO), scr, r, F.lane); continue; } r -= I2;
        if (r < I3) { p0_transpose_item(F.in[17], 1024, 1024, (bf16*)(F.ws + WS_WOO), scr, r, F.lane); continue; } r -= I3;
        const int mat = r >> 3;
        p0_transpose_item(F.in[20] + (size_t)mat * 16384, 128, 128, (bf16*)(F.ws + WS_GW) + (size_t)mat * 16384, scr, r & 7, F.lane);
    }
}
__device__ __forceinline__ void modnorm_rows(Frame& F, int layer, const float* xa, const float* xb) {
    const float* mods = (const float*)(F.ws + WS_MODS) + (size_t)layer * 9 * 3072;
    const float* gain = F.in[8] + layer * 1024;
    bf16* H = (bf16*)(F.ws + WS_H);
    const int gw = F.vcu * NWAVES + F.wave, NGW = F.G * NWAVES;
    for (int m = gw; m < M_ALL; m += NGW) {
        const int n = m < M_CTX ? 0 : 1 + ((m - M_CTX) >> 11);
        const f32x4* xr = (const f32x4*)(m < M_CTX ? xa + (size_t)m * DM : xb + (size_t)(m - M_CTX) * DM) + F.lane;
        const f32x4* sh = (const f32x4*)(mods + (size_t)n * 3072) + F.lane; const f32x4* sc = (const f32x4*)(mods + (size_t)n * 3072 + 1024) + F.lane;
        const f32x4* gp = (const f32x4*)gain + F.lane;
        f32x4 v[4]; float s = 0.f;
#pragma unroll
        for (int j = 0; j < 4; ++j) { v[j] = xr[64 * j]; s += (v[j].x * v[j].x + v[j].y * v[j].y) + (v[j].z * v[j].z + v[j].w * v[j].w); }
        const float rstd = 1.0f / sqrtf(wave_sum(s) * (1.0f / DM) + 1e-6f);
        unsigned long long* o8 = (unsigned long long*)(H + (size_t)m * DM) + F.lane;
#pragma unroll
        for (int j = 0; j < 4; ++j) { const f32x4 g = gp[64 * j], a = sc[64 * j], b = sh[64 * j]; const f32x4 o = v[j] * rstd * g * (1.0f + a) + b;
            o8[64 * j] = (unsigned long long)pk2(o.x, o.y) | ((unsigned long long)pk2(o.z, o.w) << 32); }
    }
}
__device__ __forceinline__ void hgrn_naive_item(Frame& F, int item) {
    const int s = item >> 3, h = (item >> 1) & 3, d = item & 1;
    const bool lat = s >= 16; const int T = lat ? 2048 : 256; const int row0 = lat ? M_CTX + (s - 16) * 2048 : s * 256;
    bf16* P = (bf16*)(F.ws + WS_PROJ);
    float* Lq = (float*)F.lds; float* Lf = Lq + 128; float* Lk = Lf + 128; float* Lv = Lk + 128; float* Lp = Lv + 128;
    const int tid = F.tid, dv = tid & 127, kq = tid >> 7;
    const int zcol = (d == 0 ? 512 : 1024) + h * 128;
    float S[32];
    if (lat) { const float* s0 = F.in[2] + ((size_t)(((s - 16) * 2 + d) * 4 + h)) * 16384;
#pragma unroll
        for (int i = 0; i < 32; ++i) S[i] = s0[(32 * kq + i) * 128 + dv]; }
    else {
#pragma unroll
        for (int i = 0; i < 32; ++i) S[i] = 0.f; }
    float lbv = 0.f;
    if (tid < 128) { const float l0 = F.in[13][(d * 2 + 0) * 512 + h * 128 + tid], l1 = F.in[13][(d * 2 + 1) * 512 + h * 128 + tid]; lbv = 1.0f / (1.0f + __expf(l1 - l0)); }
    __syncthreads();
    for (int tt = 0; tt < T; ++tt) {
        const int tok = d == 0 ? tt : T - 1 - tt; const size_t rb = (size_t)(row0 + tok) * EVEN_IN;
        if (tid < 128) { const float z = bf2f(P[rb + zcol + tid]); const float sg = sigmoidf(z);
            Lf[tid] = lbv + (1.0f - lbv) * sg; Lk[tid] = (1.0f - lbv) * (1.0f - sg); Lq[tid] = bf2f(P[rb + h * 128 + tid]); }
        else if (tid < 256) Lv[tid - 128] = bf2f(P[rb + 1536 + h * 128 + (tid - 128)]);
        __syncthreads();
        const float v = Lv[dv]; float part = 0.f;
#pragma unroll
        for (int i = 0; i < 32; ++i) { const int dk = 32 * kq + i; S[i] = Lf[dk] * S[i] + Lk[dk] * v; part += S[i] * Lq[dk]; }
        Lp[kq * 128 + dv] = part;
        __syncthreads();
        if (tid < 128) { const float o = (Lp[tid] + Lp[128 + tid]) + (Lp[256 + tid] + Lp[384 + tid]); P[rb + zcol + tid] = (bf16)f2bf(o); }
    }
    if (!lat) { float* so = F.out + OUT_HG + ((size_t)((s * 2 + d) * 4 + h)) * 16384;
#pragma unroll
        for (int i = 0; i < 32; ++i) so[(32 * kq + i) * 128 + dv] = S[i]; }
    __syncthreads();
}
__device__ __forceinline__ float dot64_bf(const float* qs, const bf16* kp) {
    float dot = 0.f;
    for (int e = 0; e < 8; ++e) { const v4u w = ((const v4u*)kp)[e]; const float* q = qs + 8 * e;
        dot += (q[0] * bflo(w.x) + q[1] * bfhi(w.x)) + (q[2] * bflo(w.y) + q[3] * bfhi(w.y)) + (q[4] * bflo(w.z) + q[5] * bfhi(w.z)) + (q[6] * bflo(w.w) + q[7] * bfhi(w.w)); }
    return dot;
}
__device__ __forceinline__ void attn_naive_item(Frame& F, int it) {
    const int m = it >> 3, head = it & 7, lane = F.lane;
    bf16* P = (bf16*)(F.ws + WS_PROJ);
    float* qs = (float*)(F.lds + F.wave * 2048); float* ps = qs + 64;
    qs[lane] = bf2f(P[(size_t)m * EVEN_IN + 2560 + head * 64 + lane]);
    LDS_WAIT(); asm volatile("" ::: "memory");
    float sc[6]; int nk;
    const bool lat = m >= M_CTX;
    int b = 0, r = 0, c = 0, rs = 0, wsx = 0;
    if (lat) { b = (m - M_CTX) >> 11; const int t = (m - M_CTX) & 2047; r = t >> 6; c = t & 63; rs = min(max(r - 4, 0), 24); wsx = min(max(c - 8, 0), 48); nk = 6; } else { b = m >> 8; nk = 4; }
#pragma unroll
    for (int i = 0; i < 6; ++i) {
        sc[i] = -1e30f;
        if (i < nk) {
            const int j = lane + 64 * i; float dot = 0.f, bias = 0.f;
            if (lat && i < 2) { const int kr = j >> 4, kc = j & 15; const int tk = (rs + kr) * 64 + wsx + kc;
                dot = dot64_bf(qs, P + (size_t)(M_CTX + b * 2048 + tk) * EVEN_IN + 3072 + head * 64);
                bias = F.in[15][(head * 15 + (rs + kr - r + 7)) * 31 + (wsx + kc - c + 15)]; }
            else if (lat) { const float* kp = F.in[3] + ((size_t)(b * 8 + head) * 256 + (j - 128)) * 64;
                for (int e = 0; e < 16; ++e) { const f32x4 kv = ((const f32x4*)kp)[e]; dot += (qs[4 * e] * kv.x + qs[4 * e + 1] * kv.y) + (qs[4 * e + 2] * kv.z + qs[4 * e + 3] * kv.w); } }
            else dot = dot64_bf(qs, P + (size_t)(b * 256 + j) * EVEN_IN + 3072 + head * 64);
            sc[i] = dot * 0.125f + bias;
        }
    }
    float mx = sc[0];
#pragma unroll
    for (int i = 1; i < 6; ++i) mx = fmaxf(mx, sc[i]);
#pragma unroll
    for (int o = 1; o < 64; o <<= 1) mx = fmaxf(mx, __shfl_xor(mx, o));
    float sum = 0.f;
#pragma unroll
    for (int i = 0; i < 6; ++i) { sc[i] = (i < nk) ? __expf(sc[i] - mx) : 0.f; sum += sc[i]; }
    sum = wave_sum(sum); const float inv = 1.0f / sum;
#pragma unroll
    for (int i = 0; i < 6; ++i) if (i < nk) ps[lane + 64 * i] = sc[i] * inv;
    LDS_WAIT(); asm volatile("" ::: "memory");
    float o = 0.f;
    if (lat) {
        for (int j = 0; j < 128; ++j) { const int kr = j >> 4, kc = j & 15; const int tk = (rs + kr) * 64 + wsx + kc;
            o += ps[j] * bf2f(P[(size_t)(M_CTX + b * 2048 + tk) * EVEN_IN + 3584 + head * 64 + lane]); }
        const float* vp = F.in[4] + ((size_t)(b * 8 + head) * 256) * 64 + lane;
        for (int j = 0; j < 256; ++j) o += ps[128 + j] * vp[(size_t)j * 64];
    } else {
        for (int j = 0; j < 256; ++j) o += ps[j] * bf2f(P[(size_t)(b * 256 + j) * EVEN_IN + 3584 + head * 64 + lane]);
    }
    P[(size_t)m * EVEN_IN + 2560 + head * 64 + lane] = (bf16)f2bf(o);
    LDS_WAIT(); asm volatile("" ::: "memory");
}
constexpr size_t WS_RGF = WS_PROJ + 80 * MiB, WS_RGB = WS_PROJ + 120 * MiB;
__device__ __forceinline__ void rg_naive_item(Frame& F, int item) {
    const int s = item >> 4, hb = (item >> 1) & 7, d = item & 1;
    const bool lat = s >= 16; const int T = lat ? 2048 : 256; const int row0 = lat ? M_CTX + (s - 16) * 2048 : s * 256;
    const bf16* P2 = (const bf16*)(F.ws + WS_PROJ);
    bf16* O = (bf16*)(F.ws + (d == 0 ? WS_RGF : WS_RGB));
    float* XB = (float*)F.lds; float* XC = XB + 19 * 128; float* GG = XC + 16 * 128;
    const int tid = F.tid;
    float hst = 0.f, sp = 0.f;
    if (tid < 128) { if (lat) hst = F.in[5][((s - 16) * 2 + d) * 1024 + hb * 128 + tid]; const float lam = F.in[22][d * 1024 + hb * 128 + tid]; sp = log1pf(__expf(-lam)); }
    for (int k = 0; k < T / 16; ++k) {
        const int tb = d == 0 ? 16 * k : T - 16 * (k + 1);
        for (int idx = tid; idx < 19 * 128; idx += NWAVES * 64) { const int hr = idx >> 7, ch = idx & 127, tok = tb + hr - 2;
            XB[idx] = (tok >= 0 && tok < T) ? bf2f(P2[(size_t)(row0 + tok) * ODD_IN + hb * 128 + ch]) : 0.f; }
        __syncthreads();
        for (int idx = tid; idx < 16 * 128; idx += NWAVES * 64) { const int t = idx >> 7, ch = idx & 127; float a = F.in[19][hb * 128 + ch];
#pragma unroll
            for (int j = 0; j < 4; ++j) a += F.in[18][j * 1024 + hb * 128 + ch] * XB[(t + j) * 128 + ch];
            XC[idx] = a; }
        __syncthreads();
        { const int g = tid >> 8, th = (tid >> 7) & 1, j = tid & 127;
          const float* w = F.in[20] + ((size_t)((d * 2 + g) * 8 + hb) * 128) * 128 + j;
          float acc[8];
#pragma unroll
          for (int t = 0; t < 8; ++t) acc[t] = 0.f;
          for (int i = 0; i < 128; ++i) { const float wv = w[(size_t)i * 128];
#pragma unroll
              for (int t = 0; t < 8; ++t) acc[t] += XC[(th * 8 + t) * 128 + i] * wv; }
          const float gb = F.in[21][(d * 2 + g) * 1024 + hb * 128 + j];
#pragma unroll
          for (int t = 0; t < 8; ++t) GG[(g * 16 + th * 8 + t) * 128 + j] = sigmoidf(acc[t] + gb); }
        __syncthreads();
        if (tid < 128) {
            for (int tt = 0; tt < 16; ++tt) { const int t = d == 0 ? tt : 15 - tt;
                const float rr = GG[t * 128 + tid], ii = GG[(16 + t) * 128 + tid];
                const float la = -8.0f * rr * sp; const float a = __expf(la); const float u = sqrtf(-expm1f(2.0f * la)) * (ii * XC[t * 128 + tid]);
                hst = a * hst + u;
                O[(size_t)(row0 + tb + t) * DM + hb * 128 + tid] = (bf16)f2bf(hst); } }
        __syncthreads();
    }
    if (!lat && tid < 128) F.out[OUT_RG + (s * 2 + d) * 1024 + hb * 128 + tid] = hst;
}
__device__ __forceinline__ void gate_even_rows(Frame& F) {
    const bf16* P = (const bf16*)(F.ws + WS_PROJ); bf16* Y = (bf16*)(F.ws + WS_H);
    const int gw = F.vcu * NWAVES + F.wave, NGW = F.G * NWAVES, lane = F.lane;
    const f32x4 g0 = ((const f32x4*)F.in[14])[lane * 2], g1 = ((const f32x4*)F.in[14])[lane * 2 + 1];
    const float gain[8] = {g0.x, g0.y, g0.z, g0.w, g1.x, g1.y, g1.z, g1.w};
    for (int m = gw; m < M_ALL; m += NGW) {
        const bf16* pr = P + (size_t)m * EVEN_IN + lane * 8;
        const v4u wf = *(const v4u*)(pr + 512), wb = *(const v4u*)(pr + 1024), wga = *(const v4u*)(pr + 2048), wo = *(const v4u*)(pr + 2560), wgb = *(const v4u*)(pr + 4096);
        float o[8], ga[8], ob[8], gb[8];
#pragma unroll
        for (int e = 0; e < 4; ++e) { o[2 * e] = bflo(wf[e]) + bflo(wb[e]); o[2 * e + 1] = bfhi(wf[e]) + bfhi(wb[e]); ga[2 * e] = bflo(wga[e]); ga[2 * e + 1] = bfhi(wga[e]);
            ob[2 * e] = bflo(wo[e]); ob[2 * e + 1] = bfhi(wo[e]); gb[2 * e] = bflo(wgb[e]); gb[2 * e + 1] = bfhi(wgb[e]); }
        float ss = 0.f;
#pragma unroll
        for (int e = 0; e < 8; ++e) ss += o[e] * o[e];
        ss += __shfl_xor(ss, 1); ss += __shfl_xor(ss, 2); ss += __shfl_xor(ss, 4); ss += __shfl_xor(ss, 8);
        const float rstd = 1.0f / sqrtf(ss * (1.0f / 128.0f) + 1e-6f);
        float ya[8], yb[8];
#pragma unroll
        for (int e = 0; e < 8; ++e) { ya[e] = o[e] * rstd * gain[e] * siluf(ga[e]); yb[e] = ob[e] * siluf(gb[e]); }
        v4u wa, wbo;
#pragma unroll
        for (int e = 0; e < 4; ++e) { wa[e] = pk2(ya[2 * e], ya[2 * e + 1]); wbo[e] = pk2(yb[2 * e], yb[2 * e + 1]); }
        bf16* yr = Y + (size_t)m * DM + lane * 8;
        *(v4u*)yr = wa; *(v4u*)(yr + 512) = wbo;
    }
}
__device__ __forceinline__ void rg_combine_rows(Frame& F) {
    const bf16* P2 = (const bf16*)(F.ws + WS_PROJ); const bf16* OF = (const bf16*)(F.ws + WS_RGF); const bf16* OB = (const bf16*)(F.ws + WS_RGB); bf16* Y = (bf16*)(F.ws + WS_H);
    const int gw = F.vcu * NWAVES + F.wave, NGW = F.G * NWAVES, lane = F.lane;
    for (int m = gw; m < M_ALL; m += NGW) {
#pragma unroll
        for (int part = 0; part < 2; ++part) { const int c0 = part * 512 + lane * 8;
            const v4u a = *(const v4u*)(OF + (size_t)m * DM + c0), b = *(const v4u*)(OB + (size_t)m * DM + c0), g = *(const v4u*)(P2 + (size_t)m * ODD_IN + 1024 + c0);
            v4u w;
#pragma unroll
            for (int e = 0; e < 4; ++e) w[e] = pk2((bflo(a[e]) + bflo(b[e])) * siluf(bflo(g[e])), (bfhi(a[e]) + bfhi(b[e])) * siluf(bfhi(g[e])));
            *(v4u*)(Y + (size_t)m * DM + c0) = w; }
    }
}
__device__ __forceinline__ void final_norm_rows(Frame& F) {
    const int gw = F.vcu * NWAVES + F.wave, NGW = F.G * NWAVES;
    const f32x4* gp = (const f32x4*)F.in[23] + F.lane;
    for (int m = gw; m < M_ALL; m += NGW) {
        f32x4* xr = (f32x4*)(F.out + (size_t)m * DM) + F.lane;
        f32x4 v[4]; float s = 0.f;
#pragma unroll
        for (int j = 0; j < 4; ++j) { v[j] = xr[64 * j]; s += (v[j].x * v[j].x + v[j].y * v[j].y) + (v[j].z * v[j].z + v[j].w * v[j].w); }
        const float rstd = 1.0f / sqrtf(wave_sum(s) * (1.0f / DM) + 1e-6f);
#pragma unroll
        for (int j = 0; j < 4; ++j) xr[64 * j] = v[j] * rstd * gp[64 * j];
    }
}
typedef float f32x2_t __attribute__((ext_vector_type(2))); typedef __bf16 bf16x2_t __attribute__((ext_vector_type(2)));
__device__ __forceinline__ unsigned cvtpk(float lo, float hi) { f32x2_t v = {lo, hi}; bf16x2_t b = __builtin_convertvector(v, bf16x2_t); return __builtin_bit_cast(unsigned, b); }
#define MFMA32(a, b, c) __builtin_amdgcn_mfma_f32_32x32x16_bf16((a), (b), (c), 0, 0, 0)
template <int ST> __device__ __forceinline__ bf16x8 pack8(const f32x16& x) {
    v4u p; p.x = cvtpk(x[8 * ST], x[8 * ST + 1]); p.y = cvtpk(x[8 * ST + 2], x[8 * ST + 3]); p.z = cvtpk(x[8 * ST + 4], x[8 * ST + 5]); p.w = cvtpk(x[8 * ST + 6], x[8 * ST + 7]);
    return __builtin_bit_cast(bf16x8, p);
}
__device__ __forceinline__ bf16x8 cat4(s16x4 lo, s16x4 hi) { return __builtin_shufflevector(lo, hi, 0, 1, 2, 3, 4, 5, 6, 7); }
constexpr int HG_QD = 0, HG_KI = 8704, HG_KDT = 17408, HG_VT = 27648, HG_DEC = 37888, HG_BUF = 38400, HG_RAW = 76800;
__device__ __forceinline__ void hgrn_mfma_item(Frame& F, int item) {
    const int s = item >> 3, h = (item >> 1) & 3, d = item & 1;
    const bool lat = s >= 16; const int T = lat ? 2048 : 256; const int row0 = lat ? M_CTX + (s - 16) * 2048 : s * 256; const int nch = T / 32;
    bf16* P = (bf16*)(F.ws + WS_PROJ);
    LAS unsigned char* L = (LAS unsigned char*)F.lds;
    const int zcol = (d == 0 ? 512 : 1024) + h * 128;
    const int lane = F.lane, r = lane & 31, hh = lane >> 5;
    if (F.wave >= 4) {
        const int pw = F.wave - 4, dk = 32 * pw + r;
        const float l0 = F.in[13][(d * 2 + 0) * 512 + h * 128 + dk], l1 = F.in[13][(d * 2 + 1) * 512 + h * 128 + dk];
        const float lbv = 1.0f / (1.0f + __expf(l1 - l0)), omlb = 1.0f - lbv;
        const int pt = F.tid - 256;
        v4u az[2], aq[2], av[2], bz[2], bq[2], bv[2];
#define HG_ISSUE(Z, Q, V, n) do { _Pragma("unroll") for (int j = 0; j < 2; ++j) { const int piece = pt + 256 * j, i = piece >> 4, oct = piece & 15; const int tok = d == 0 ? 32 * (n) + i : T - 1 - (32 * (n) + i); \
            const bf16* pr = P + (size_t)(row0 + tok) * EVEN_IN + oct * 8; Z[j] = *(const v4u*)(pr + zcol); Q[j] = *(const v4u*)(pr + h * 128); V[j] = *(const v4u*)(pr + 1536 + h * 128); } } while (0)
#define HG_WRITE(Z, Q, V, n) do { LAS unsigned char* RB = L + HG_RAW + ((n) & 1) * 24576; _Pragma("unroll") for (int j = 0; j < 2; ++j) { const int piece = pt + 256 * j; \
            *(LAS v4u*)(RB + piece * 16) = Z[j]; *(LAS v4u*)(RB + 8192 + piece * 16) = Q[j]; *(LAS v4u*)(RB + 16384 + piece * 16) = V[j]; } } while (0)
#define HG_PREP(n) do { LAS unsigned char* B = L + ((n) & 1) * HG_BUF; const LAS unsigned char* RB = L + HG_RAW + ((n) & 1) * 24576 + dk * 2; \
            float lf[16], kk[16]; float tot = 0.f; \
            _Pragma("unroll") for (int ii = 0; ii < 16; ++ii) { const float z = bf2f(*(const LAS unsigned short*)(RB + (16 * hh + ii) * 256)); const float sg = rcpf_(1.0f + fexp(-z)); const float f = lbv + omlb * sg; lf[ii] = flog(f); kk[ii] = omlb * (1.0f - sg); tot += lf[ii]; } \
            const float other = __shfl_xor(tot, 32); const float bend = tot + other, ebend = fexp(bend); float b = hh ? other : 0.f; \
            unsigned kd[8], vv[8]; \
            _Pragma("unroll") for (int ii = 0; ii < 16; ++ii) { b += lf[ii]; const int i = 16 * hh + ii; const float eb = fexp(b), ki = kk[ii] * rcpf_(eb); \
                const float qd = bf2f(*(const LAS unsigned short*)(RB + 8192 + i * 256)) * eb, kdv = ki * ebend; const unsigned vraw = *(const LAS unsigned short*)(RB + 16384 + i * 256); \
                *(LAS unsigned short*)(B + HG_QD + i * 272 + dk * 2) = (unsigned short)f2bf(qd); \
                *(LAS unsigned short*)(B + HG_KI + i * 272 + dk * 2) = (unsigned short)f2bf(ki); \
                if (ii & 1) { kd[ii >> 1] |= f2bf(kdv) << 16; vv[ii >> 1] |= vraw << 16; } else { kd[ii >> 1] = f2bf(kdv); vv[ii >> 1] = vraw; } } \
            *(LAS v4u*)(B + HG_KDT + dk * 80 + hh * 32) = (v4u){kd[0], kd[1], kd[2], kd[3]}; *(LAS v4u*)(B + HG_KDT + dk * 80 + hh * 32 + 16) = (v4u){kd[4], kd[5], kd[6], kd[7]}; \
            *(LAS v4u*)(B + HG_VT + dk * 80 + hh * 32) = (v4u){vv[0], vv[1], vv[2], vv[3]}; *(LAS v4u*)(B + HG_VT + dk * 80 + hh * 32 + 16) = (v4u){vv[4], vv[5], vv[6], vv[7]}; \
            if (hh == 0) *(LAS float*)(B + HG_DEC + dk * 4) = ebend; } while (0)
        HG_ISSUE(az, aq, av, 0); HG_ISSUE(bz, bq, bv, 1);
        HG_WRITE(az, aq, av, 0); HG_ISSUE(az, aq, av, 2);
        __syncthreads();
        for (int n = 0; n < nch; n += 2) {
            HG_WRITE(bz, bq, bv, n + 1); if (n + 3 < nch) HG_ISSUE(bz, bq, bv, n + 3);
            HG_PREP(n);
            __syncthreads();
            if (n + 2 < nch) { HG_WRITE(az, aq, av, n + 2); if (n + 4 < nch) HG_ISSUE(az, aq, av, n + 4); }
            HG_PREP(n + 1);
            __syncthreads();
        }
        __syncthreads();
#undef HG_ISSUE
#undef HG_WRITE
#undef HG_PREP
    } else {
        const int w = F.wave, dvc = 32 * w + r; const long osgn = d == 0 ? 1 : -1;
        f32x16 S[4];
        if (lat) { const float* s0 = F.in[2] + ((size_t)(((s - 16) * 2 + d) * 4 + h)) * 16384;
#pragma unroll
            for (int i = 0; i < 4; ++i)
#pragma unroll
                for (int g = 0; g < 16; ++g) S[i][g] = s0[(32 * i + (g & 3) + 8 * (g >> 2) + 4 * hh) * 128 + dvc]; }
        else {
#pragma unroll
            for (int i = 0; i < 4; ++i)
#pragma unroll
                for (int g = 0; g < 16; ++g) S[i][g] = 0.f; }
        __syncthreads();
        __syncthreads();
        for (int n = 0; n < nch; ++n) {
            LAS unsigned char* B = L + (n & 1) * HG_BUF;
#define HG_FENCE() asm volatile("" ::: "memory")
            bf16x8 ka[8], qb[8];
#pragma unroll
            for (int st = 0; st < 8; ++st) { ka[st] = *(const LAS bf16x8*)(B + HG_KI + r * 272 + (16 * st + 8 * hh) * 2); qb[st] = *(const LAS bf16x8*)(B + HG_QD + r * 272 + (16 * st + 8 * hh) * 2); }
            HG_FENCE();
            f32x16 X;
#pragma unroll
            for (int g = 0; g < 16; ++g) X[g] = 0.f;
#pragma unroll
            for (int st = 0; st < 8; ++st) X = MFMA32(ka[st], qb[st], X);
            s16x4 ql[8], qh[8], vl[2], vh[2];
#pragma unroll
            for (int j = 0; j < 8; ++j) { const LAS unsigned char* qd = B + HG_QD + r * 272 + 32 * j + 8 * hh; ql[j] = *(const LAS s16x4*)(qd); qh[j] = *(const LAS s16x4*)(qd + 16); }
            { const LAS unsigned char* vt = B + HG_VT + dvc * 80 + 8 * hh;
              vl[0] = *(const LAS s16x4*)(vt); vh[0] = *(const LAS s16x4*)(vt + 16); vl[1] = *(const LAS s16x4*)(vt + 32); vh[1] = *(const LAS s16x4*)(vt + 48); }
            bf16x8 kd[8], vb[2];
#pragma unroll
            for (int i = 0; i < 4; ++i)
#pragma unroll
                for (int st = 0; st < 2; ++st) kd[2 * i + st] = *(const LAS bf16x8*)(B + HG_KDT + (32 * i + r) * 80 + (16 * st + 8 * hh) * 2);
#pragma unroll
            for (int st = 0; st < 2; ++st) vb[st] = *(const LAS bf16x8*)(B + HG_VT + dvc * 80 + (16 * st + 8 * hh) * 2);
            HG_FENCE();
#pragma unroll
            for (int g = 0; g < 16; ++g) { const int sr = (g & 3) + 8 * (g >> 2) + 4 * hh; X[g] = sr <= r ? X[g] : 0.f; }
            const bf16x8 xa0 = pack8<0>(X), xa1 = pack8<1>(X);
            f32x16 O;
#pragma unroll
            for (int g = 0; g < 16; ++g) O[g] = 0.f;
#pragma unroll
            for (int i = 0; i < 4; ++i) { O = MFMA32(cat4(ql[2 * i], qh[2 * i]), pack8<0>(S[i]), O); O = MFMA32(cat4(ql[2 * i + 1], qh[2 * i + 1]), pack8<1>(S[i]), O); }
            O = MFMA32(xa0, cat4(vl[0], vh[0]), O);
            O = MFMA32(xa1, cat4(vl[1], vh[1]), O);
            HG_FENCE();
            f32x4 dc[16];
#pragma unroll
            for (int i = 0; i < 4; ++i)
#pragma unroll
                for (int G = 0; G < 4; ++G) dc[4 * i + G] = *(const LAS f32x4*)(B + HG_DEC + (32 * i + 8 * G + 4 * hh) * 4);
            HG_FENCE();
#pragma unroll
            for (int i = 0; i < 4; ++i) {
#pragma unroll
                for (int g = 0; g < 16; ++g) S[i][g] *= dc[4 * i + (g >> 2)][g & 3];
                S[i] = MFMA32(kd[2 * i], vb[0], S[i]); S[i] = MFMA32(kd[2 * i + 1], vb[1], S[i]); }
            { bf16* ob = P + (size_t)(row0 + (d == 0 ? 32 * n + 4 * hh : T - 1 - 32 * n - 4 * hh)) * EVEN_IN + zcol + dvc;
#pragma unroll
              for (int g = 0; g < 16; ++g) ob[osgn * (long)(((g & 3) + 8 * (g >> 2)) * EVEN_IN)] = (bf16)f2bf(O[g]); }
#undef HG_FENCE
            __syncthreads();
        }
        if (!lat) { float* so = F.out + OUT_HG + ((size_t)((s * 2 + d) * 4 + h)) * 16384;
#pragma unroll
            for (int i = 0; i < 4; ++i)
#pragma unroll
                for (int g = 0; g < 16; ++g) so[(32 * i + (g & 3) + 8 * (g >> 2) + 4 * hh) * 128 + dvc] = S[i][g]; }
    }
}
#define MFMA16(a, b, c) __builtin_amdgcn_mfma_f32_16x16x32_bf16((a), (b), (c), 0, 0, 0)
typedef short v4i16_t __attribute__((ext_vector_type(4)));
__device__ __forceinline__ s16x4 vtr(const LAS unsigned char* p) { return __builtin_bit_cast(s16x4, __builtin_amdgcn_ds_read_tr16_b64_v4i16((LAS v4i16_t*)p)); }
__device__ __forceinline__ bf16x8 pack44(const f32x4& a, const f32x4& b) { v4u p; p.x = cvtpk(a[0], a[1]); p.y = cvtpk(a[2], a[3]); p.z = cvtpk(b[0], b[1]); p.w = cvtpk(b[2], b[3]); return __builtin_bit_cast(bf16x8, p); }
constexpr int AT_VL = 0, AT_KC = 73728, AT_VC = AT_KC + 36864, AT_BT = AT_VC + 32768, AT_END = AT_BT + 2048;
static_assert(AT_END <= MISC_OFF, "attention LDS map");
template <bool LOCAL> __device__ __forceinline__ void attn_mfma_item(Frame& F, int item, int scr = 0) {
    LAS unsigned char* L = (LAS unsigned char*)F.lds;
    bf16* P = (bf16*)(F.ws + WS_PROJ);
    const int tid = F.tid, lane = F.lane, fr = lane & 15, fq = lane >> 4, w = F.wave;
    int b, head, rp = 0, half = 0, rs0 = 0;
    if (LOCAL) { b = item >> 7; head = (item >> 4) & 7; rp = item & 15; rs0 = min(max(2 * rp - 4, 0), 24); }
    else { b = item >> 4; head = (item >> 1) & 7; half = item & 1; }
    if (LOCAL) {
        const int nrows = min(9, 32 - rs0);
        for (int c = tid; c < nrows * 512; c += NWAVES * 64) { const int key = c >> 3, ch = c & 7;
            *(LAS v4u*)(L + AT_VL + key * 128 + ch * 16) = *(const v4u*)(P + (size_t)(M_CTX + b * 2048 + rs0 * 64 + key) * EVEN_IN + 3584 + head * 64 + ch * 8); }
        const float* kc = F.in[3] + (size_t)(b * 8 + head) * 16384; const float* vc = F.in[4] + (size_t)(b * 8 + head) * 16384;
        for (int c = tid; c < 2048; c += NWAVES * 64) { const int key = c >> 3, ch = c & 7;
            const f32x4 a0 = *(const f32x4*)(kc + key * 64 + ch * 8), a1 = *(const f32x4*)(kc + key * 64 + ch * 8 + 4);
            *(LAS v4u*)(L + AT_KC + key * 144 + ch * 16) = (v4u){pk2(a0.x, a0.y), pk2(a0.z, a0.w), pk2(a1.x, a1.y), pk2(a1.z, a1.w)};
            const f32x4 b0 = *(const f32x4*)(vc + key * 64 + ch * 8), b1 = *(const f32x4*)(vc + key * 64 + ch * 8 + 4);
            *(LAS v4u*)(L + AT_VC + key * 128 + ch * 16) = (v4u){pk2(b0.x, b0.y), pk2(b0.z, b0.w), pk2(b1.x, b1.y), pk2(b1.z, b1.w)}; }
        for (int i = tid; i < 465; i += NWAVES * 64) ((LAS float*)(L + AT_BT))[i] = F.in[15][head * 465 + i];
    } else {
        for (int c = tid; c < 2048; c += NWAVES * 64) { const int key = c >> 3, ch = c & 7; const bf16* pr = P + (size_t)(b * 256 + key) * EVEN_IN + head * 64 + ch * 8;
            *(LAS v4u*)(L + AT_KC + key * 144 + ch * 16) = *(const v4u*)(pr + 3072); *(LAS v4u*)(L + AT_VC + key * 128 + ch * 16) = *(const v4u*)(pr + 3584); }
    }
    const int ri = w >> 2, jb = w & 3, r = 2 * rp + ri;
    const int qbase = LOCAL ? M_CTX + b * 2048 + r * 64 + 16 * jb : b * 256 + half * 128 + 16 * w;
    const bf16* qp = P + (size_t)(qbase + fr) * EVEN_IN + 2560 + head * 64 + 8 * fq;
    const bf16x8 qf0 = *(const bf16x8*)qp, qf1 = *(const bf16x8*)(qp + 32);
    __syncthreads();
    const int trow = fr >> 2, tcol = (fr & 3) * 8;
    f32x4 O1[4];
#pragma unroll
    for (int dt = 0; dt < 4; ++dt) O1[dt] = (f32x4){0.f, 0.f, 0.f, 0.f};
    float mx1 = -1e30f, l1 = 0.f;
    {
        f32x4 sc[16];
#pragma unroll
        for (int kt = 0; kt < 16; ++kt) { const LAS unsigned char* kp = L + AT_KC + (16 * kt + fr) * 144 + 16 * fq;
            f32x4 acc = {0.f, 0.f, 0.f, 0.f}; acc = MFMA16(*(const LAS bf16x8*)kp, qf0, acc); acc = MFMA16(*(const LAS bf16x8*)(kp + 64), qf1, acc);
            acc = acc * 0.125f; sc[kt] = acc; mx1 = fmaxf(fmaxf(mx1, fmaxf(acc[0], acc[1])), fmaxf(acc[2], acc[3])); }
        mx1 = fmaxf(mx1, __shfl_xor(mx1, 16)); mx1 = fmaxf(mx1, __shfl_xor(mx1, 32));
#pragma unroll
        for (int kt = 0; kt < 16; ++kt)
#pragma unroll
            for (int e = 0; e < 4; ++e) { const float p = fexp(sc[kt][e] - mx1); sc[kt][e] = p; l1 += p; }
        l1 += __shfl_xor(l1, 16); l1 += __shfl_xor(l1, 32);
#pragma unroll
        for (int c = 0; c < 8; ++c) { const bf16x8 pa = pack44(sc[2 * c], sc[2 * c + 1]);
            const LAS unsigned char* v0 = L + AT_VC + (32 * c + 4 * fq + trow) * 128 + tcol;
#pragma unroll
            for (int dt = 0; dt < 4; ++dt) O1[dt] = MFMA16(pa, cat4(vtr(v0 + dt * 32), vtr(v0 + 16 * 128 + dt * 32)), O1[dt]); }
    }
    float f1 = 1.0f / l1, f2 = 0.f;
    f32x4 O2[4];
#pragma unroll
    for (int dt = 0; dt < 4; ++dt) O2[dt] = (f32x4){0.f, 0.f, 0.f, 0.f};
    if (LOCAL) {
        const int rs = min(max(r - 4, 0), 24), band = jb == 0 ? 0 : (jb == 1 ? 8 : (jb == 2 ? 24 : 32));
        const int qc = 16 * jb + fr, wsx = min(max(qc - 8, 0), 48);
        f32x4 sl[16]; float mx2 = -1e30f, l2 = 0.f;
#pragma unroll
        for (int kr = 0; kr < 8; ++kr)
#pragma unroll
            for (int hf = 0; hf < 2; ++hf) { const int tok = (rs + kr) * 64 + band + 16 * hf + fr;
                const bf16* kp = P + (size_t)(M_CTX + b * 2048 + tok) * EVEN_IN + 3072 + head * 64 + 8 * fq;
                f32x4 acc = {0.f, 0.f, 0.f, 0.f}; acc = MFMA16(*(const bf16x8*)kp, qf0, acc); acc = MFMA16(*(const bf16x8*)(kp + 32), qf1, acc);
                const LAS float* bt = (const LAS float*)(L + AT_BT) + (rs + kr - r + 7) * 31;
#pragma unroll
                for (int e = 0; e < 4; ++e) { const int kc = band + 16 * hf + 4 * fq + e; const bool valid = kc >= wsx && kc < wsx + 16;
                    const float bias = bt[min(max(kc - qc + 15, 0), 30)];
                    acc[e] = valid ? acc[e] * 0.125f + bias : -1e30f; mx2 = fmaxf(mx2, acc[e]); }
                sl[kr * 2 + hf] = acc; }
        mx2 = fmaxf(mx2, __shfl_xor(mx2, 16)); mx2 = fmaxf(mx2, __shfl_xor(mx2, 32));
#pragma unroll
        for (int kt = 0; kt < 16; ++kt)
#pragma unroll
            for (int e = 0; e < 4; ++e) { const float p = fexp(sl[kt][e] - mx2); sl[kt][e] = p; l2 += p; }
        l2 += __shfl_xor(l2, 16); l2 += __shfl_xor(l2, 32);
#pragma unroll
        for (int kr = 0; kr < 8; ++kr) { const bf16x8 pa = pack44(sl[2 * kr], sl[2 * kr + 1]);
            const LAS unsigned char* v0 = L + AT_VL + ((rs + kr - rs0) * 64 + band + 4 * fq + trow) * 128 + tcol;
#pragma unroll
            for (int dt = 0; dt < 4; ++dt) O2[dt] = MFMA16(pa, cat4(vtr(v0 + dt * 32), vtr(v0 + 16 * 128 + dt * 32)), O2[dt]); }
        const float m = fmaxf(mx1, mx2), a1 = fexp(mx1 - m), a2 = fexp(mx2 - m), linv = 1.0f / (l1 * a1 + l2 * a2);
        f1 = a1 * linv; f2 = a2 * linv;
    }
#pragma unroll
    for (int e = 0; e < 4; ++e) { const float g1 = __shfl(f1, 4 * fq + e), g2 = __shfl(f2, 4 * fq + e);
        bf16* op = (scr ? (bf16*)(F.ws + WS_H) : P) + (size_t)(scr ? ((qbase + 4 * fq + e) & 2047) : (qbase + 4 * fq + e)) * EVEN_IN + 2560 + head * 64 + fr;
#pragma unroll
        for (int dt = 0; dt < 4; ++dt) op[16 * dt] = (bf16)f2bf(O1[dt][e] * g1 + O2[dt][e] * g2); }
    __syncthreads();
}
constexpr int RG_XC = 0, RG_XCF = 17408, RG_HB = 50176, RG_CIN = 115712, RG_END = 125952;
template <bool APPLY> __device__ __forceinline__ void rg_phase(Frame& F) {
    LAS unsigned char* L = (LAS unsigned char*)F.lds;
    const bf16* P2 = (const bf16*)(F.ws + WS_PROJ);
    float* AGG = (float*)(F.ws + WS_AGG);
    const int bx = blockIdx.x, hb = bx & 7, t0i = bx >> 3;
    if (F.G != 256) return;
    const int tid = F.tid, lane = F.lane, r = lane & 31, hh = lane >> 5, w = F.wave, d = w >> 2, jq = w & 3;
    const int chl = 32 * jq + r, ch = hb * 128 + chl;
    if (APPLY) {
        for (int idx = tid; idx < 10 * 256; idx += NWAVES * 64) {
            const int k = idx >> 8, dd = (idx >> 7) & 1, c = idx & 127, ti = t0i + 32 * k;
            const bool lat = ti >= 64; const int first = lat ? 64 + ((ti - 64) & ~31) : (ti & ~3), nts = lat ? 32 : 4, pos = ti - first;
            const int cnt = dd == 0 ? pos : nts - 1 - pos;
            float st = lat ? F.in[5][(((ti - 64) >> 5) * 2 + dd) * 1024 + hb * 128 + c] : 0.f;
            float av[31], uv[31];
#pragma unroll
            for (int j = 0; j < 31; ++j) { const bool ok = j < cnt; const int tj = ok ? (dd == 0 ? first + j : first + nts - 1 - j) : ti;
                const float2 v = *(const float2*)(AGG + ((size_t)(tj * 2 + dd) * 1024 + hb * 128 + c) * 2); av[j] = ok ? v.x : 1.0f; uv[j] = ok ? v.y : 0.0f; }
#pragma unroll
            for (int j = 0; j < 31; ++j) st = av[j] * st + uv[j];
            *(LAS float*)(L + RG_CIN + ((k * 2 + dd) * 128 + c) * 4) = st;
        }
    }
    const float gb0 = F.in[21][(d * 2 + 0) * 1024 + ch], gb1 = F.in[21][(d * 2 + 1) * 1024 + ch];
    const float sp8 = -8.0f * log1pf(__expf(-F.in[22][d * 1024 + ch]));
    const int cc = tid & 127, tq = tid >> 7;
    const float cw0 = F.in[18][0 * 1024 + hb * 128 + cc], cw1 = F.in[18][1 * 1024 + hb * 128 + cc], cw2 = F.in[18][2 * 1024 + hb * 128 + cc], cw3 = F.in[18][3 * 1024 + hb * 128 + cc], cbv = F.in[19][hb * 128 + cc];
    for (int k = 0; k < 10; ++k) {
        const int ti = t0i + 32 * k; const int rowb = ti * 64;
        const bool lat = ti >= 64; const int pos = lat ? ((ti - 64) & 31) : (ti & 3), nts = lat ? 32 : 4;
        bf16x8 Bw[2][8];
#pragma unroll
        for (int g = 0; g < 2; ++g)
#pragma unroll
            for (int st = 0; st < 8; ++st) Bw[g][st] = *(const bf16x8*)((const bf16*)(F.ws + WS_GW) + (size_t)((d * 2 + g) * 8 + hb) * 16384 + chl * 128 + 16 * st + 8 * hh);
        { const bf16* xp = P2 + (size_t)(rowb + 16 * tq) * ODD_IN + hb * 128 + cc;
          const bool lo_ok = !(pos == 0 && tq == 0), hi_ok = !(pos == nts - 1 && tq == 3);
          float xm2 = lo_ok ? bf2f(xp[-2 * ODD_IN]) : 0.f, xm1 = lo_ok ? bf2f(xp[-1 * ODD_IN]) : 0.f, x0 = bf2f(xp[0]);
#pragma unroll
          for (int t = 0; t < 16; ++t) { const float x1 = (t < 15 || hi_ok) ? bf2f(xp[(size_t)(t + 1) * ODD_IN]) : 0.f;
              const float xc = cbv + cw0 * xm2 + cw1 * xm1 + cw2 * x0 + cw3 * x1;
              *(LAS unsigned short*)(L + RG_XC + (16 * tq + t) * 272 + cc * 2) = (unsigned short)f2bf(xc);
              *(LAS float*)(L + RG_XCF + ((16 * tq + t) * 128 + cc) * 4) = xc;
              xm2 = xm1; xm1 = x0; x0 = x1; } }
        __syncthreads();
        f32x16 acc[2][2];
#pragma unroll
        for (int g = 0; g < 2; ++g)
#pragma unroll
            for (int mt = 0; mt < 2; ++mt)
#pragma unroll
                for (int q = 0; q < 16; ++q) acc[g][mt][q] = 0.f;
#pragma unroll
        for (int st = 0; st < 8; ++st)
#pragma unroll
            for (int mt = 0; mt < 2; ++mt) { const bf16x8 a = *(const LAS bf16x8*)(L + RG_XC + (32 * mt + r) * 272 + (16 * st + 8 * hh) * 2);
                acc[0][mt] = MFMA32(a, Bw[0][st], acc[0][mt]); acc[1][mt] = MFMA32(a, Bw[1][st], acc[1][mt]); }
#pragma unroll
        for (int mt = 0; mt < 2; ++mt)
#pragma unroll
            for (int q = 0; q < 16; ++q) { const int t = 32 * mt + (q & 3) + 8 * (q >> 2) + 4 * hh;
                const float rr = rcpf_(1.0f + fexp(-(acc[0][mt][q] + gb0))), ii = rcpf_(1.0f + fexp(-(acc[1][mt][q] + gb1)));
                const float la = sp8 * rr, a = fexp(la), x2 = 2.0f * la;
                const float em_s = -x2 * (1.0f + x2 * (0.5f + x2 * (0.16666667f + x2 * (0.041666668f + x2 * 0.008333334f)))), em = x2 > -0.2f ? em_s : 1.0f - a * a;
                acc[0][mt][q] = a; acc[1][mt][q] = __builtin_amdgcn_sqrtf(em) * (ii * *(const LAS float*)(L + RG_XCF + (t * 128 + chl) * 4)); }
        float Ag[8], Ug[8];
#pragma unroll
        for (int mt = 0; mt < 2; ++mt)
#pragma unroll
            for (int G = 0; G < 4; ++G) { float pa = 1.f, hs = 0.f;
#pragma unroll
                for (int e0 = 0; e0 < 4; ++e0) { const int e = d == 0 ? e0 : 3 - e0; const float a = acc[0][mt][4 * G + e], u = acc[1][mt][4 * G + e]; hs = a * hs + u; pa *= a; }
                Ag[4 * mt + G] = pa; Ug[4 * mt + G] = hs; }
        float cin = 0.f;
        if (APPLY) cin = *(const LAS float*)(L + RG_CIN + ((k * 2 + d) * 128 + chl) * 4);
        float state = cin, ptot = 1.f, cown[8];
#pragma unroll
        for (int k0 = 0; k0 < 8; ++k0) { const int kk = d == 0 ? k0 : 7 - k0;
            const float pA = __shfl_xor(Ag[kk], 32), pU = __shfl_xor(Ug[kk], 32);
            const bool ownfirst = (d == 0) ? (hh == 0) : (hh == 1);
            const float A1 = ownfirst ? Ag[kk] : pA, U1 = ownfirst ? Ug[kk] : pU, A2 = ownfirst ? pA : Ag[kk], U2 = ownfirst ? pU : Ug[kk];
            const float s1 = A1 * state + U1; cown[kk] = ownfirst ? state : s1; state = A2 * s1 + U2; ptot *= A1 * A2; }
        if (!APPLY) { if (hh == 0) *(float2*)(AGG + ((size_t)(ti * 2 + d) * 1024 + ch) * 2) = make_float2(ptot, state); }
        else {
#pragma unroll
            for (int mt = 0; mt < 2; ++mt)
#pragma unroll
                for (int G = 0; G < 4; ++G) { float hs = cown[4 * mt + G];
#pragma unroll
                    for (int e0 = 0; e0 < 4; ++e0) { const int e = d == 0 ? e0 : 3 - e0; hs = acc[0][mt][4 * G + e] * hs + acc[1][mt][4 * G + e];
                        const int t = 32 * mt + 8 * G + 4 * hh + e; *(LAS float*)(L + RG_HB + ((d * 64 + t) * 128 + chl) * 4) = hs; } }
            if (!lat && hh == 0 && ((d == 0 && pos == nts - 1) || (d == 1 && pos == 0))) F.out[OUT_RG + ((ti >> 2) * 2 + d) * 1024 + ch] = state;
            __syncthreads();
#pragma unroll
            for (int it = 0; it < 2; ++it) { const int cidx = tid + it * 512, t = cidx >> 4, c8 = (cidx & 15) * 8;
                const v4u gw = *(const v4u*)(P2 + (size_t)(rowb + t) * ODD_IN + 1024 + hb * 128 + c8);
                const f32x4 f0 = *(const LAS f32x4*)(L + RG_HB + (t * 128 + c8) * 4), f1 = *(const LAS f32x4*)(L + RG_HB + (t * 128 + c8 + 4) * 4);
                const f32x4 b0 = *(const LAS f32x4*)(L + RG_HB + ((64 + t) * 128 + c8) * 4), b1 = *(const LAS f32x4*)(L + RG_HB + ((64 + t) * 128 + c8 + 4) * 4);
                v4u o; o.x = pk2((f0.x + b0.x) * siluf(bflo(gw.x)), (f0.y + b0.y) * siluf(bfhi(gw.x))); o.y = pk2((f0.z + b0.z) * siluf(bflo(gw.y)), (f0.w + b0.w) * siluf(bfhi(gw.y)));
                o.z = pk2((f1.x + b1.x) * siluf(bflo(gw.z)), (f1.y + b1.y) * siluf(bfhi(gw.z))); o.w = pk2((f1.z + b1.z) * siluf(bflo(gw.w)), (f1.w + b1.w) * siluf(bfhi(gw.w)));
                *(v4u*)((bf16*)(F.ws + WS_H) + (size_t)(rowb + t) * DM + hb * 128 + c8) = o; }
        }
        if (!APPLY) __syncthreads();
    }
    __syncthreads();
}
struct Args { const float* in[24]; float* out; unsigned char* ws; int ph_lo, ph_hi; };
__global__ void __launch_bounds__(NWAVES * 64, 2) mega_fwd(Args args) {
    extern __shared__ __attribute__((aligned(16))) unsigned char lds[];
    Frame F;
    F.lds = lds;
    F.MISC = (volatile LAS unsigned*)((LAS unsigned char*)lds + MISC_OFF);
    F.tid = threadIdx.x; F.lane = F.tid & 63; F.wave = __builtin_amdgcn_readfirstlane(F.tid >> 6);
    F.G = gridDim.x; { const int bx = blockIdx.x; F.vcu = (F.G % 8 == 0) ? (bx % 8) * (F.G / 8) + bx / 8 : bx; }
    F.ws = args.ws; F.out = args.out; F.ctl = (gu32*)(args.ws + WS_CTL);
#pragma unroll
    for (int i = 0; i < 24; ++i) F.in[i] = args.in[i];
    for (int u = F.tid; u < (LDS_BYTES - MISC_OFF) / 4; u += NWAVES * 64) ((LAS unsigned*)((LAS unsigned char*)lds + MISC_OFF))[u] = 0u;
    __syncthreads();
    const int lo = args.ph_lo, hi = args.ph_hi;
    const bool one = (lo == 0 && hi == NPHASE);
    XcdBarrier bar; bar.bar = (unsigned*)(F.ctl + CW_BAR); bar.x = 0; bar.st = nullptr;
    if (one) bar = xcd_barrier_post((unsigned*)(F.ctl + CW_BAR), F.MISC + 8);
#define IN(k) (lo <= (k) && (k) < hi)
#define QSLOT 0
#define GRID_BAR(k) do { if (IN(k) && IN((k) + 1)) xcd_barrier(bar); } while (0)
    LAS unsigned char* ring = (LAS unsigned char*)lds;

    if (IN(0)) { p0_prologue(F); GRID_BAR(0); }
    if (IN(1)) { modnorm_rows(F, 0, F.in[0], F.in[1]); GRID_BAR(1); }
    if (IN(2)) {
        pg8::Gemm g{(const bf16*)(F.ws + WS_H), (const bf16*)(F.ws + WS_WIE), M_ALL, EVEN_IN, DM}; pg8::StaticOrder S; S.init(M_ALL, EVEN_IN, F.G, (int)blockIdx.x);
        pg8::EpiProj E{(bf16*)(F.ws + WS_PROJ), EVEN_IN, F.out + OUT_K};
        pg8::gemm_phase<pg8::EpiProj, pg8::StaticOrder, true, true>(ring, g, S, E);
        GRID_BAR(2);
    }
    if (IN(3)) {
#define QUEUE_LOOP(slot, count, call) for (;;) { \
            if (F.tid == 0) F.MISC[16] = __hip_atomic_fetch_add((unsigned*)(F.ctl + CW_QUEUE + 64 * (slot) + 256 * QSLOT), 1u, __ATOMIC_RELAXED, __HIP_MEMORY_SCOPE_AGENT); \
            __syncthreads(); const int qi = (int)F.MISC[16]; __syncthreads(); \
            if (qi >= (count)) break; call; }
        QUEUE_LOOP(0, 192, hgrn_mfma_item(F, qi < 64 ? 128 + qi : qi - 64))
        QUEUE_LOOP(1, 1024, attn_mfma_item<true>(F, qi))
        QUEUE_LOOP(2, 256, attn_mfma_item<false>(F, qi))
#undef QUEUE_LOOP
        GRID_BAR(3);
    }
#if defined(PROBE_Y)
    for (int it = blockIdx.x; it < 1024; it += F.G) attn_mfma_item<true>(F, it, 1);
    xcd_barrier(bar);
#endif
#if defined(PROBE_Z)
    for (int it = blockIdx.x; it < 256; it += F.G) attn_mfma_item<false>(F, it, 1);
    xcd_barrier(bar);
#endif
    if (IN(4)) { gate_even_rows(F); GRID_BAR(4); }
    if (IN(5)) {
        pg8::Gemm g{(const bf16*)(F.ws + WS_H), (const bf16*)(F.ws + WS_WOE), M_ALL, DM, DM}; pg8::StaticOrder S; S.init(M_ALL, DM, F.G, (int)blockIdx.x);
        pg8::EpiRes E{F.in[0], F.in[1], F.out, (const float*)(F.ws + WS_MODS) + 2048};
        pg8::gemm_phase<pg8::EpiRes, pg8::StaticOrder, true, true>(ring, g, S, E);
        GRID_BAR(5);
    }
    if (IN(6)) { modnorm_rows(F, 1, F.out, F.out + (size_t)M_CTX * DM); GRID_BAR(6); }
    if (IN(7)) {
        pg8::Gemm g{(const bf16*)(F.ws + WS_H), (const bf16*)(F.ws + WS_WIO), M_ALL, ODD_IN, DM}; pg8::StaticOrder S; S.init(M_ALL, ODD_IN, F.G, (int)blockIdx.x);
        pg8::EpiProj E{(bf16*)(F.ws + WS_PROJ), ODD_IN, nullptr};
        pg8::gemm_phase<pg8::EpiProj, pg8::StaticOrder, true, true>(ring, g, S, E);
        GRID_BAR(7);
    }
    if (IN(8)) { rg_phase<false>(F); GRID_BAR(8); }
    if (IN(9)) { rg_phase<true>(F); GRID_BAR(9); }
    if (IN(10)) {
        pg8::Gemm g{(const bf16*)(F.ws + WS_H), (const bf16*)(F.ws + WS_WOO), M_ALL, DM, DM}; pg8::StaticOrder S; S.init(M_ALL, DM, F.G, (int)blockIdx.x);
        pg8::EpiRes E{F.out, F.out + (size_t)M_CTX * DM, F.out, (const float*)(F.ws + WS_MODS) + 9 * 3072 + 2048};
        pg8::gemm_phase<pg8::EpiRes, pg8::StaticOrder, true, true>(ring, g, S, E);
        GRID_BAR(10);
    }
    if (IN(11)) { final_norm_rows(F); }

#undef IN
#undef GRID_BAR
}

extern "C" void kernel_launch(void* const* d_in, const int* in_sizes, int n_in, void* d_out, int out_size, void* d_ws, size_t ws_size, hipStream_t stream) {
    static int grid = 0;
    if (grid == 0) {
        if (n_in != 24 || out_size != (int)OUT_TOTAL || ws_size < WS_END) { fprintf(stderr, "kernel_launch: unexpected shapes (n_in %d out %d ws %zu)\n", n_in, out_size, ws_size); grid = -1; return; }
        int dev = 0, cus = 0, per_cu = 0;
        if (hipGetDevice(&dev) != hipSuccess || hipDeviceGetAttribute(&cus, hipDeviceAttributeMultiprocessorCount, dev) != hipSuccess) { grid = -1; return; }
        if (hipFuncSetAttribute((const void*)mega_fwd, hipFuncAttributeMaxDynamicSharedMemorySize, LDS_BYTES) != hipSuccess) { fprintf(stderr, "kernel_launch: hipFuncSetAttribute failed\n"); grid = -1; return; }
        if (hipOccupancyMaxActiveBlocksPerMultiprocessor(&per_cu, (const void*)mega_fwd, NWAVES * 64, LDS_BYTES) != hipSuccess || per_cu < 1) { fprintf(stderr, "kernel_launch: occupancy query says %d\n", per_cu); }
        (void)hipGetLastError();
        grid = cus;
    }
    if (grid < 0) return;
    (void)hipMemsetAsync((char*)d_ws + WS_CTL, 0, CTL_ZERO_BYTES, stream);
    Args a{};
    for (int i = 0; i < 24; ++i) a.in[i] = (const float*)d_in[i];
    a.out = (float*)d_out; a.ws = (unsigned char*)d_ws;
#if defined(MK_PER_PHASE)
    for (int p = 0; p < NPHASE; ++p) { a.ph_lo = p; a.ph_hi = p + 1; hipLaunchKernelGGL(mega_fwd, dim3(grid), dim3(NWAVES * 64), LDS_BYTES, stream, a); }
#else
    a.ph_lo = 0; a.ph_hi = NPHASE;
    hipLaunchKernelGGL(mega_fwd, dim3(grid), dim3(NWAVES * 64), LDS_BYTES, stream, a);
#endif
}
```

```cpp
#include <hip/hip_runtime.h>
#include <cstdio>
#include <cstdint>
namespace pg8 {
#define PG8_LAS __attribute__((address_space(3)))
typedef unsigned short bf16_t;
typedef short bf16x8 __attribute__((ext_vector_type(8)));
typedef float f32x4 __attribute__((ext_vector_type(4)));
typedef unsigned u32x4 __attribute__((ext_vector_type(4)));
constexpr int BM = 256, BK = 64, HALF = 128, HTB = HALF * BK * 2  , STAGE_BYTES = 8 * HTB, NXCD = 8, WGM = 8;

__host__ __device__ __forceinline__ int lds_byte(int r, int c) { const int st = (r >> 4) * 2 + (c >> 5), rr = r & 15, cc = c & 31, ob = rr * 64 + cc * 2; return st * 1024 + (ob ^ (((ob >> 9) & 1) << 5)); }
__host__ __device__ __forceinline__ void stage_rc(int b, int& R, int& C) { const int st = b / 1024, sb = b % 1024, swz = sb ^ (((sb >> 9) & 1) << 5); R = (st >> 1) * 16 + swz / 64; C = (st & 1) * 32 + (swz % 64) / 2; }
__host__ __device__ __forceinline__ int perm32(int rho) { const int n = rho >> 4, i = rho & 15; return 8 * (i >> 2) + 4 * n + (i & 3); }

struct Unit { int pm, pn; };
struct Gemm { const bf16_t* A; const bf16_t* Bt; int M, N, K; };

struct StaticOrder {
    int nM, nN, nwg, G, c;
    __host__ __device__ void init(int M, int N, int G_, int c_) { nM = M / BM; nN = N / BM; nwg = nM * nN; G = G_; c = c_; }
    __host__ __device__ bool next(int i, Unit& u) const {
        const long L = (long)i * G + c; if (L >= nwg) return false;
        int wgid = (int)L; { const int q = nwg / NXCD, r = nwg % NXCD, xcd = wgid % NXCD, off = wgid / NXCD; wgid = (xcd < r ? xcd * (q + 1) : r * (q + 1) + (xcd - r) * q) + off; }
        const int nig = WGM * nN, gid = wgid / nig, fm = gid * WGM, gsz = (nM - fm) < WGM ? (nM - fm) : WGM;
        u.pm = fm + ((wgid % nig) % gsz); u.pn = (wgid % nig) / gsz; return true;
    }
    __device__ __forceinline__ void a_ready(const Unit&) const {}
    __device__ __forceinline__ void done(const Unit&) const {}
};

__device__ __forceinline__ unsigned cvt_pk_bf16(float lo, float hi) { unsigned r; asm volatile("v_cvt_pk_bf16_f32 %0, %1, %2" : "=v"(r) : "v"(lo), "v"(hi)); return r; }
typedef float f32x2 __attribute__((ext_vector_type(2)));
struct EpiProj {
    static constexpr bool PERM = true, AFTER_DRAIN = false;
    bf16_t* O; int ldc; float* kv;
    __device__ __forceinline__ void operator()(const f32x4 (&acc)[2][2][4][2], const Unit& u, int wr, int wc, int fr, int fq) const {
        const int row0 = u.pm * BM + wr * 64 + fr; const int col0 = u.pn * BM + wc * 32 + 8 * fq;
        const bool dokv = (kv != nullptr) && u.pm < 16 && u.pn >= 12 && u.pn < 16;
#pragma unroll
        for (int ai = 0; ai < 2; ++ai)
#pragma unroll
            for (int m = 0; m < 4; ++m) { bf16_t* rowp = O + (size_t)(row0 + ai * HALF + m * 16) * ldc + col0;
#pragma unroll
                for (int bj = 0; bj < 2; ++bj) { const f32x4 v0 = acc[ai][bj][m][0], v1 = acc[ai][bj][m][1];
                    u32x4 w; w.x = cvt_pk_bf16(v0[0], v0[1]); w.y = cvt_pk_bf16(v0[2], v0[3]); w.z = cvt_pk_bf16(v1[0], v1[1]); w.w = cvt_pk_bf16(v1[2], v1[3]);
                    *(u32x4*)(rowp + bj * HALF) = w;
                    if (dokv) { const int cc = col0 + bj * HALF - 3072, which = cc >> 9, c2 = cc & 511, head = c2 >> 6, d = c2 & 63, t = wr * 64 + fr + ai * HALF + m * 16;
                        float* p = kv + (size_t)which * 2097152 + ((size_t)(u.pm * 8 + head) * 256 + t) * 64 + d; *(f32x4*)p = v0; *(f32x4*)(p + 4) = v1; } } }
    }
};
struct EpiRes {
    static constexpr bool PERM = false, AFTER_DRAIN = false;
    const float* base0; const float* base1; float* out; const float* gate;
    __device__ __forceinline__ void operator()(const f32x4 (&acc)[2][2][4][2], const Unit& u, int wr, int wc, int fr, int fq) const {
        const int nidx = u.pm < 16 ? 0 : 1 + ((u.pm - 16) >> 3);
        const float* gp = gate + (size_t)nidx * 3072;
        const int col0 = u.pn * BM + wc * 32 + 4 * fq;
        f32x4 gv[2][2];
#pragma unroll
        for (int bj = 0; bj < 2; ++bj)
#pragma unroll
            for (int n = 0; n < 2; ++n) gv[bj][n] = *(const f32x4*)(gp + col0 + bj * HALF + n * 16);
#pragma unroll
        for (int ai = 0; ai < 2; ++ai)
#pragma unroll
            for (int m = 0; m < 4; ++m) { const int row = u.pm * BM + ai * HALF + wr * 64 + m * 16 + fr;
                const float* bp = (row < 4096 ? base0 + (size_t)row * 1024 : base1 + (size_t)(row - 4096) * 1024) + col0;
                float* op = out + (size_t)row * 1024 + col0;
#pragma unroll
                for (int bj = 0; bj < 2; ++bj)
#pragma unroll
                    for (int n = 0; n < 2; ++n) { const f32x4 b = *(const f32x4*)(bp + bj * HALF + n * 16); *(f32x4*)(op + bj * HALF + n * 16) = b + gv[bj][n] * acc[ai][bj][m][n]; } }
    }
};
template <class Epi, class Sched, bool ALIGN_EPI = false, bool SP2 = false>
__device__ __forceinline__ void gemm_phase(PG8_LAS unsigned char* lds, const Gemm g, const Sched& S, const Epi& E) {
    const int tid = threadIdx.x, wid = __builtin_amdgcn_readfirstlane(tid >> 6), lane = tid & 63, wr = wid >> 2, wc = wid & 3, fr = lane & 15, fq = lane >> 4;
    const int K = g.K, nt = K / BK;
    unsigned voffA[2], voffB[2];
#pragma unroll
    for (int i = 0; i < 2; ++i) { int R, C; stage_rc(tid * 16 + i * 8192, R, C); const int Rb = Epi::PERM ? ((R & ~31) + perm32(R & 31)) : R;
        voffA[i] = (unsigned)(R * K + C) * 2u; voffB[i] = (unsigned)(Rb * K + C) * 2u; }
    const size_t kstep = (size_t)(BK * 2);
    const size_t hstep = (size_t)HALF * K * 2;
    const size_t tstep = 2 * hstep;
    const unsigned ldsw = (unsigned)wid * 1024u;
    const int aoff = lds_byte(wr * 64 + fr, fq * 8), boff = lds_byte(wc * 32 + fr, fq * 8);
#define PG8_SA(b, h) (((b) * 2 + (h)) * HTB)
#define PG8_SB(b, h) ((4 + (b) * 2 + (h)) * HTB)
#define PG8_STAGE(bufoff, gbase, voff) do { _Pragma("unroll") for (int _i = 0; _i < 2; ++_i) \
        __builtin_amdgcn_global_load_lds((const unsigned*)((const char*)(gbase) + (voff)[_i]), (PG8_LAS unsigned*)(lds + (bufoff) + ldsw + _i * 8192), 16, 0, 0); } while (0)
#define PG8_LDA(dst, b, h) do { _Pragma("unroll") for (int m = 0; m < 4; ++m) _Pragma("unroll") for (int k = 0; k < 2; ++k) dst[m][k] = *(const PG8_LAS bf16x8*)(lds + PG8_SA(b, h) + aoff + m * 2048 + k * 1024); } while (0)
#define PG8_LDB(dst, b, h) do { _Pragma("unroll") for (int n = 0; n < 2; ++n) _Pragma("unroll") for (int k = 0; k < 2; ++k) dst[n][k] = *(const PG8_LAS bf16x8*)(lds + PG8_SB(b, h) + boff + n * 2048 + k * 1024); } while (0)
#define PG8_MMA(ai, bj, At, Bt) do { __builtin_amdgcn_s_setprio(1); _Pragma("unroll") for (int m = 0; m < 4; ++m) _Pragma("unroll") for (int n = 0; n < 2; ++n) _Pragma("unroll") for (int k = 0; k < 2; ++k) \
        acc[ai][bj][m][n] = __builtin_amdgcn_mfma_f32_16x16x32_bf16(Bt[n][k], At[m][k], acc[ai][bj][m][n], 0, 0, 0); __builtin_amdgcn_s_setprio(0); } while (0)
#define PG8_WAIT_V(n) asm volatile("s_waitcnt vmcnt(" #n ")" ::: "memory")
#define PG8_WAIT_L(n) asm volatile("s_waitcnt lgkmcnt(" #n ")" ::: "memory")
#define PG8_BAR __builtin_amdgcn_s_barrier()
#define PG8_SCHED __builtin_amdgcn_sched_barrier(0)
    Unit cur, nxt; int ui = 0;
    if (!S.next(0, cur)) return;
    f32x4 acc[2][2][4][2];
#pragma unroll
    for (int a = 0; a < 2; ++a)
#pragma unroll
        for (int b = 0; b < 2; ++b)
#pragma unroll
            for (int m = 0; m < 4; ++m)
#pragma unroll
                for (int n = 0; n < 2; ++n) acc[a][b][m][n] = (f32x4){0.f, 0.f, 0.f, 0.f};
    bf16x8 At[4][2], B0[2][2], B1[2][2];
    const char* cA = (const char*)g.A + (size_t)cur.pm * tstep; const char* cB = (const char*)g.Bt + (size_t)cur.pn * tstep;
    S.a_ready(cur);
    if constexpr (SP2) {
        PG8_STAGE(PG8_SB(0, 0), cB, voffB); PG8_STAGE(PG8_SB(0, 1), cB + hstep, voffB); PG8_STAGE(PG8_SA(0, 0), cA, voffA); PG8_STAGE(PG8_SA(0, 1), cA + hstep, voffA);
        if (wr == 1) PG8_BAR;
        PG8_WAIT_V(2); PG8_BAR;
        PG8_STAGE(PG8_SB(1, 0), cB + kstep, voffB); PG8_STAGE(PG8_SA(1, 0), cA + kstep, voffA); PG8_STAGE(PG8_SB(1, 1), cB + hstep + kstep, voffB);
        PG8_WAIT_V(6); PG8_BAR;
    } else {
        PG8_STAGE(PG8_SB(0, 0), cB, voffB); PG8_STAGE(PG8_SA(0, 0), cA, voffA); PG8_STAGE(PG8_SB(0, 1), cB + hstep, voffB); PG8_STAGE(PG8_SA(0, 1), cA + hstep, voffA);
        if (wr == 1) PG8_BAR;
        PG8_WAIT_V(4); PG8_BAR;
        PG8_STAGE(PG8_SB(1, 0), cB + kstep, voffB); PG8_STAGE(PG8_SA(1, 0), cA + kstep, voffA); PG8_STAGE(PG8_SB(1, 1), cB + hstep + kstep, voffB);
        PG8_WAIT_V(6); PG8_BAR;
    }
    for (;;) {
        const bool has_next = S.next(ui + 1, nxt);
        const char* nA = has_next ? (const char*)g.A + (size_t)nxt.pm * tstep : cA; const char* nB = has_next ? (const char*)g.Bt + (size_t)nxt.pn * tstep : cB;
        for (int t = 0; t < nt; t += 2) {
            const bool last = (t == nt - 2);
            const char* a1 = cA + (size_t)(t + 1) * kstep;
            const char* a2 = last ? nA : cA + (size_t)(t + 2) * kstep; const char* b2 = last ? nB : cB + (size_t)(t + 2) * kstep;
            const char* a3 = a2 + kstep; const char* b3 = b2 + kstep;
            if (last && has_next) S.a_ready(nxt);
            if constexpr (SP2) {
            PG8_LDB(B0, 0, 0); PG8_LDB(B1, 0, 1); PG8_SCHED; PG8_LDA(At, 0, 0); PG8_STAGE(PG8_SA(1, 1), a1 + hstep, voffA);
            PG8_WAIT_V(8); PG8_WAIT_L(0); PG8_BAR; PG8_MMA(0, 0, At, B0); PG8_MMA(0, 1, At, B1); PG8_BAR; PG8_SCHED;
            PG8_LDA(At, 0, 1); PG8_STAGE(PG8_SB(0, 0), b2, voffB); PG8_STAGE(PG8_SB(0, 1), b2 + hstep, voffB); PG8_STAGE(PG8_SA(0, 0), a2, voffA);
            PG8_WAIT_V(8); PG8_WAIT_L(0); PG8_BAR; PG8_MMA(1, 0, At, B0); PG8_MMA(1, 1, At, B1); PG8_BAR; PG8_SCHED;
            PG8_LDB(B0, 1, 0); PG8_LDB(B1, 1, 1); PG8_SCHED; PG8_LDA(At, 1, 0); PG8_STAGE(PG8_SA(0, 1), a2 + hstep, voffA);
            PG8_WAIT_V(8); PG8_WAIT_L(0); PG8_BAR; PG8_MMA(0, 0, At, B0); PG8_MMA(0, 1, At, B1); PG8_BAR; PG8_SCHED;
            PG8_LDA(At, 1, 1); PG8_STAGE(PG8_SB(1, 0), b3, voffB); PG8_STAGE(PG8_SB(1, 1), b3 + hstep, voffB); PG8_STAGE(PG8_SA(1, 0), a3, voffA);
            PG8_WAIT_V(8); PG8_WAIT_L(0); PG8_BAR; PG8_MMA(1, 0, At, B0); PG8_MMA(1, 1, At, B1); PG8_BAR; PG8_SCHED;
            } else {
            PG8_LDB(B0, 0, 0); PG8_SCHED; PG8_LDA(At, 0, 0); PG8_STAGE(PG8_SA(1, 1), a1 + hstep, voffA);
            PG8_WAIT_L(8); PG8_BAR; PG8_WAIT_L(0); PG8_MMA(0, 0, At, B0); PG8_BAR; PG8_SCHED;
            PG8_LDB(B1, 0, 1); PG8_STAGE(PG8_SB(0, 0), b2, voffB);
            PG8_BAR; PG8_WAIT_L(0); PG8_MMA(0, 1, At, B1); PG8_BAR;
            PG8_LDA(At, 0, 1); PG8_STAGE(PG8_SA(0, 0), a2, voffA);
            PG8_BAR; PG8_WAIT_L(0); PG8_MMA(1, 0, At, B0); PG8_BAR; PG8_SCHED;
            PG8_STAGE(PG8_SB(0, 1), b2 + hstep, voffB);
            PG8_WAIT_V(6); PG8_BAR; PG8_MMA(1, 1, At, B1); PG8_BAR;
            PG8_LDB(B0, 1, 0); PG8_SCHED; PG8_LDA(At, 1, 0); PG8_STAGE(PG8_SA(0, 1), a2 + hstep, voffA);
            PG8_WAIT_L(8); PG8_BAR; PG8_WAIT_L(0); PG8_MMA(0, 0, At, B0); PG8_BAR; PG8_SCHED;
            PG8_LDB(B1, 1, 1); PG8_STAGE(PG8_SB(1, 0), b3, voffB);
            PG8_BAR; PG8_WAIT_L(0); PG8_MMA(0, 1, At, B1); PG8_BAR;
            PG8_LDA(At, 1, 1); PG8_STAGE(PG8_SA(1, 0), a3, voffA);
            PG8_BAR; PG8_WAIT_L(0); PG8_MMA(1, 0, At, B0); PG8_BAR; PG8_SCHED;
            PG8_STAGE(PG8_SB(1, 1), b3 + hstep, voffB);
            PG8_WAIT_V(6); PG8_BAR; PG8_MMA(1, 1, At, B1); PG8_BAR;
            }
        }
        if constexpr (ALIGN_EPI) { if (wr == 0) PG8_BAR; }
        if constexpr (!Epi::AFTER_DRAIN) { E(acc, cur, wr, wc, fr, fq); S.done(cur); }
        if (!has_next) break;
#pragma unroll
        for (int a = 0; a < 2; ++a)
#pragma unroll
            for (int b = 0; b < 2; ++b)
#pragma unroll
                for (int m = 0; m < 4; ++m)
#pragma unroll
                    for (int n = 0; n < 2; ++n) acc[a][b][m][n] = (f32x4){0.f, 0.f, 0.f, 0.f};
        cur = nxt; cA = nA; cB = nB; ++ui;
        if constexpr (ALIGN_EPI) { if (wr == 1) PG8_BAR; }
    }
    PG8_WAIT_V(0);
    if constexpr (!ALIGN_EPI) { if (wr == 0) PG8_BAR; }
    PG8_BAR;
    if constexpr (Epi::AFTER_DRAIN) { E.fused(acc, cur, wr, wc, fr, fq, lds, wid, lane); S.done(cur); }
#undef PG8_SA
#undef PG8_SB
#undef PG8_STAGE
#undef PG8_LDA
#undef PG8_LDB
#undef PG8_MMA
#undef PG8_WAIT_V
#undef PG8_WAIT_L
#undef PG8_BAR
#undef PG8_SCHED
}
}
constexpr int NWAVES = 8;
constexpr int DM = 1024, M_CTX = 4096, M_LAT = 16384, M_ALL = 20480, EVEN_IN = 4608, ODD_IN = 2048;
constexpr size_t MiB = 1u << 20;
constexpr size_t WS_CTL = 0, CTL_ZERO_BYTES = 1 * MiB;
constexpr size_t WS_MODS = 1 * MiB;
constexpr size_t WS_WIE = 2 * MiB, WS_WOE = 11 * MiB, WS_WIO = 13 * MiB, WS_WOO = 17 * MiB, WS_GW = 19 * MiB;
constexpr size_t WS_AGG = 20 * MiB;
constexpr size_t WS_H = 26 * MiB;
constexpr size_t WS_PROJ = 66 * MiB;
constexpr size_t WS_END = 246 * MiB;
constexpr size_t OUT_Y = 0, OUT_HG = 20971520, OUT_K = 23068672, OUT_V = 25165824, OUT_RG = 27262976, OUT_TOTAL = 27295744;
constexpr int CW_TMO = 0, CW_CODE = 1, CW_BAR = 4096, CW_QUEUE = 16384;
constexpr int RING_BYTES = 131072;
constexpr int LDS_BYTES = 162816, MISC_OFF = LDS_BYTES - 512;
constexpr int NPHASE = 12;

#define GAS __attribute__((address_space(1)))
#define LAS __attribute__((address_space(3)))
typedef unsigned short bf16;
typedef unsigned v4u __attribute__((ext_vector_type(4)));
typedef unsigned v2u __attribute__((ext_vector_type(2)));
typedef float f32x4 __attribute__((ext_vector_type(4)));
typedef float f32x16 __attribute__((ext_vector_type(16)));
typedef short bf16x8 __attribute__((ext_vector_type(8)));
typedef short s16x4 __attribute__((ext_vector_type(4)));
typedef GAS unsigned gu32;
#define RLX_AGENT __ATOMIC_RELAXED, __HIP_MEMORY_SCOPE_AGENT
#define LDS_WAIT() asm volatile("s_waitcnt lgkmcnt(0)" ::: "memory")
#define VM_WAIT() asm volatile("s_waitcnt vmcnt(0)" ::: "memory")
__device__ __forceinline__ unsigned f2bf(float f) { unsigned u = __builtin_bit_cast(unsigned, f); return (u + 0x7fffu + ((u >> 16) & 1u)) >> 16; }
__device__ __forceinline__ unsigned pk2(float lo, float hi) { return f2bf(lo) | (f2bf(hi) << 16); }
__device__ __forceinline__ float bf2f(unsigned b) { return __builtin_bit_cast(float, b << 16); }
__device__ __forceinline__ float bflo(unsigned w) { return __builtin_bit_cast(float, w << 16); }
__device__ __forceinline__ float bfhi(unsigned w) { return __builtin_bit_cast(float, w & 0xffff0000u); }
__device__ __forceinline__ float fexp(float x) { return __builtin_amdgcn_exp2f(x * 1.4426950408889634f); }
__device__ __forceinline__ float flog(float x) { return __builtin_amdgcn_logf(x) * 0.6931471805599453f; }
__device__ __forceinline__ float rcpf_(float x) { return __builtin_amdgcn_rcpf(x); }
__device__ __forceinline__ float sigmoidf(float x) { return rcpf_(1.0f + fexp(-x)); }
__device__ __forceinline__ float siluf(float x) { return x * rcpf_(1.0f + fexp(-x)); }
#define XB_TMO      128
#define XB_XCNT(j)  (256  + 64 * (j))
#define XB_XSUB(j)  (1280 + 64 * (j))
#define XB_XGEN(j)  (2304 + 64 * (j))
#define XB_TOP      3328
#define XB_TOPGEN   3392
#define XCD_BAR_WORDS 3456
#define XB_SPIN_CAP (1u << 18)

__device__ __forceinline__ unsigned xb_ld(unsigned* p)              { return __hip_atomic_load(p, __ATOMIC_RELAXED, __HIP_MEMORY_SCOPE_AGENT); }
__device__ __forceinline__ unsigned xb_add(unsigned* p, unsigned v) { return __hip_atomic_fetch_add(p, v, __ATOMIC_RELAXED, __HIP_MEMORY_SCOPE_AGENT); }
__device__ __forceinline__ unsigned xb_xcc_id() { return (unsigned)__builtin_amdgcn_s_getreg((3 << 11) | 20) & 0xFu; }
#define XB_SPIN(cond, bar) do { unsigned _sp = 0; while (cond) { __builtin_amdgcn_s_sleep(1); \
    if ((++_sp & 255u) == 0u) { if (xb_ld(&(bar)[XB_TMO])) break; if (_sp > XB_SPIN_CAP) { atomicAdd(&(bar)[XB_TMO], 1u); break; } } } } while (0)

struct XcdBarrier {
    unsigned* bar; unsigned x;
    volatile LAS unsigned* st;
};

__device__ __forceinline__ XcdBarrier xcd_barrier_post(unsigned* bar, volatile LAS unsigned* st) {
    XcdBarrier b; b.bar = bar; b.x = xb_xcc_id(); b.st = st;
    if (threadIdx.x == 0) (void)xb_add(&bar[XB_XCNT(b.x)], 1u);
    return b;
}
__device__ __forceinline__ void xcd_barrier_complete(unsigned* bar, unsigned x, unsigned& nloc, unsigned& nx) {
    const unsigned G = gridDim.x * gridDim.y * gridDim.z;
    unsigned sum, cnt, mine, sp = 0u;
    for (;;) {
        sum = 0u; cnt = 0u; mine = 0u;
#pragma unroll
        for (unsigned j = 0; j < 16; ++j) { const unsigned c = xb_ld(&bar[XB_XCNT(j)]); sum += c; cnt += (c > 0u) ? 1u : 0u; mine = (j == x) ? c : mine; }
        if (sum == G) break;
        __builtin_amdgcn_s_sleep(1);
        if ((++sp & 255u) == 0u) { if (xb_ld(&bar[XB_TMO])) break; if (sp > XB_SPIN_CAP) { atomicAdd(&bar[XB_TMO], 1u); break; } }
    }
    nloc = mine > 0u ? mine : 1u; nx = cnt > 0u ? cnt : 1u;
}

__device__ __forceinline__ void xcd_barrier(const XcdBarrier& b) {
    asm volatile("s_waitcnt vmcnt(0)" ::: "memory");
    __syncthreads();
    if (threadIdx.x == 0) {
        unsigned* bar = b.bar;
        __builtin_amdgcn_s_waitcnt(0);
        unsigned nloc = b.st[0], nx = b.st[1];
        if (nloc == 0u) { xcd_barrier_complete(bar, b.x, nloc, nx); b.st[0] = nloc; b.st[1] = nx; }
        const unsigned old = xb_add(&bar[XB_XSUB(b.x)], 1u);
        const unsigned gen = old / nloc;
        if (old + 1u == (gen + 1u) * nloc) {
            __builtin_amdgcn_fence(__ATOMIC_RELEASE, "agent");
            asm volatile("s_waitcnt vmcnt(0)" ::: "memory");
            const unsigned og = xb_add(&bar[XB_TOP], 1u);
            const unsigned tg = og / nx;
            if (og + 1u == (tg + 1u) * nx) xb_add(&bar[XB_TOPGEN], 1u);
            else XB_SPIN(xb_ld(&bar[XB_TOPGEN]) == tg, bar);
            __builtin_amdgcn_fence(__ATOMIC_ACQUIRE, "agent");
            xb_add(&bar[XB_XGEN(b.x)], 1u);
            asm volatile("s_waitcnt vmcnt(0)" ::: "memory");
        } else {
            XB_SPIN(xb_ld(&bar[XB_XGEN(b.x)]) == gen, bar);
            __builtin_amdgcn_fence(__ATOMIC_ACQUIRE, "agent");
            asm volatile("s_waitcnt vmcnt(0)" ::: "memory");
        }
    }
    __syncthreads();
}
struct Frame {
    unsigned char* lds;
    volatile LAS unsigned* MISC;
    gu32* ctl;
    int tid, lane, wave, vcu, G;
    const float* in[24];
    float* out; unsigned char* ws;
};
__device__ __forceinline__ float wave_sum(float v) {
#pragma unroll
    for (int o = 1; o < 64; o <<= 1) v += __shfl_xor(v, o);
    return v;
}
__device__ __forceinline__ void p0_transpose_item(const float* W, int K, int N, bf16* WT, float* scr, int item, int lane) {
    const int nblk = N / 32, kb = item / nblk, nb = item % nblk, k0 = 64 * kb, n0 = 32 * nb;
#pragma unroll 8
    for (int i = 0; i < 32; ++i) { const int kk = 2 * i + (lane >> 5); scr[kk * 33 + (lane & 31)] = W[(size_t)(k0 + kk) * N + n0 + (lane & 31)]; }
    LDS_WAIT(); asm volatile("" ::: "memory");
    const int c = lane & 7;
#pragma unroll
    for (int j = 0; j < 4; ++j) { const int n = (lane >> 3) + 8 * j; const float* s = scr + (8 * c) * 33 + n;
        v4u o; o.x = pk2(s[0 * 33], s[1 * 33]); o.y = pk2(s[2 * 33], s[3 * 33]); o.z = pk2(s[4 * 33], s[5 * 33]); o.w = pk2(s[6 * 33], s[7 * 33]);
        *(v4u*)(WT + (size_t)(n0 + n) * K + k0 + 8 * c) = o; }
    LDS_WAIT(); asm volatile("" ::: "memory");
}
__device__ __forceinline__ void p0_prologue(Frame& F) {
    float* mods = (float*)(F.ws + WS_MODS);
    for (int it = blockIdx.x; it < 96; it += F.G) {
        const int l = it / 48, c0 = (it % 48) * 64;
        float* S = (float*)F.lds;
        for (int idx = F.tid; idx < 9216; idx += NWAVES * 64) { const int n = idx >> 10, k = idx & 1023; const float v = n == 0 ? F.in[7][k] : F.in[6][(n - 1) * 1024 + k]; S[idx] = siluf(v); }
        __syncthreads();
        const float* W = F.in[9] + (size_t)l * 1024 * 3072 + c0 + F.lane;
        float acc[9];
#pragma unroll
        for (int n = 0; n < 9; ++n) acc[n] = 0.f;
        const int k0 = F.wave * 128;
#pragma unroll 4
        for (int kk = 0; kk < 128; ++kk) { const float wv = W[(size_t)(k0 + kk) * 3072];
#pragma unroll
            for (int n = 0; n < 9; ++n) acc[n] += S[n * 1024 + k0 + kk] * wv; }
        float* red = S + 9216;
#pragma unroll
        for (int n = 0; n < 9; ++n) red[(F.wave * 9 + n) * 64 + F.lane] = acc[n];
        __syncthreads();
        for (int idx = F.tid; idx < 576; idx += NWAVES * 64) { const int n = idx >> 6, ln = idx & 63; float s = F.in[10][l * 3072 + c0 + ln];
#pragma unroll
            for (int w = 0; w < 8; ++w) s += red[(w * 9 + n) * 64 + ln];
            mods[(size_t)(l * 9 + n) * 3072 + c0 + ln] = s; }
        __syncthreads();
    }
    float* scr = (float*)(F.lds + F.wave * 16384);
    const int gw = F.vcu * NWAVES + F.wave, NGW = F.G * NWAVES;
    constexpr int I0 = 16 * 144, I1 = 16 * 32, I2 = 16 * 64, I3 = 16 * 32, I4 = 32 * 8;
    for (int it = gw; it < I0 + I1 + I2 + I3 + I4; it += NGW) {
        int r = it;
        if (r < I0) { p0_transpose_item(F.in[11], 1024, 4608, (bf16*)(F.ws + WS_WIE), scr, r, F.lane); continue; } r -= I0;
        if (r < I1) { p0_transpose_item(F.in[12], 1024, 1024, (bf16*)(F.ws + WS_WOE), scr, r, F.lane); continue; } r -= I1;
        if (r < I2) { p0_transpose_item(F.in[16], 1024, 2048, (bf16*)(F.ws + WS_WIO), scr, r, F.lane); continue; } r -= I2;
        if (r < I3) { p0_transpose_item(F.in[17], 1024, 1024, (bf16*)(F.ws + WS_WOO), scr, r, F.lane); continue; } r -= I3;
        const int mat = r >> 3;
        p0_transpose_item(F.in[20] + (size_t)mat * 16384, 128, 128, (bf16*)(F.ws + WS_GW) + (size_t)mat * 16384, scr, r & 7, F.lane);
    }
}
__device__ __forceinline__ void modnorm_rows(Frame& F, int layer, const float* xa, const float* xb) {
    const float* mods = (const float*)(F.ws + WS_MODS) + (size_t)layer * 9 * 3072;
    const float* gain = F.in[8] + layer * 1024;
    bf16* H = (bf16*)(F.ws + WS_H);
    const int gw = F.vcu * NWAVES + F.wave, NGW = F.G * NWAVES;
    for (int m = gw; m < M_ALL; m += NGW) {
        const int n = m < M_CTX ? 0 : 1 + ((m - M_CTX) >> 11);
        const f32x4* xr = (const f32x4*)(m < M_CTX ? xa + (size_t)m * DM : xb + (size_t)(m - M_CTX) * DM) + F.lane;
        const f32x4* sh = (const f32x4*)(mods + (size_t)n * 3072) + F.lane; const f32x4* sc = (const f32x4*)(mods + (size_t)n * 3072 + 1024) + F.lane;
        const f32x4* gp = (const f32x4*)gain + F.lane;
        f32x4 v[4]; float s = 0.f;
#pragma unroll
        for (int j = 0; j < 4; ++j) { v[j] = xr[64 * j]; s += (v[j].x * v[j].x + v[j].y * v[j].y) + (v[j].z * v[j].z + v[j].w * v[j].w); }
        const float rstd = 1.0f / sqrtf(wave_sum(s) * (1.0f / DM) + 1e-6f);
        unsigned long long* o8 = (unsigned long long*)(H + (size_t)m * DM) + F.lane;
#pragma unroll
        for (int j = 0; j < 4; ++j) { const f32x4 g = gp[64 * j], a = sc[64 * j], b = sh[64 * j]; const f32x4 o = v[j] * rstd * g * (1.0f + a) + b;
            o8[64 * j] = (unsigned long long)pk2(o.x, o.y) | ((unsigned long long)pk2(o.z, o.w) << 32); }
    }
}
__device__ __forceinline__ void hgrn_naive_item(Frame& F, int item) {
    const int s = item >> 3, h = (item >> 1) & 3, d = item & 1;
    const bool lat = s >= 16; const int T = lat ? 2048 : 256; const int row0 = lat ? M_CTX + (s - 16) * 2048 : s * 256;
    bf16* P = (bf16*)(F.ws + WS_PROJ);
    float* Lq = (float*)F.lds; float* Lf = Lq + 128; float* Lk = Lf + 128; float* Lv = Lk + 128; float* Lp = Lv + 128;
    const int tid = F.tid, dv = tid & 127, kq = tid >> 7;
    const int zcol = (d == 0 ? 512 : 1024) + h * 128;
    float S[32];
    if (lat) { const float* s0 = F.in[2] + ((size_t)(((s - 16) * 2 + d) * 4 + h)) * 16384;
#pragma unroll
        for (int i = 0; i < 32; ++i) S[i] = s0[(32 * kq + i) * 128 + dv]; }
    else {
#pragma unroll
        for (int i = 0; i < 32; ++i) S[i] = 0.f; }
    float lbv = 0.f;
    if (tid < 128) { const float l0 = F.in[13][(d * 2 + 0) * 512 + h * 128 + tid], l1 = F.in[13][(d * 2 + 1) * 512 + h * 128 + tid]; lbv = 1.0f / (1.0f + __expf(l1 - l0)); }
    __syncthreads();
    for (int tt = 0; tt < T; ++tt) {
        const int tok = d == 0 ? tt : T - 1 - tt; const size_t rb = (size_t)(row0 + tok) * EVEN_IN;
        if (tid < 128) { const float z = bf2f(P[rb + zcol + tid]); const float sg = sigmoidf(z);
            Lf[tid] = lbv + (1.0f - lbv) * sg; Lk[tid] = (1.0f - lbv) * (1.0f - sg); Lq[tid] = bf2f(P[rb + h * 128 + tid]); }
        else if (tid < 256) Lv[tid - 128] = bf2f(P[rb + 1536 + h * 128 + (tid - 128)]);
        __syncthreads();
        const float v = Lv[dv]; float part = 0.f;
#pragma unroll
        for (int i = 0; i < 32; ++i) { const int dk = 32 * kq + i; S[i] = Lf[dk] * S[i] + Lk[dk] * v; part += S[i] * Lq[dk]; }
        Lp[kq * 128 + dv] = part;
        __syncthreads();
        if (tid < 128) { const float o = (Lp[tid] + Lp[128 + tid]) + (Lp[256 + tid] + Lp[384 + tid]); P[rb + zcol + tid] = (bf16)f2bf(o); }
    }
    if (!lat) { float* so = F.out + OUT_HG + ((size_t)((s * 2 + d) * 4 + h)) * 16384;
#pragma unroll
        for (int i = 0; i < 32; ++i) so[(32 * kq + i) * 128 + dv] = S[i]; }
    __syncthreads();
}
__device__ __forceinline__ float dot64_bf(const float* qs, const bf16* kp) {
    float dot = 0.f;
    for (int e = 0; e < 8; ++e) { const v4u w = ((const v4u*)kp)[e]; const float* q = qs + 8 * e;
        dot += (q[0] * bflo(w.x) + q[1] * bfhi(w.x)) + (q[2] * bflo(w.y) + q[3] * bfhi(w.y)) + (q[4] * bflo(w.z) + q[5] * bfhi(w.z)) + (q[6] * bflo(w.w) + q[7] * bfhi(w.w)); }
    return dot;
}
__device__ __forceinline__ void attn_naive_item(Frame& F, int it) {
    const int m = it >> 3, head = it & 7, lane = F.lane;
    bf16* P = (bf16*)(F.ws + WS_PROJ);
    float* qs = (float*)(F.lds + F.wave * 2048); float* ps = qs + 64;
    qs[lane] = bf2f(P[(size_t)m * EVEN_IN + 2560 + head * 64 + lane]);
    LDS_WAIT(); asm volatile("" ::: "memory");
    float sc[6]; int nk;
    const bool lat = m >= M_CTX;
    int b = 0, r = 0, c = 0, rs = 0, wsx = 0;
    if (lat) { b = (m - M_CTX) >> 11; const int t = (m - M_CTX) & 2047; r = t >> 6; c = t & 63; rs = min(max(r - 4, 0), 24); wsx = min(max(c - 8, 0), 48); nk = 6; } else { b = m >> 8; nk = 4; }
#pragma unroll
    for (int i = 0; i < 6; ++i) {
        sc[i] = -1e30f;
        if (i < nk) {
            const int j = lane + 64 * i; float dot = 0.f, bias = 0.f;
            if (lat && i < 2) { const int kr = j >> 4, kc = j & 15; const int tk = (rs + kr) * 64 + wsx + kc;
                dot = dot64_bf(qs, P + (size_t)(M_CTX + b * 2048 + tk) * EVEN_IN + 3072 + head * 64);
                bias = F.in[15][(head * 15 + (rs + kr - r + 7)) * 31 + (wsx + kc - c + 15)]; }
            else if (lat) { const float* kp = F.in[3] + ((size_t)(b * 8 + head) * 256 + (j - 128)) * 64;
                for (int e = 0; e < 16; ++e) { const f32x4 kv = ((const f32x4*)kp)[e]; dot += (qs[4 * e] * kv.x + qs[4 * e + 1] * kv.y) + (qs[4 * e + 2] * kv.z + qs[4 * e + 3] * kv.w); } }
            else dot = dot64_bf(qs, P + (size_t)(b * 256 + j) * EVEN_IN + 3072 + head * 64);
            sc[i] = dot * 0.125f + bias;
        }
    }
    float mx = sc[0];
#pragma unroll
    for (int i = 1; i < 6; ++i) mx = fmaxf(mx, sc[i]);
#pragma unroll
    for (int o = 1; o < 64; o <<= 1) mx = fmaxf(mx, __shfl_xor(mx, o));
    float sum = 0.f;
#pragma unroll
    for (int i = 0; i < 6; ++i) { sc[i] = (i < nk) ? __expf(sc[i] - mx) : 0.f; sum += sc[i]; }
    sum = wave_sum(sum); const float inv = 1.0f / sum;
#pragma unroll
    for (int i = 0; i < 6; ++i) if (i < nk) ps[lane + 64 * i] = sc[i] * inv;
    LDS_WAIT(); asm volatile("" ::: "memory");
    float o = 0.f;
    if (lat) {
        for (int j = 0; j < 128; ++j) { const int kr = j >> 4, kc = j & 15; const int tk = (rs + kr) * 64 + wsx + kc;
            o += ps[j] * bf2f(P[(size_t)(M_CTX + b * 2048 + tk) * EVEN_IN + 3584 + head * 64 + lane]); }
        const float* vp = F.in[4] + ((size_t)(b * 8 + head) * 256) * 64 + lane;
        for (int j = 0; j < 256; ++j) o += ps[128 + j] * vp[(size_t)j * 64];
    } else {
        for (int j = 0; j < 256; ++j) o += ps[j] * bf2f(P[(size_t)(b * 256 + j) * EVEN_IN + 3584 + head * 64 + lane]);
    }
    P[(size_t)m * EVEN_IN + 2560 + head * 64 + lane] = (bf16)f2bf(o);
    LDS_WAIT(); asm volatile("" ::: "memory");
}
constexpr size_t WS_RGF = WS_PROJ + 80 * MiB, WS_RGB = WS_PROJ + 120 * MiB;
__device__ __forceinline__ void rg_naive_item(Frame& F, int item) {
    const int s = item >> 4, hb = (item >> 1) & 7, d = item & 1;
    const bool lat = s >= 16; const int T = lat ? 2048 : 256; const int row0 = lat ? M_CTX + (s - 16) * 2048 : s * 256;
    const bf16* P2 = (const bf16*)(F.ws + WS_PROJ);
    bf16* O = (bf16*)(F.ws + (d == 0 ? WS_RGF : WS_RGB));
    float* XB = (float*)F.lds; float* XC = XB + 19 * 128; float* GG = XC + 16 * 128;
    const int tid = F.tid;
    float hst = 0.f, sp = 0.f;
    if (tid < 128) { if (lat) hst = F.in[5][((s - 16) * 2 + d) * 1024 + hb * 128 + tid]; const float lam = F.in[22][d * 1024 + hb * 128 + tid]; sp = log1pf(__expf(-lam)); }
    for (int k = 0; k < T / 16; ++k) {
        const int tb = d == 0 ? 16 * k : T - 16 * (k + 1);
        for (int idx = tid; idx < 19 * 128; idx += NWAVES * 64) { const int hr = idx >> 7, ch = idx & 127, tok = tb + hr - 2;
            XB[idx] = (tok >= 0 && tok < T) ? bf2f(P2[(size_t)(row0 + tok) * ODD_IN + hb * 128 + ch]) : 0.f; }
        __syncthreads();
        for (int idx = tid; idx < 16 * 128; idx += NWAVES * 64) { const int t = idx >> 7, ch = idx & 127; float a = F.in[19][hb * 128 + ch];
#pragma unroll
            for (int j = 0; j < 4; ++j) a += F.in[18][j * 1024 + hb * 128 + ch] * XB[(t + j) * 128 + ch];
            XC[idx] = a; }
        __syncthreads();
        { const int g = tid >> 8, th = (tid >> 7) & 1, j = tid & 127;
          const float* w = F.in[20] + ((size_t)((d * 2 + g) * 8 + hb) * 128) * 128 + j;
          float acc[8];
#pragma unroll
          for (int t = 0; t < 8; ++t) acc[t] = 0.f;
          for (int i = 0; i < 128; ++i) { const float wv = w[(size_t)i * 128];
#pragma unroll
              for (int t = 0; t < 8; ++t) acc[t] += XC[(th * 8 + t) * 128 + i] * wv; }
          const float gb = F.in[21][(d * 2 + g) * 1024 + hb * 128 + j];
#pragma unroll
          for (int t = 0; t < 8; ++t) GG[(g * 16 + th * 8 + t) * 128 + j] = sigmoidf(acc[t] + gb); }
        __syncthreads();
        if (tid < 128) {
            for (int tt = 0; tt < 16; ++tt) { const int t = d == 0 ? tt : 15 - tt;
                const float rr = GG[t * 128 + tid], ii = GG[(16 + t) * 128 + tid];
                const float la = -8.0f * rr * sp; const float a = __expf(la); const float u = sqrtf(-expm1f(2.0f * la)) * (ii * XC[t * 128 + tid]);
                hst = a * hst + u;
                O[(size_t)(row0 + tb + t) * DM + hb * 128 + tid] = (bf16)f2bf(hst); } }
        __syncthreads();
    }
    if (!lat && tid < 128) F.out[OUT_RG + (s * 2 + d) * 1024 + hb * 128 + tid] = hst;
}
__device__ __forceinline__ void gate_even_rows(Frame& F) {
    const bf16* P = (const bf16*)(F.ws + WS_PROJ); bf16* Y = (bf16*)(F.ws + WS_H);
    const int gw = F.vcu * NWAVES + F.wave, NGW = F.G * NWAVES, lane = F.lane;
    const f32x4 g0 = ((const f32x4*)F.in[14])[lane * 2], g1 = ((const f32x4*)F.in[14])[lane * 2 + 1];
    const float gain[8] = {g0.x, g0.y, g0.z, g0.w, g1.x, g1.y, g1.z, g1.w};
    for (int m = gw; m < M_ALL; m += NGW) {
        const bf16* pr = P + (size_t)m * EVEN_IN + lane * 8;
        const v4u wf = *(const v4u*)(pr + 512), wb = *(const v4u*)(pr + 1024), wga = *(const v4u*)(pr + 2048), wo = *(const v4u*)(pr + 2560), wgb = *(const v4u*)(pr + 4096);
        float o[8], ga[8], ob[8], gb[8];
#pragma unroll
        for (int e = 0; e < 4; ++e) { o[2 * e] = bflo(wf[e]) + bflo(wb[e]); o[2 * e + 1] = bfhi(wf[e]) + bfhi(wb[e]); ga[2 * e] = bflo(wga[e]); ga[2 * e + 1] = bfhi(wga[e]);
            ob[2 * e] = bflo(wo[e]); ob[2 * e + 1] = bfhi(wo[e]); gb[2 * e] = bflo(wgb[e]); gb[2 * e + 1] = bfhi(wgb[e]); }
        float ss = 0.f;
#pragma unroll
        for (int e = 0; e < 8; ++e) ss += o[e] * o[e];
        ss += __shfl_xor(ss, 1); ss += __shfl_xor(ss, 2); ss += __shfl_xor(ss, 4); ss += __shfl_xor(ss, 8);
        const float rstd = 1.0f / sqrtf(ss * (1.0f / 128.0f) + 1e-6f);
        float ya[8], yb[8];
#pragma unroll
        for (int e = 0; e < 8; ++e) { ya[e] = o[e] * rstd * gain[e] * siluf(ga[e]); yb[e] = ob[e] * siluf(gb[e]); }
        v4u wa, wbo;
#pragma unroll
        for (int e = 0; e < 4; ++e) { wa[e] = pk2(ya[2 * e], ya[2 * e + 1]); wbo[e] = pk2(yb[2 * e], yb[2 * e + 1]); }
        bf16* yr = Y + (size_t)m * DM + lane * 8;
        *(v4u*)yr = wa; *(v4u*)(yr + 512) = wbo;
    }
}
__device__ __forceinline__ void rg_combine_rows(Frame& F) {
    const bf16* P2 = (const bf16*)(F.ws + WS_PROJ); const bf16* OF = (const bf16*)(F.ws + WS_RGF); const bf16* OB = (const bf16*)(F.ws + WS_RGB); bf16* Y = (bf16*)(F.ws + WS_H);
    const int gw = F.vcu * NWAVES + F.wave, NGW = F.G * NWAVES, lane = F.lane;
    for (int m = gw; m < M_ALL; m += NGW) {
#pragma unroll
        for (int part = 0; part < 2; ++part) { const int c0 = part * 512 + lane * 8;
            const v4u a = *(const v4u*)(OF + (size_t)m * DM + c0), b = *(const v4u*)(OB + (size_t)m * DM + c0), g = *(const v4u*)(P2 + (size_t)m * ODD_IN + 1024 + c0);
            v4u w;
#pragma unroll
            for (int e = 0; e < 4; ++e) w[e] = pk2((bflo(a[e]) + bflo(b[e])) * siluf(bflo(g[e])), (bfhi(a[e]) + bfhi(b[e])) * siluf(bfhi(g[e])));
            *(v4u*)(Y + (size_t)m * DM + c0) = w; }
    }
}
__device__ __forceinline__ void final_norm_rows(Frame& F) {
    const int gw = F.vcu * NWAVES + F.wave, NGW = F.G * NWAVES;
    const f32x4* gp = (const f32x4*)F.in[23] + F.lane;
    for (int m = gw; m < M_ALL; m += NGW) {
        f32x4* xr = (f32x4*)(F.out + (size_t)m * DM) + F.lane;
        f32x4 v[4]; float s = 0.f;
#pragma unroll
        for (int j = 0; j < 4; ++j) { v[j] = xr[64 * j]; s += (v[j].x * v[j].x + v[j].y * v[j].y) + (v[j].z * v[j].z + v[j].w * v[j].w); }
        const float rstd = 1.0f / sqrtf(wave_sum(s) * (1.0f / DM) + 1e-6f);
#pragma unroll
        for (int j = 0; j < 4; ++j) xr[64 * j] = v[j] * rstd * gp[64 * j];
    }
}
typedef float f32x2_t __attribute__((ext_vector_type(2))); typedef __bf16 bf16x2_t __attribute__((ext_vector_type(2)));
__device__ __forceinline__ unsigned cvtpk(float lo, float hi) { f32x2_t v = {lo, hi}; bf16x2_t b = __builtin_convertvector(v, bf16x2_t); return __builtin_bit_cast(unsigned, b); }
#define MFMA32(a, b, c) __builtin_amdgcn_mfma_f32_32x32x16_bf16((a), (b), (c), 0, 0, 0)
template <int ST> __device__ __forceinline__ bf16x8 pack8(const f32x16& x) {
    v4u p; p.x = cvtpk(x[8 * ST], x[8 * ST + 1]); p.y = cvtpk(x[8 * ST + 2], x[8 * ST + 3]); p.z = cvtpk(x[8 * ST + 4], x[8 * ST + 5]); p.w = cvtpk(x[8 * ST + 6], x[8 * ST + 7]);
    return __builtin_bit_cast(bf16x8, p);
}
__device__ __forceinline__ bf16x8 cat4(s16x4 lo, s16x4 hi) { return __builtin_shufflevector(lo, hi, 0, 1, 2, 3, 4, 5, 6, 7); }
constexpr int HG_QD = 0, HG_KI = 8704, HG_KDT = 17408, HG_VT = 27648, HG_DEC = 37888, HG_BUF = 38400, HG_RAW = 76800;
__device__ __forceinline__ void hgrn_mfma_item(Frame& F, int item) {
    const int s = item >> 3, h = (item >> 1) & 3, d = item & 1;
    const bool lat = s >= 16; const int T = lat ? 2048 : 256; const int row0 = lat ? M_CTX + (s - 16) * 2048 : s * 256; const int nch = T / 32;
    bf16* P = (bf16*)(F.ws + WS_PROJ);
    LAS unsigned char* L = (LAS unsigned char*)F.lds;
    const int zcol = (d == 0 ? 512 : 1024) + h * 128;
    const int lane = F.lane, r = lane & 31, hh = lane >> 5;
    if (F.wave >= 4) {
        const int pw = F.wave - 4, dk = 32 * pw + r;
        const float l0 = F.in[13][(d * 2 + 0) * 512 + h * 128 + dk], l1 = F.in[13][(d * 2 + 1) * 512 + h * 128 + dk];
        const float lbv = 1.0f / (1.0f + __expf(l1 - l0)), omlb = 1.0f - lbv;
        const int pt = F.tid - 256;
        v4u az[2], aq[2], av[2], bz[2], bq[2], bv[2];
#define HG_ISSUE(Z, Q, V, n) do { _Pragma("unroll") for (int j = 0; j < 2; ++j) { const int piece = pt + 256 * j, i = piece >> 4, oct = piece & 15; const int tok = d == 0 ? 32 * (n) + i : T - 1 - (32 * (n) + i); \
            const bf16* pr = P + (size_t)(row0 + tok) * EVEN_IN + oct * 8; Z[j] = *(const v4u*)(pr + zcol); Q[j] = *(const v4u*)(pr + h * 128); V[j] = *(const v4u*)(pr + 1536 + h * 128); } } while (0)
#define HG_WRITE(Z, Q, V, n) do { LAS unsigned char* RB = L + HG_RAW + ((n) & 1) * 24576; _Pragma("unroll") for (int j = 0; j < 2; ++j) { const int piece = pt + 256 * j; \
            *(LAS v4u*)(RB + piece * 16) = Z[j]; *(LAS v4u*)(RB + 8192 + piece * 16) = Q[j]; *(LAS v4u*)(RB + 16384 + piece * 16) = V[j]; } } while (0)
#define HG_PREP(n) do { LAS unsigned char* B = L + ((n) & 1) * HG_BUF; const LAS unsigned char* RB = L + HG_RAW + ((n) & 1) * 24576 + dk * 2; \
            float lf[16], kk[16]; float tot = 0.f; \
            _Pragma("unroll") for (int ii = 0; ii < 16; ++ii) { const float z = bf2f(*(const LAS unsigned short*)(RB + (16 * hh + ii) * 256)); const float sg = rcpf_(1.0f + fexp(-z)); const float f = lbv + omlb * sg; lf[ii] = flog(f); kk[ii] = omlb * (1.0f - sg); tot += lf[ii]; } \
            const float other = __shfl_xor(tot, 32); const float bend = tot + other, ebend = fexp(bend); float b = hh ? other : 0.f; \
            unsigned kd[8], vv[8]; \
            _Pragma("unroll") for (int ii = 0; ii < 16; ++ii) { b += lf[ii]; const int i = 16 * hh + ii; const float eb = fexp(b), ki = kk[ii] * rcpf_(eb); \
                const float qd = bf2f(*(const LAS unsigned short*)(RB + 8192 + i * 256)) * eb, kdv = ki * ebend; const unsigned vraw = *(const LAS unsigned short*)(RB + 16384 + i * 256); \
                *(LAS unsigned short*)(B + HG_QD + i * 272 + dk * 2) = (unsigned short)f2bf(qd); \
                *(LAS unsigned short*)(B + HG_KI + i * 272 + dk * 2) = (unsigned short)f2bf(ki); \
                if (ii & 1) { kd[ii >> 1] |= f2bf(kdv) << 16; vv[ii >> 1] |= vraw << 16; } else { kd[ii >> 1] = f2bf(kdv); vv[ii >> 1] = vraw; } } \
            *(LAS v4u*)(B + HG_KDT + dk * 80 + hh * 32) = (v4u){kd[0], kd[1], kd[2], kd[3]}; *(LAS v4u*)(B + HG_KDT + dk * 80 + hh * 32 + 16) = (v4u){kd[4], kd[5], kd[6], kd[7]}; \
            *(LAS v4u*)(B + HG_VT + dk * 80 + hh * 32) = (v4u){vv[0], vv[1], vv[2], vv[3]}; *(LAS v4u*)(B + HG_VT + dk * 80 + hh * 32 + 16) = (v4u){vv[4], vv[5], vv[6], vv[7]}; \
            if (hh == 0) *(LAS float*)(B + HG_DEC + dk * 4) = ebend; } while (0)
        HG_ISSUE(az, aq, av, 0); HG_ISSUE(bz, bq, bv, 1);
        HG_WRITE(az, aq, av, 0); HG_ISSUE(az, aq, av, 2);
        __syncthreads();
        for (int n = 0; n < nch; n += 2) {
            HG_WRITE(bz, bq, bv, n + 1); if (n + 3 < nch) HG_ISSUE(bz, bq, bv, n + 3);
            HG_PREP(n);
            __syncthreads();
            if (n + 2 < nch) { HG_WRITE(az, aq, av, n + 2); if (n + 4 < nch) HG_ISSUE(az, aq, av, n + 4); }
            HG_PREP(n + 1);
            __syncthreads();
        }
        __syncthreads();
#undef HG_ISSUE
#undef HG_WRITE
#undef HG_PREP
    } else {
        const int w = F.wave, dvc = 32 * w + r; const long osgn = d == 0 ? 1 : -1;
        f32x16 S[4];
        if (lat) { const float* s0 = F.in[2] + ((size_t)(((s - 16) * 2 + d) * 4 + h)) * 16384;
#pragma unroll
            for (int i = 0; i < 4; ++i)
#pragma unroll
                for (int g = 0; g < 16; ++g) S[i][g] = s0[(32 * i + (g & 3) + 8 * (g >> 2) + 4 * hh) * 128 + dvc]; }
        else {
#pragma unroll
            for (int i = 0; i < 4; ++i)
#pragma unroll
                for (int g = 0; g < 16; ++g) S[i][g] = 0.f; }
        __syncthreads();
        __syncthreads();
        for (int n = 0; n < nch; ++n) {
            LAS unsigned char* B = L + (n & 1) * HG_BUF;
#define HG_FENCE() asm volatile("" ::: "memory")
            bf16x8 ka[8], qb[8];
#pragma unroll
            for (int st = 0; st < 8; ++st) { ka[st] = *(const LAS bf16x8*)(B + HG_KI + r * 272 + (16 * st + 8 * hh) * 2); qb[st] = *(const LAS bf16x8*)(B + HG_QD + r * 272 + (16 * st + 8 * hh) * 2); }
            HG_FENCE();
            f32x16 X;
#pragma unroll
            for (int g = 0; g < 16; ++g) X[g] = 0.f;
#pragma unroll
            for (int st = 0; st < 8; ++st) X = MFMA32(ka[st], qb[st], X);
            s16x4 ql[8], qh[8], vl[2], vh[2];
#pragma unroll
            for (int j = 0; j < 8; ++j) { const LAS unsigned char* qd = B + HG_QD + r * 272 + 32 * j + 8 * hh; ql[j] = *(const LAS s16x4*)(qd); qh[j] = *(const LAS s16x4*)(qd + 16); }
            { const LAS unsigned char* vt = B + HG_VT + dvc * 80 + 8 * hh;
              vl[0] = *(const LAS s16x4*)(vt); vh[0] = *(const LAS s16x4*)(vt + 16); vl[1] = *(const LAS s16x4*)(vt + 32); vh[1] = *(const LAS s16x4*)(vt + 48); }
            bf16x8 kd[8], vb[2];
#pragma unroll
            for (int i = 0; i < 4; ++i)
#pragma unroll
                for (int st = 0; st < 2; ++st) kd[2 * i + st] = *(const LAS bf16x8*)(B + HG_KDT + (32 * i + r) * 80 + (16 * st + 8 * hh) * 2);
#pragma unroll
            for (int st = 0; st < 2; ++st) vb[st] = *(const LAS bf16x8*)(B + HG_VT + dvc * 80 + (16 * st + 8 * hh) * 2);
            HG_FENCE();
#pragma unroll
            for (int g = 0; g < 16; ++g) { const int sr = (g & 3) + 8 * (g >> 2) + 4 * hh; X[g] = sr <= r ? X[g] : 0.f; }
            const bf16x8 xa0 = pack8<0>(X), xa1 = pack8<1>(X);
            f32x16 O;
#pragma unroll
            for (int g = 0; g < 16; ++g) O[g] = 0.f;
#pragma unroll
            for (int i = 0; i < 4; ++i) { O = MFMA32(cat4(ql[2 * i], qh[2 * i]), pack8<0>(S[i]), O); O = MFMA32(cat4(ql[2 * i + 1], qh[2 * i + 1]), pack8<1>(S[i]), O); }
            O = MFMA32(xa0, cat4(vl[0], vh[0]), O);
            O = MFMA32(xa1, cat4(vl[1], vh[1]), O);
            HG_FENCE();
            f32x4 dc[16];
#pragma unroll
            for (int i = 0; i < 4; ++i)
#pragma unroll
                for (int G = 0; G < 4; ++G) dc[4 * i + G] = *(const LAS f32x4*)(B + HG_DEC + (32 * i + 8 * G + 4 * hh) * 4);
            HG_FENCE();
#pragma unroll
            for (int i = 0; i < 4; ++i) {
#pragma unroll
                for (int g = 0; g < 16; ++g) S[i][g] *= dc[4 * i + (g >> 2)][g & 3];
                S[i] = MFMA32(kd[2 * i], vb[0], S[i]); S[i] = MFMA32(kd[2 * i + 1], vb[1], S[i]); }
            { bf16* ob = P + (size_t)(row0 + (d == 0 ? 32 * n + 4 * hh : T - 1 - 32 * n - 4 * hh)) * EVEN_IN + zcol + dvc;
#pragma unroll
              for (int g = 0; g < 16; ++g) ob[osgn * (long)(((g & 3) + 8 * (g >> 2)) * EVEN_IN)] = (bf16)f2bf(O[g]); }
#undef HG_FENCE
            __syncthreads();
        }
        if (!lat) { float* so = F.out + OUT_HG + ((size_t)((s * 2 + d) * 4 + h)) * 16384;
#pragma unroll
            for (int i = 0; i < 4; ++i)
#pragma unroll
                for (int g = 0; g < 16; ++g) so[(32 * i + (g & 3) + 8 * (g >> 2) + 4 * hh) * 128 + dvc] = S[i][g]; }
    }
}
#define MFMA16(a, b, c) __builtin_amdgcn_mfma_f32_16x16x32_bf16((a), (b), (c), 0, 0, 0)
typedef short v4i16_t __attribute__((ext_vector_type(4)));
__device__ __forceinline__ s16x4 vtr(const LAS unsigned char* p) { return __builtin_bit_cast(s16x4, __builtin_amdgcn_ds_read_tr16_b64_v4i16((LAS v4i16_t*)p)); }
__device__ __forceinline__ bf16x8 pack44(const f32x4& a, const f32x4& b) { v4u p; p.x = cvtpk(a[0], a[1]); p.y = cvtpk(a[2], a[3]); p.z = cvtpk(b[0], b[1]); p.w = cvtpk(b[2], b[3]); return __builtin_bit_cast(bf16x8, p); }
constexpr int AT_VL = 0, AT_KC = 73728, AT_VC = AT_KC + 36864, AT_BT = AT_VC + 32768, AT_END = AT_BT + 2048;
static_assert(AT_END <= MISC_OFF, "attention LDS map");
template <bool LOCAL> __device__ __forceinline__ void attn_mfma_item(Frame& F, int item, int scr = 0) {
    LAS unsigned char* L = (LAS unsigned char*)F.lds;
    bf16* P = (bf16*)(F.ws + WS_PROJ);
    const int tid = F.tid, lane = F.lane, fr = lane & 15, fq = lane >> 4, w = F.wave;
    int b, head, rp = 0, half = 0, rs0 = 0;
    if (LOCAL) { b = item >> 7; head = (item >> 4) & 7; rp = item & 15; rs0 = min(max(2 * rp - 4, 0), 24); }
    else { b = item >> 4; head = (item >> 1) & 7; half = item & 1; }
    if (LOCAL) {
        const int nrows = min(9, 32 - rs0);
        for (int c = tid; c < nrows * 512; c += NWAVES * 64) { const int key = c >> 3, ch = c & 7;
            *(LAS v4u*)(L + AT_VL + key * 128 + ch * 16) = *(const v4u*)(P + (size_t)(M_CTX + b * 2048 + rs0 * 64 + key) * EVEN_IN + 3584 + head * 64 + ch * 8); }
        const float* kc = F.in[3] + (size_t)(b * 8 + head) * 16384; const float* vc = F.in[4] + (size_t)(b * 8 + head) * 16384;
        for (int c = tid; c < 2048; c += NWAVES * 64) { const int key = c >> 3, ch = c & 7;
            const f32x4 a0 = *(const f32x4*)(kc + key * 64 + ch * 8), a1 = *(const f32x4*)(kc + key * 64 + ch * 8 + 4);
            *(LAS v4u*)(L + AT_KC + key * 144 + ch * 16) = (v4u){pk2(a0.x, a0.y), pk2(a0.z, a0.w), pk2(a1.x, a1.y), pk2(a1.z, a1.w)};
            const f32x4 b0 = *(const f32x4*)(vc + key * 64 + ch * 8), b1 = *(const f32x4*)(vc + key * 64 + ch * 8 + 4);
            *(LAS v4u*)(L + AT_VC + key * 128 + ch * 16) = (v4u){pk2(b0.x, b0.y), pk2(b0.z, b0.w), pk2(b1.x, b1.y), pk2(b1.z, b1.w)}; }
        for (int i = tid; i < 465; i += NWAVES * 64) ((LAS float*)(L + AT_BT))[i] = F.in[15][head * 465 + i];
    } else {
        for (int c = tid; c < 2048; c += NWAVES * 64) { const int key = c >> 3, ch = c & 7; const bf16* pr = P + (size_t)(b * 256 + key) * EVEN_IN + head * 64 + ch * 8;
            *(LAS v4u*)(L + AT_KC + key * 144 + ch * 16) = *(const v4u*)(pr + 3072); *(LAS v4u*)(L + AT_VC + key * 128 + ch * 16) = *(const v4u*)(pr + 3584); }
    }
    const int ri = w >> 2, jb = w & 3, r = 2 * rp + ri;
    const int qbase = LOCAL ? M_CTX + b * 2048 + r * 64 + 16 * jb : b * 256 + half * 128 + 16 * w;
    const bf16* qp = P + (size_t)(qbase + fr) * EVEN_IN + 2560 + head * 64 + 8 * fq;
    const bf16x8 qf0 = *(const bf16x8*)qp, qf1 = *(const bf16x8*)(qp + 32);
    __syncthreads();
    const int trow = fr >> 2, tcol = (fr & 3) * 8;
    f32x4 O1[4];
#pragma unroll
    for (int dt = 0; dt < 4; ++dt) O1[dt] = (f32x4){0.f, 0.f, 0.f, 0.f};
    float mx1 = -1e30f, l1 = 0.f;
    {
        f32x4 sc[16];
#pragma unroll
        for (int kt = 0; kt < 16; ++kt) { const LAS unsigned char* kp = L + AT_KC + (16 * kt + fr) * 144 + 16 * fq;
            f32x4 acc = {0.f, 0.f, 0.f, 0.f}; acc = MFMA16(*(const LAS bf16x8*)kp, qf0, acc); acc = MFMA16(*(const LAS bf16x8*)(kp + 64), qf1, acc);
            acc = acc * 0.125f; sc[kt] = acc; mx1 = fmaxf(fmaxf(mx1, fmaxf(acc[0], acc[1])), fmaxf(acc[2], acc[3])); }
        mx1 = fmaxf(mx1, __shfl_xor(mx1, 16)); mx1 = fmaxf(mx1, __shfl_xor(mx1, 32));
#pragma unroll
        for (int kt = 0; kt < 16; ++kt)
#pragma unroll
            for (int e = 0; e < 4; ++e) { const float p = fexp(sc[kt][e] - mx1); sc[kt][e] = p; l1 += p; }
        l1 += __shfl_xor(l1, 16); l1 += __shfl_xor(l1, 32);
#pragma unroll
        for (int c = 0; c < 8; ++c) { const bf16x8 pa = pack44(sc[2 * c], sc[2 * c + 1]);
            const LAS unsigned char* v0 = L + AT_VC + (32 * c + 4 * fq + trow) * 128 + tcol;
#pragma unroll
            for (int dt = 0; dt < 4; ++dt) O1[dt] = MFMA16(pa, cat4(vtr(v0 + dt * 32), vtr(v0 + 16 * 128 + dt * 32)), O1[dt]); }
    }
    float f1 = 1.0f / l1, f2 = 0.f;
    f32x4 O2[4];
#pragma unroll
    for (int dt = 0; dt < 4; ++dt) O2[dt] = (f32x4){0.f, 0.f, 0.f, 0.f};
    if (LOCAL) {
        const int rs = min(max(r - 4, 0), 24), band = jb == 0 ? 0 : (jb == 1 ? 8 : (jb == 2 ? 24 : 32));
        const int qc = 16 * jb + fr, wsx = min(max(qc - 8, 0), 48);
        f32x4 sl[16]; float mx2 = -1e30f, l2 = 0.f;
#pragma unroll
        for (int kr = 0; kr < 8; ++kr)
#pragma unroll
            for (int hf = 0; hf < 2; ++hf) { const int tok = (rs + kr) * 64 + band + 16 * hf + fr;
                const bf16* kp = P + (size_t)(M_CTX + b * 2048 + tok) * EVEN_IN + 3072 + head * 64 + 8 * fq;
                f32x4 acc = {0.f, 0.f, 0.f, 0.f}; acc = MFMA16(*(const bf16x8*)kp, qf0, acc); acc = MFMA16(*(const bf16x8*)(kp + 32), qf1, acc);
                const LAS float* bt = (const LAS float*)(L + AT_BT) + (rs + kr - r + 7) * 31;
#pragma unroll
                for (int e = 0; e < 4; ++e) { const int kc = band + 16 * hf + 4 * fq + e; const bool valid = kc >= wsx && kc < wsx + 16;
                    const float bias = bt[min(max(kc - qc + 15, 0), 30)];
                    acc[e] = valid ? acc[e] * 0.125f + bias : -1e30f; mx2 = fmaxf(mx2, acc[e]); }
                sl[kr * 2 + hf] = acc; }
        mx2 = fmaxf(mx2, __shfl_xor(mx2, 16)); mx2 = fmaxf(mx2, __shfl_xor(mx2, 32));
#pragma unroll
        for (int kt = 0; kt < 16; ++kt)
#pragma unroll
            for (int e = 0; e < 4; ++e) { const float p = fexp(sl[kt][e] - mx2); sl[kt][e] = p; l2 += p; }
        l2 += __shfl_xor(l2, 16); l2 += __shfl_xor(l2, 32);
#pragma unroll
        for (int kr = 0; kr < 8; ++kr) { const bf16x8 pa = pack44(sl[2 * kr], sl[2 * kr + 1]);
            const LAS unsigned char* v0 = L + AT_VL + ((rs + kr - rs0) * 64 + band + 4 * fq + trow) * 128 + tcol;
#pragma unroll
            for (int dt = 0; dt < 4; ++dt) O2[dt] = MFMA16(pa, cat4(vtr(v0 + dt * 32), vtr(v0 + 16 * 128 + dt * 32)), O2[dt]); }
        const float m = fmaxf(mx1, mx2), a1 = fexp(mx1 - m), a2 = fexp(mx2 - m), linv = 1.0f / (l1 * a1 + l2 * a2);
        f1 = a1 * linv; f2 = a2 * linv;
    }
#pragma unroll
    for (int e = 0; e < 4; ++e) { const float g1 = __shfl(f1, 4 * fq + e), g2 = __shfl(f2, 4 * fq + e);
        bf16* op = (scr ? (bf16*)(F.ws + WS_H) : P) + (size_t)(scr ? ((qbase + 4 * fq + e) & 2047) : (qbase + 4 * fq + e)) * EVEN_IN + 2560 + head * 64 + fr;
#pragma unroll
        for (int dt = 0; dt < 4; ++dt) op[16 * dt] = (bf16)f2bf(O1[dt][e] * g1 + O2[dt][e] * g2); }
    __syncthreads();
}
constexpr int RG_XC = 0, RG_XCF = 17408, RG_HB = 50176, RG_CIN = 115712, RG_END = 125952;
template <bool APPLY> __device__ __forceinline__ void rg_phase(Frame& F) {
    LAS unsigned char* L = (LAS unsigned char*)F.lds;
    const bf16* P2 = (const bf16*)(F.ws + WS_PROJ);
    float* AGG = (float*)(F.ws + WS_AGG);
    const int bx = blockIdx.x, hb = bx & 7, t0i = bx >> 3;
    if (F.G != 256) return;
    const int tid = F.tid, lane = F.lane, r = lane & 31, hh = lane >> 5, w = F.wave, d = w >> 2, jq = w & 3;
    const int chl = 32 * jq + r, ch = hb * 128 + chl;
    if (APPLY) {
        for (int idx = tid; idx < 10 * 256; idx += NWAVES * 64) {
            const int k = idx >> 8, dd = (idx >> 7) & 1, c = idx & 127, ti = t0i + 32 * k;
            const bool lat = ti >= 64; const int first = lat ? 64 + ((ti - 64) & ~31) : (ti & ~3), nts = lat ? 32 : 4, pos = ti - first;
            const int cnt = dd == 0 ? pos : nts - 1 - pos;
            float st = lat ? F.in[5][(((ti - 64) >> 5) * 2 + dd) * 1024 + hb * 128 + c] : 0.f;
            float av[31], uv[31];
#pragma unroll
            for (int j = 0; j < 31; ++j) { const bool ok = j < cnt; const int tj = ok ? (dd == 0 ? first + j : first + nts - 1 - j) : ti;
                const float2 v = *(const float2*)(AGG + ((size_t)(tj * 2 + dd) * 1024 + hb * 128 + c) * 2); av[j] = ok ? v.x : 1.0f; uv[j] = ok ? v.y : 0.0f; }
#pragma unroll
            for (int j = 0; j < 31; ++j) st = av[j] * st + uv[j];
            *(LAS float*)(L + RG_CIN + ((k * 2 + dd) * 128 + c) * 4) = st;
        }
    }
    const float gb0 = F.in[21][(d * 2 + 0) * 1024 + ch], gb1 = F.in[21][(d * 2 + 1) * 1024 + ch];
    const float sp8 = -8.0f * log1pf(__expf(-F.in[22][d * 1024 + ch]));
    const int cc = tid & 127, tq = tid >> 7;
    const float cw0 = F.in[18][0 * 1024 + hb * 128 + cc], cw1 = F.in[18][1 * 1024 + hb * 128 + cc], cw2 = F.in[18][2 * 1024 + hb * 128 + cc], cw3 = F.in[18][3 * 1024 + hb * 128 + cc], cbv = F.in[19][hb * 128 + cc];
    for (int k = 0; k < 10; ++k) {
        const int ti = t0i + 32 * k; const int rowb = ti * 64;
        const bool lat = ti >= 64; const int pos = lat ? ((ti - 64) & 31) : (ti & 3), nts = lat ? 32 : 4;
        bf16x8 Bw[2][8];
#pragma unroll
        for (int g = 0; g < 2; ++g)
#pragma unroll
            for (int st = 0; st < 8; ++st) Bw[g][st] = *(const bf16x8*)((const bf16*)(F.ws + WS_GW) + (size_t)((d * 2 + g) * 8 + hb) * 16384 + chl * 128 + 16 * st + 8 * hh);
        { const bf16* xp = P2 + (size_t)(rowb + 16 * tq) * ODD_IN + hb * 128 + cc;
          const bool lo_ok = !(pos == 0 && tq == 0), hi_ok = !(pos == nts - 1 && tq == 3);
          float xm2 = lo_ok ? bf2f(xp[-2 * ODD_IN]) : 0.f, xm1 = lo_ok ? bf2f(xp[-1 * ODD_IN]) : 0.f, x0 = bf2f(xp[0]);
#pragma unroll
          for (int t = 0; t < 16; ++t) { const float x1 = (t < 15 || hi_ok) ? bf2f(xp[(size_t)(t + 1) * ODD_IN]) : 0.f;
              const float xc = cbv + cw0 * xm2 + cw1 * xm1 + cw2 * x0 + cw3 * x1;
              *(LAS unsigned short*)(L + RG_XC + (16 * tq + t) * 272 + cc * 2) = (unsigned short)f2bf(xc);
              *(LAS float*)(L + RG_XCF + ((16 * tq + t) * 128 + cc) * 4) = xc;
              xm2 = xm1; xm1 = x0; x0 = x1; } }
        __syncthreads();
        f32x16 acc[2][2];
#pragma unroll
        for (int g = 0; g < 2; ++g)
#pragma unroll
            for (int mt = 0; mt < 2; ++mt)
#pragma unroll
                for (int q = 0; q < 16; ++q) acc[g][mt][q] = 0.f;
#pragma unroll
        for (int st = 0; st < 8; ++st)
#pragma unroll
            for (int mt = 0; mt < 2; ++mt) { const bf16x8 a = *(const LAS bf16x8*)(L + RG_XC + (32 * mt + r) * 272 + (16 * st + 8 * hh) * 2);
                acc[0][mt] = MFMA32(a, Bw[0][st], acc[0][mt]); acc[1][mt] = MFMA32(a, Bw[1][st], acc[1][mt]); }
#pragma unroll
        for (int mt = 0; mt < 2; ++mt)
#pragma unroll
            for (int q = 0; q < 16; ++q) { const int t = 32 * mt + (q & 3) + 8 * (q >> 2) + 4 * hh;
                const float rr = rcpf_(1.0f + fexp(-(acc[0][mt][q] + gb0))), ii = rcpf_(1.0f + fexp(-(acc[1][mt][q] + gb1)));
                const float la = sp8 * rr, a = fexp(la), x2 = 2.0f * la;
                const float em_s = -x2 * (1.0f + x2 * (0.5f + x2 * (0.16666667f + x2 * (0.041666668f + x2 * 0.008333334f)))), em = x2 > -0.2f ? em_s : 1.0f - a * a;
                acc[0][mt][q] = a; acc[1][mt][q] = __builtin_amdgcn_sqrtf(em) * (ii * *(const LAS float*)(L + RG_XCF + (t * 128 + chl) * 4)); }
        float Ag[8], Ug[8];
#pragma unroll
        for (int mt = 0; mt < 2; ++mt)
#pragma unroll
            for (int G = 0; G < 4; ++G) { float pa = 1.f, hs = 0.f;
#pragma unroll
                for (int e0 = 0; e0 < 4; ++e0) { const int e = d == 0 ? e0 : 3 - e0; const float a = acc[0][mt][4 * G + e], u = acc[1][mt][4 * G + e]; hs = a * hs + u; pa *= a; }
                Ag[4 * mt + G] = pa; Ug[4 * mt + G] = hs; }
        float cin = 0.f;
        if (APPLY) cin = *(const LAS float*)(L + RG_CIN + ((k * 2 + d) * 128 + chl) * 4);
        float state = cin, ptot = 1.f, cown[8];
#pragma unroll
        for (int k0 = 0; k0 < 8; ++k0) { const int kk = d == 0 ? k0 : 7 - k0;
            const float pA = __shfl_xor(Ag[kk], 32), pU = __shfl_xor(Ug[kk], 32);
            const bool ownfirst = (d == 0) ? (hh == 0) : (hh == 1);
            const float A1 = ownfirst ? Ag[kk] : pA, U1 = ownfirst ? Ug[kk] : pU, A2 = ownfirst ? pA : Ag[kk], U2 = ownfirst ? pU : Ug[kk];
            const float s1 = A1 * state + U1; cown[kk] = ownfirst ? state : s1; state = A2 * s1 + U2; ptot *= A1 * A2; }
        if (!APPLY) { if (hh == 0) *(float2*)(AGG + ((size_t)(ti * 2 + d) * 1024 + ch) * 2) = make_float2(ptot, state); }
        else {
#pragma unroll
            for (int mt = 0; mt < 2; ++mt)
#pragma unroll
                for (int G = 0; G < 4; ++G) { float hs = cown[4 * mt + G];
#pragma unroll
                    for (int e0 = 0; e0 < 4; ++e0) { const int e = d == 0 ? e0 : 3 - e0; hs = acc[0][mt][4 * G + e] * hs + acc[1][mt][4 * G + e];
                        const int t = 32 * mt + 8 * G + 4 * hh + e; *(LAS float*)(L + RG_HB + ((d * 64 + t) * 128 + chl) * 4) = hs; } }
            if (!lat && hh == 0 && ((d == 0 && pos == nts - 1) || (d == 1 && pos == 0))) F.out[OUT_RG + ((ti >> 2) * 2 + d) * 1024 + ch] = state;
            __syncthreads();
#pragma unroll
            for (int it = 0; it < 2; ++it) { const int cidx = tid + it * 512, t = cidx >> 4, c8 = (cidx & 15) * 8;
                const v4u gw = *(const v4u*)(P2 + (size_t)(rowb + t) * ODD_IN + 1024 + hb * 128 + c8);
                const f32x4 f0 = *(const LAS f32x4*)(L + RG_HB + (t * 128 + c8) * 4), f1 = *(const LAS f32x4*)(L + RG_HB + (t * 128 + c8 + 4) * 4);
                const f32x4 b0 = *(const LAS f32x4*)(L + RG_HB + ((64 + t) * 128 + c8) * 4), b1 = *(const LAS f32x4*)(L + RG_HB + ((64 + t) * 128 + c8 + 4) * 4);
                v4u o; o.x = pk2((f0.x + b0.x) * siluf(bflo(gw.x)), (f0.y + b0.y) * siluf(bfhi(gw.x))); o.y = pk2((f0.z + b0.z) * siluf(bflo(gw.y)), (f0.w + b0.w) * siluf(bfhi(gw.y)));
                o.z = pk2((f1.x + b1.x) * siluf(bflo(gw.z)), (f1.y + b1.y) * siluf(bfhi(gw.z))); o.w = pk2((f1.z + b1.z) * siluf(bflo(gw.w)), (f1.w + b1.w) * siluf(bfhi(gw.w)));
                *(v4u*)((bf16*)(F.ws + WS_H) + (size_t)(rowb + t) * DM + hb * 128 + c8) = o; }
        }
        if (!APPLY) __syncthreads();
    }
    __syncthreads();
}

constexpr int CW_RGCNT = 32768;
__device__ __forceinline__ void rg_phase_single(Frame& F) {
    LAS unsigned char* L = (LAS unsigned char*)F.lds;
    const bf16* P2 = (const bf16*)(F.ws + WS_PROJ);
    unsigned long long* AGG = (unsigned long long*)(F.ws + WS_AGG);
    const int bx = blockIdx.x, hb = bx & 7, t0i = bx >> 3;
    if (F.G != 256) return;
    const int tid = F.tid, lane = F.lane, r = lane & 31, hh = lane >> 5, w = F.wave, d = w >> 2, jq = w & 3;
    const int chl = 32 * jq + r, ch = hb * 128 + chl;
    const float gb0 = F.in[21][(d * 2 + 0) * 1024 + ch], gb1 = F.in[21][(d * 2 + 1) * 1024 + ch];
    const float sp8 = -8.0f * log1pf(__expf(-F.in[22][d * 1024 + ch]));
    const int cc = tid & 127, tq = tid >> 7;
    const float cw0 = F.in[18][0 * 1024 + hb * 128 + cc], cw1 = F.in[18][1 * 1024 + hb * 128 + cc], cw2 = F.in[18][2 * 1024 + hb * 128 + cc], cw3 = F.in[18][3 * 1024 + hb * 128 + cc], cbv = F.in[19][hb * 128 + cc];
    for (int k = 0; k < 10; ++k) {
        const int ti = t0i + 32 * k; const int rowb = ti * 64;
        const bool lat = ti >= 64; const int pos = lat ? ((ti - 64) & 31) : (ti & 3), nts = lat ? 32 : 4, first = ti - pos, seq = lat ? 16 + ((ti - 64) >> 5) : (ti >> 2);
        bf16x8 Bw[2][8];
#pragma unroll
        for (int g = 0; g < 2; ++g)
#pragma unroll
            for (int st = 0; st < 8; ++st) Bw[g][st] = *(const bf16x8*)((const bf16*)(F.ws + WS_GW) + (size_t)((d * 2 + g) * 8 + hb) * 16384 + chl * 128 + 16 * st + 8 * hh);
        { const bf16* xp = P2 + (size_t)(rowb + 16 * tq) * ODD_IN + hb * 128 + cc;
          const bool lo_ok = !(pos == 0 && tq == 0), hi_ok = !(pos == nts - 1 && tq == 3);
          float xm2 = lo_ok ? bf2f(xp[-2 * ODD_IN]) : 0.f, xm1 = lo_ok ? bf2f(xp[-1 * ODD_IN]) : 0.f, x0 = bf2f(xp[0]);
#pragma unroll
          for (int t = 0; t < 16; ++t) { const float x1 = (t < 15 || hi_ok) ? bf2f(xp[(size_t)(t + 1) * ODD_IN]) : 0.f;
              const float xc = cbv + cw0 * xm2 + cw1 * xm1 + cw2 * x0 + cw3 * x1;
              *(LAS unsigned short*)(L + RG_XC + (16 * tq + t) * 272 + cc * 2) = (unsigned short)f2bf(xc);
              *(LAS float*)(L + RG_XCF + ((16 * tq + t) * 128 + cc) * 4) = xc;
              xm2 = xm1; xm1 = x0; x0 = x1; } }
        __syncthreads();
        f32x16 acc[2][2];
#pragma unroll
        for (int g = 0; g < 2; ++g)
#pragma unroll
            for (int mt = 0; mt < 2; ++mt)
#pragma unroll
                for (int q = 0; q < 16; ++q) acc[g][mt][q] = 0.f;
#pragma unroll
        for (int st = 0; st < 8; ++st)
#pragma unroll
            for (int mt = 0; mt < 2; ++mt) { const bf16x8 a = *(const LAS bf16x8*)(L + RG_XC + (32 * mt + r) * 272 + (16 * st + 8 * hh) * 2);
                acc[0][mt] = MFMA32(a, Bw[0][st], acc[0][mt]); acc[1][mt] = MFMA32(a, Bw[1][st], acc[1][mt]); }
#pragma unroll
        for (int mt = 0; mt < 2; ++mt)
#pragma unroll
            for (int q = 0; q < 16; ++q) { const int t = 32 * mt + (q & 3) + 8 * (q >> 2) + 4 * hh;
                const float rr = rcpf_(1.0f + fexp(-(acc[0][mt][q] + gb0))), ii = rcpf_(1.0f + fexp(-(acc[1][mt][q] + gb1)));
                const float la = sp8 * rr, a = fexp(la), x2 = 2.0f * la;
                const float em_s = -x2 * (1.0f + x2 * (0.5f + x2 * (0.16666667f + x2 * (0.041666668f + x2 * 0.008333334f)))), em = x2 > -0.2f ? em_s : 1.0f - a * a;
                acc[0][mt][q] = a; acc[1][mt][q] = __builtin_amdgcn_sqrtf(em) * (ii * *(const LAS float*)(L + RG_XCF + (t * 128 + chl) * 4)); }
        float Ag[8], Ug[8];
#pragma unroll
        for (int mt = 0; mt < 2; ++mt)
#pragma unroll
            for (int G = 0; G < 4; ++G) { float pa = 1.f, hs = 0.f;
#pragma unroll
                for (int e0 = 0; e0 < 4; ++e0) { const int e = d == 0 ? e0 : 3 - e0; const float a = acc[0][mt][4 * G + e], u = acc[1][mt][4 * G + e]; hs = a * hs + u; pa *= a; }
                Ag[4 * mt + G] = pa; Ug[4 * mt + G] = hs; }
        float pp = 1.f, ss = 0.f, Pk[8], Sk[8];
#pragma unroll
        for (int k0 = 0; k0 < 8; ++k0) { const int kk = d == 0 ? k0 : 7 - k0;
            const float pA = __shfl_xor(Ag[kk], 32), pU = __shfl_xor(Ug[kk], 32);
            const bool ownfirst = (d == 0) ? (hh == 0) : (hh == 1);
            const float A1 = ownfirst ? Ag[kk] : pA, U1 = ownfirst ? Ug[kk] : pU, A2 = ownfirst ? pA : Ag[kk], U2 = ownfirst ? pU : Ug[kk];
            const float pp1 = A1 * pp, ss1 = A1 * ss + U1;
            Pk[kk] = ownfirst ? pp : pp1; Sk[kk] = ownfirst ? ss : ss1;
            pp = A2 * pp1; ss = A2 * ss1 + U2; }
        if (hh == 0) __hip_atomic_store(AGG + (size_t)(ti * 2 + d) * 1024 + ch, ((unsigned long long)__float_as_uint(ss) << 32) | __float_as_uint(pp), __ATOMIC_RELAXED, __HIP_MEMORY_SCOPE_AGENT);
        asm volatile("s_waitcnt vmcnt(0)" ::: "memory");
        __syncthreads();
        unsigned* cntw = (unsigned*)(F.ctl + CW_RGCNT + (seq * 8 + hb) * 64);
        if (tid == 0) {
            __hip_atomic_fetch_add(cntw, 1u, __ATOMIC_RELAXED, __HIP_MEMORY_SCOPE_AGENT);
            unsigned sp = 0;
            while (__hip_atomic_load(cntw, __ATOMIC_RELAXED, __HIP_MEMORY_SCOPE_AGENT) < (unsigned)nts) { __builtin_amdgcn_s_sleep(2); if (++sp > (1u << 20)) break; }
        }
        __syncthreads();
        float cin = lat ? F.in[5][((seq - 16) * 2 + d) * 1024 + ch] : 0.f;
        { const int cnt = d == 0 ? pos : nts - 1 - pos;
#pragma unroll
          for (int bt = 0; bt < 2; ++bt) {
              if (16 * bt < cnt) {
                  unsigned long long v[16];
#pragma unroll
                  for (int j = 0; j < 16; ++j) { const int jj = 16 * bt + j; const bool ok = jj < cnt; const int tj = ok ? (d == 0 ? first + jj : first + nts - 1 - jj) : ti;
                      v[j] = __hip_atomic_load(AGG + (size_t)(tj * 2 + d) * 1024 + ch, __ATOMIC_RELAXED, __HIP_MEMORY_SCOPE_AGENT); }
#pragma unroll
                  for (int j = 0; j < 16; ++j) { const bool ok = 16 * bt + j < cnt; const float A = ok ? __uint_as_float((unsigned)v[j]) : 1.0f, U = ok ? __uint_as_float((unsigned)(v[j] >> 32)) : 0.0f; cin = A * cin + U; }
              } } }
#pragma unroll
        for (int mt = 0; mt < 2; ++mt)
#pragma unroll
            for (int G = 0; G < 4; ++G) { float hs = Pk[4 * mt + G] * cin + Sk[4 * mt + G];
#pragma unroll
                for (int e0 = 0; e0 < 4; ++e0) { const int e = d == 0 ? e0 : 3 - e0; hs = acc[0][mt][4 * G + e] * hs + acc[1][mt][4 * G + e];
                    const int t = 32 * mt + 8 * G + 4 * hh + e; *(LAS float*)(L + RG_HB + ((d * 64 + t) * 128 + chl) * 4) = hs; } }
        if (!lat && hh == 0 && ((d == 0 && pos == nts - 1) || (d == 1 && pos == 0))) F.out[OUT_RG + ((ti >> 2) * 2 + d) * 1024 + ch] = pp * cin + ss;
        __syncthreads();
#pragma unroll
        for (int it = 0; it < 2; ++it) { const int cidx = tid + it * 512, t = cidx >> 4, c8 = (cidx & 15) * 8;
            const v4u gw = *(const v4u*)(P2 + (size_t)(rowb + t) * ODD_IN + 1024 + hb * 128 + c8);
            const f32x4 f0 = *(const LAS f32x4*)(L + RG_HB + (t * 128 + c8) * 4), f1 = *(const LAS f32x4*)(L + RG_HB + (t * 128 + c8 + 4) * 4);
            const f32x4 b0 = *(const LAS f32x4*)(L + RG_HB + ((64 + t) * 128 + c8) * 4), b1 = *(const LAS f32x4*)(L + RG_HB + ((64 + t) * 128 + c8 + 4) * 4);
            v4u o; o.x = pk2((f0.x + b0.x) * siluf(bflo(gw.x)), (f0.y + b0.y) * siluf(bfhi(gw.x))); o.y = pk2((f0.z + b0.z) * siluf(bflo(gw.y)), (f0.w + b0.w) * siluf(bfhi(gw.y)));
            o.z = pk2((f1.x + b1.x) * siluf(bflo(gw.z)), (f1.y + b1.y) * siluf(bfhi(gw.z))); o.w = pk2((f1.z + b1.z) * siluf(bflo(gw.w)), (f1.w + b1.w) * siluf(bfhi(gw.w)));
            *(v4u*)((bf16*)(F.ws + WS_H) + (size_t)(rowb + t) * DM + hb * 128 + c8) = o; }
    }
    __syncthreads();
}
struct Args { const float* in[24]; float* out; unsigned char* ws; int ph_lo, ph_hi; };
__global__ void __launch_bounds__(NWAVES * 64, 2) mega_fwd(Args args) {
    extern __shared__ __attribute__((aligned(16))) unsigned char lds[];
    Frame F;
    F.lds = lds;
    F.MISC = (volatile LAS unsigned*)((LAS unsigned char*)lds + MISC_OFF);
    F.tid = threadIdx.x; F.lane = F.tid & 63; F.wave = __builtin_amdgcn_readfirstlane(F.tid >> 6);
    F.G = gridDim.x; { const int bx = blockIdx.x; F.vcu = (F.G % 8 == 0) ? (bx % 8) * (F.G / 8) + bx / 8 : bx; }
    F.ws = args.ws; F.out = args.out; F.ctl = (gu32*)(args.ws + WS_CTL);
#pragma unroll
    for (int i = 0; i < 24; ++i) F.in[i] = args.in[i];
    for (int u = F.tid; u < (LDS_BYTES - MISC_OFF) / 4; u += NWAVES * 64) ((LAS unsigned*)((LAS unsigned char*)lds + MISC_OFF))[u] = 0u;
    __syncthreads();
    const int lo = args.ph_lo, hi = args.ph_hi;
    const bool one = (lo == 0 && hi == NPHASE);
    XcdBarrier bar; bar.bar = (unsigned*)(F.ctl + CW_BAR); bar.x = 0; bar.st = nullptr;
    if (one) bar = xcd_barrier_post((unsigned*)(F.ctl + CW_BAR), F.MISC + 8);
#define IN(k) (lo <= (k) && (k) < hi)
#define QSLOT 0
#define GRID_BAR(k) do { if (IN(k) && IN((k) + 1)) xcd_barrier(bar); } while (0)
    LAS unsigned char* ring = (LAS unsigned char*)lds;

    if (IN(0)) { p0_prologue(F); GRID_BAR(0); }
    if (IN(1)) { modnorm_rows(F, 0, F.in[0], F.in[1]); GRID_BAR(1); }
    if (IN(2)) {
        pg8::Gemm g{(const bf16*)(F.ws + WS_H), (const bf16*)(F.ws + WS_WIE), M_ALL, EVEN_IN, DM}; pg8::StaticOrder S; S.init(M_ALL, EVEN_IN, F.G, (int)blockIdx.x);
        pg8::EpiProj E{(bf16*)(F.ws + WS_PROJ), EVEN_IN, F.out + OUT_K};
        pg8::gemm_phase<pg8::EpiProj, pg8::StaticOrder, true, true>(ring, g, S, E);
        GRID_BAR(2);
    }
    if (IN(3)) {
#define QUEUE_LOOP(slot, count, call) for (;;) { \
            if (F.tid == 0) F.MISC[16] = __hip_atomic_fetch_add((unsigned*)(F.ctl + CW_QUEUE + 64 * (slot) + 256 * QSLOT), 1u, __ATOMIC_RELAXED, __HIP_MEMORY_SCOPE_AGENT); \
            __syncthreads(); const int qi = (int)F.MISC[16]; __syncthreads(); \
            if (qi >= (count)) break; call; }
        QUEUE_LOOP(0, 192, hgrn_mfma_item(F, qi < 64 ? 128 + qi : qi - 64))
        QUEUE_LOOP(1, 1024, attn_mfma_item<true>(F, qi))
        QUEUE_LOOP(2, 256, attn_mfma_item<false>(F, qi))
#undef QUEUE_LOOP
        GRID_BAR(3);
    }
#if defined(PROBE_Y)
    for (int it = blockIdx.x; it < 1024; it += F.G) attn_mfma_item<true>(F, it, 1);
    xcd_barrier(bar);
#endif
#if defined(PROBE_Z)
    for (int it = blockIdx.x; it < 256; it += F.G) attn_mfma_item<false>(F, it, 1);
    xcd_barrier(bar);
#endif
    if (IN(4)) { gate_even_rows(F); GRID_BAR(4); }
    if (IN(5)) {
        pg8::Gemm g{(const bf16*)(F.ws + WS_H), (const bf16*)(F.ws + WS_WOE), M_ALL, DM, DM}; pg8::StaticOrder S; S.init(M_ALL, DM, F.G, (int)blockIdx.x);
        pg8::EpiRes E{F.in[0], F.in[1], F.out, (const float*)(F.ws + WS_MODS) + 2048};
        pg8::gemm_phase<pg8::EpiRes, pg8::StaticOrder, true, true>(ring, g, S, E);
        GRID_BAR(5);
    }
    if (IN(6)) { modnorm_rows(F, 1, F.out, F.out + (size_t)M_CTX * DM); GRID_BAR(6); }
    if (IN(7)) {
        pg8::Gemm g{(const bf16*)(F.ws + WS_H), (const bf16*)(F.ws + WS_WIO), M_ALL, ODD_IN, DM}; pg8::StaticOrder S; S.init(M_ALL, ODD_IN, F.G, (int)blockIdx.x);
        pg8::EpiProj E{(bf16*)(F.ws + WS_PROJ), ODD_IN, nullptr};
        pg8::gemm_phase<pg8::EpiProj, pg8::StaticOrder, true, true>(ring, g, S, E);
        GRID_BAR(7);
    }
    if (IN(8)) { rg_phase_single(F); GRID_BAR(8); }
    if (IN(9)) { }
    if (IN(10)) {
        pg8::Gemm g{(const bf16*)(F.ws + WS_H), (const bf16*)(F.ws + WS_WOO), M_ALL, DM, DM}; pg8::StaticOrder S; S.init(M_ALL, DM, F.G, (int)blockIdx.x);
        pg8::EpiRes E{F.out, F.out + (size_t)M_CTX * DM, F.out, (const float*)(F.ws + WS_MODS) + 9 * 3072 + 2048};
        pg8::gemm_phase<pg8::EpiRes, pg8::StaticOrder, true, true>(ring, g, S, E);
        GRID_BAR(10);
    }
    if (IN(11)) { final_norm_rows(F); }

#undef IN
#undef GRID_BAR
}

extern "C" void kernel_launch(void* const* d_in, const int* in_sizes, int n_in, void* d_out, int out_size, void* d_ws, size_t ws_size, hipStream_t stream) {
    static int grid = 0;
    if (grid == 0) {
        if (n_in != 24 || out_size != (int)OUT_TOTAL || ws_size < WS_END) { fprintf(stderr, "kernel_launch: unexpected shapes (n_in %d out %d ws %zu)\n", n_in, out_size, ws_size); grid = -1; return; }
        int dev = 0, cus = 0, per_cu = 0;
        if (hipGetDevice(&dev) != hipSuccess || hipDeviceGetAttribute(&cus, hipDeviceAttributeMultiprocessorCount, dev) != hipSuccess) { grid = -1; return; }
        if (hipFuncSetAttribute((const void*)mega_fwd, hipFuncAttributeMaxDynamicSharedMemorySize, LDS_BYTES) != hipSuccess) { fprintf(stderr, "kernel_launch: hipFuncSetAttribute failed\n"); grid = -1; return; }
        if (hipOccupancyMaxActiveBlocksPerMultiprocessor(&per_cu, (const void*)mega_fwd, NWAVES * 64, LDS_BYTES) != hipSuccess || per_cu < 1) { fprintf(stderr, "kernel_launch: occupancy query says %d\n", per_cu); }
        (void)hipGetLastError();
        grid = cus;
    }
    if (grid < 0) return;
    (void)hipMemsetAsync((char*)d_ws + WS_CTL, 0, CTL_ZERO_BYTES, stream);
    Args a{};
    for (int i = 0; i < 24; ++i) a.in[i] = (const float*)d_in[i];
    a.out = (float*)d_out; a.ws = (unsigned char*)d_ws;
#if defined(MK_PER_PHASE)
    for (int p = 0; p < NPHASE; ++p) { a.ph_lo = p; a.ph_hi = p + 1; hipLaunchKernelGGL(mega_fwd, dim3(grid), dim3(NWAVES * 64), LDS_BYTES, stream, a); }
#else
    a.ph_lo = 0; a.ph_hi = NPHASE;
    hipLaunchKernelGGL(mega_fwd, dim3(grid), dim3(NWAVES * 64), LDS_BYTES, stream, a);
#endif
}
```

```cpp
#include <hip/hip_runtime.h>
#include <cstdio>
#include <cstdint>
namespace pg8 {
#define PG8_LAS __attribute__((address_space(3)))
typedef unsigned short bf16_t;
typedef short bf16x8 __attribute__((ext_vector_type(8)));
typedef float f32x4 __attribute__((ext_vector_type(4)));
typedef unsigned u32x4 __attribute__((ext_vector_type(4)));
constexpr int BM = 256, BK = 64, HALF = 128, HTB = HALF * BK * 2  , STAGE_BYTES = 8 * HTB, NXCD = 8, WGM = 8;

__host__ __device__ __forceinline__ int lds_byte(int r, int c) { const int st = (r >> 4) * 2 + (c >> 5), rr = r & 15, cc = c & 31, ob = rr * 64 + cc * 2; return st * 1024 + (ob ^ (((ob >> 9) & 1) << 5)); }
__host__ __device__ __forceinline__ void stage_rc(int b, int& R, int& C) { const int st = b / 1024, sb = b % 1024, swz = sb ^ (((sb >> 9) & 1) << 5); R = (st >> 1) * 16 + swz / 64; C = (st & 1) * 32 + (swz % 64) / 2; }
__host__ __device__ __forceinline__ int perm32(int rho) { const int n = rho >> 4, i = rho & 15; return 8 * (i >> 2) + 4 * n + (i & 3); }

struct Unit { int pm, pn; };
struct Gemm { const bf16_t* A; const bf16_t* Bt; int M, N, K; };

struct StaticOrder {
    int nM, nN, nwg, G, c;
    __host__ __device__ void init(int M, int N, int G_, int c_) { nM = M / BM; nN = N / BM; nwg = nM * nN; G = G_; c = c_; }
    __host__ __device__ bool next(int i, Unit& u) const {
        const long L = (long)i * G + c; if (L >= nwg) return false;
        int wgid = (int)L; { const int q = nwg / NXCD, r = nwg % NXCD, xcd = wgid % NXCD, off = wgid / NXCD; wgid = (xcd < r ? xcd * (q + 1) : r * (q + 1) + (xcd - r) * q) + off; }
        const int nig = WGM * nN, gid = wgid / nig, fm = gid * WGM, gsz = (nM - fm) < WGM ? (nM - fm) : WGM;
        u.pm = fm + ((wgid % nig) % gsz); u.pn = (wgid % nig) / gsz; return true;
    }
    __device__ __forceinline__ void a_ready(const Unit&) const {}
    __device__ __forceinline__ void done(const Unit&) const {}
};

__device__ __forceinline__ unsigned cvt_pk_bf16(float lo, float hi) { unsigned r; asm volatile("v_cvt_pk_bf16_f32 %0, %1, %2" : "=v"(r) : "v"(lo), "v"(hi)); return r; }
typedef float f32x2 __attribute__((ext_vector_type(2)));
struct EpiProj {
    static constexpr bool PERM = true, AFTER_DRAIN = false;
    bf16_t* O; int ldc; float* kv;
    __device__ __forceinline__ void operator()(const f32x4 (&acc)[2][2][4][2], const Unit& u, int wr, int wc, int fr, int fq) const {
        const int row0 = u.pm * BM + wr * 64 + fr; const int col0 = u.pn * BM + wc * 32 + 8 * fq;
        const bool dokv = (kv != nullptr) && u.pm < 16 && u.pn >= 12 && u.pn < 16;
#pragma unroll
        for (int ai = 0; ai < 2; ++ai)
#pragma unroll
            for (int m = 0; m < 4; ++m) { bf16_t* rowp = O + (size_t)(row0 + ai * HALF + m * 16) * ldc + col0;
#pragma unroll
                for (int bj = 0; bj < 2; ++bj) { const f32x4 v0 = acc[ai][bj][m][0], v1 = acc[ai][bj][m][1];
                    u32x4 w; w.x = cvt_pk_bf16(v0[0], v0[1]); w.y = cvt_pk_bf16(v0[2], v0[3]); w.z = cvt_pk_bf16(v1[0], v1[1]); w.w = cvt_pk_bf16(v1[2], v1[3]);
                    *(u32x4*)(rowp + bj * HALF) = w;
                    if (dokv) { const int cc = col0 + bj * HALF - 3072, which = cc >> 9, c2 = cc & 511, head = c2 >> 6, d = c2 & 63, t = wr * 64 + fr + ai * HALF + m * 16;
                        float* p = kv + (size_t)which * 2097152 + ((size_t)(u.pm * 8 + head) * 256 + t) * 64 + d; *(f32x4*)p = v0; *(f32x4*)(p + 4) = v1; } } }
    }
};
struct EpiRes {
    static constexpr bool PERM = false, AFTER_DRAIN = false;
    const float* base0; const float* base1; float* out; const float* gate;
    __device__ __forceinline__ void operator()(const f32x4 (&acc)[2][2][4][2], const Unit& u, int wr, int wc, int fr, int fq) const {
        const int nidx = u.pm < 16 ? 0 : 1 + ((u.pm - 16) >> 3);
        const float* gp = gate + (size_t)nidx * 3072;
        const int col0 = u.pn * BM + wc * 32 + 4 * fq;
        f32x4 gv[2][2];
#pragma unroll
        for (int bj = 0; bj < 2; ++bj)
#pragma unroll
            for (int n = 0; n < 2; ++n) gv[bj][n] = *(const f32x4*)(gp + col0 + bj * HALF + n * 16);
#pragma unroll
        for (int ai = 0; ai < 2; ++ai)
#pragma unroll
            for (int m = 0; m < 4; ++m) { const int row = u.pm * BM + ai * HALF + wr * 64 + m * 16 + fr;
                const float* bp = (row < 4096 ? base0 + (size_t)row * 1024 : base1 + (size_t)(row - 4096) * 1024) + col0;
                float* op = out + (size_t)row * 1024 + col0;
#pragma unroll
                for (int bj = 0; bj < 2; ++bj)
#pragma unroll
                    for (int n = 0; n < 2; ++n) { const f32x4 b = *(const f32x4*)(bp + bj * HALF + n * 16); *(f32x4*)(op + bj * HALF + n * 16) = b + gv[bj][n] * acc[ai][bj][m][n]; } }
    }
};
template <class Epi, class Sched, bool ALIGN_EPI = false, bool SP2 = false>
__device__ __forceinline__ void gemm_phase(PG8_LAS unsigned char* lds, const Gemm g, const Sched& S, const Epi& E) {
    const int tid = threadIdx.x, wid = __builtin_amdgcn_readfirstlane(tid >> 6), lane = tid & 63, wr = wid >> 2, wc = wid & 3, fr = lane & 15, fq = lane >> 4;
    const int K = g.K, nt = K / BK;
    unsigned voffA[2], voffB[2];
#pragma unroll
    for (int i = 0; i < 2; ++i) { int R, C; stage_rc(tid * 16 + i * 8192, R, C); const int Rb = Epi::PERM ? ((R & ~31) + perm32(R & 31)) : R;
        voffA[i] = (unsigned)(R * K + C) * 2u; voffB[i] = (unsigned)(Rb * K + C) * 2u; }
    const size_t kstep = (size_t)(BK * 2);
    const size_t hstep = (size_t)HALF * K * 2;
    const size_t tstep = 2 * hstep;
    const unsigned ldsw = (unsigned)wid * 1024u;
    const int aoff = lds_byte(wr * 64 + fr, fq * 8), boff = lds_byte(wc * 32 + fr, fq * 8);
#define PG8_SA(b, h) (((b) * 2 + (h)) * HTB)
#define PG8_SB(b, h) ((4 + (b) * 2 + (h)) * HTB)
#define PG8_STAGE(bufoff, gbase, voff) do { _Pragma("unroll") for (int _i = 0; _i < 2; ++_i) \
        __builtin_amdgcn_global_load_lds((const unsigned*)((const char*)(gbase) + (voff)[_i]), (PG8_LAS unsigned*)(lds + (bufoff) + ldsw + _i * 8192), 16, 0, 0); } while (0)
#define PG8_LDA(dst, b, h) do { _Pragma("unroll") for (int m = 0; m < 4; ++m) _Pragma("unroll") for (int k = 0; k < 2; ++k) dst[m][k] = *(const PG8_LAS bf16x8*)(lds + PG8_SA(b, h) + aoff + m * 2048 + k * 1024); } while (0)
#define PG8_LDB(dst, b, h) do { _Pragma("unroll") for (int n = 0; n < 2; ++n) _Pragma("unroll") for (int k = 0; k < 2; ++k) dst[n][k] = *(const PG8_LAS bf16x8*)(lds + PG8_SB(b, h) + boff + n * 2048 + k * 1024); } while (0)
#define PG8_MMA(ai, bj, At, Bt) do { __builtin_amdgcn_s_setprio(1); _Pragma("unroll") for (int m = 0; m < 4; ++m) _Pragma("unroll") for (int n = 0; n < 2; ++n) _Pragma("unroll") for (int k = 0; k < 2; ++k) \
        acc[ai][bj][m][n] = __builtin_amdgcn_mfma_f32_16x16x32_bf16(Bt[n][k], At[m][k], acc[ai][bj][m][n], 0, 0, 0); __builtin_amdgcn_s_setprio(0); } while (0)
#define PG8_WAIT_V(n) asm volatile("s_waitcnt vmcnt(" #n ")" ::: "memory")
#define PG8_WAIT_L(n) asm volatile("s_waitcnt lgkmcnt(" #n ")" ::: "memory")
#define PG8_BAR __builtin_amdgcn_s_barrier()
#define PG8_SCHED __builtin_amdgcn_sched_barrier(0)
    Unit cur, nxt; int ui = 0;
    if (!S.next(0, cur)) return;
    f32x4 acc[2][2][4][2];
#pragma unroll
    for (int a = 0; a < 2; ++a)
#pragma unroll
        for (int b = 0; b < 2; ++b)
#pragma unroll
            for (int m = 0; m < 4; ++m)
#pragma unroll
                for (int n = 0; n < 2; ++n) acc[a][b][m][n] = (f32x4){0.f, 0.f, 0.f, 0.f};
    bf16x8 At[4][2], B0[2][2], B1[2][2];
    const char* cA = (const char*)g.A + (size_t)cur.pm * tstep; const char* cB = (const char*)g.Bt + (size_t)cur.pn * tstep;
    S.a_ready(cur);
    if constexpr (SP2) {
        PG8_STAGE(PG8_SB(0, 0), cB, voffB); PG8_STAGE(PG8_SB(0, 1), cB + hstep, voffB); PG8_STAGE(PG8_SA(0, 0), cA, voffA); PG8_STAGE(PG8_SA(0, 1), cA + hstep, voffA);
        if (wr == 1) PG8_BAR;
        PG8_WAIT_V(2); PG8_BAR;
        PG8_STAGE(PG8_SB(1, 0), cB + kstep, voffB); PG8_STAGE(PG8_SA(1, 0), cA + kstep, voffA); PG8_STAGE(PG8_SB(1, 1), cB + hstep + kstep, voffB);
        PG8_WAIT_V(6); PG8_BAR;
    } else {
        PG8_STAGE(PG8_SB(0, 0), cB, voffB); PG8_STAGE(PG8_SA(0, 0), cA, voffA); PG8_STAGE(PG8_SB(0, 1), cB + hstep, voffB); PG8_STAGE(PG8_SA(0, 1), cA + hstep, voffA);
        if (wr == 1) PG8_BAR;
        PG8_WAIT_V(4); PG8_BAR;
        PG8_STAGE(PG8_SB(1, 0), cB + kstep, voffB); PG8_STAGE(PG8_SA(1, 0), cA + kstep, voffA); PG8_STAGE(PG8_SB(1, 1), cB + hstep + kstep, voffB);
        PG8_WAIT_V(6); PG8_BAR;
    }
    for (;;) {
        const bool has_next = S.next(ui + 1, nxt);
        const char* nA = has_next ? (const char*)g.A + (size_t)nxt.pm * tstep : cA; const char* nB = has_next ? (const char*)g.Bt + (size_t)nxt.pn * tstep : cB;
        for (int t = 0; t < nt; t += 2) {
            const bool last = (t == nt - 2);
            const char* a1 = cA + (size_t)(t + 1) * kstep;
            const char* a2 = last ? nA : cA + (size_t)(t + 2) * kstep; const char* b2 = last ? nB : cB + (size_t)(t + 2) * kstep;
            const char* a3 = a2 + kstep; const char* b3 = b2 + kstep;
            if (last && has_next) S.a_ready(nxt);
            if constexpr (SP2) {
            PG8_LDB(B0, 0, 0); PG8_LDB(B1, 0, 1); PG8_SCHED; PG8_LDA(At, 0, 0); PG8_STAGE(PG8_SA(1, 1), a1 + hstep, voffA);
            PG8_WAIT_V(8); PG8_WAIT_L(0); PG8_BAR; PG8_MMA(0, 0, At, B0); PG8_MMA(0, 1, At, B1); PG8_BAR; PG8_SCHED;
            PG8_LDA(At, 0, 1); PG8_STAGE(PG8_SB(0, 0), b2, voffB); PG8_STAGE(PG8_SB(0, 1), b2 + hstep, voffB); PG8_STAGE(PG8_SA(0, 0), a2, voffA);
            PG8_WAIT_V(8); PG8_WAIT_L(0); PG8_BAR; PG8_MMA(1, 0, At, B0); PG8_MMA(1, 1, At, B1); PG8_BAR; PG8_SCHED;
            PG8_LDB(B0, 1, 0); PG8_LDB(B1, 1, 1); PG8_SCHED; PG8_LDA(At, 1, 0); PG8_STAGE(PG8_SA(0, 1), a2 + hstep, voffA);
            PG8_WAIT_V(8); PG8_WAIT_L(0); PG8_BAR; PG8_MMA(0, 0, At, B0); PG8_MMA(0, 1, At, B1); PG8_BAR; PG8_SCHED;
            PG8_LDA(At, 1, 1); PG8_STAGE(PG8_SB(1, 0), b3, voffB); PG8_STAGE(PG8_SB(1, 1), b3 + hstep, voffB); PG8_STAGE(PG8_SA(1, 0), a3, voffA);
            PG8_WAIT_V(8); PG8_WAIT_L(0); PG8_BAR; PG8_MMA(1, 0, At, B0); PG8_MMA(1, 1, At, B1); PG8_BAR; PG8_SCHED;
            } else {
            PG8_LDB(B0, 0, 0); PG8_SCHED; PG8_LDA(At, 0, 0); PG8_STAGE(PG8_SA(1, 1), a1 + hstep, voffA);
            PG8_WAIT_L(8); PG8_BAR; PG8_WAIT_L(0); PG8_MMA(0, 0, At, B0); PG8_BAR; PG8_SCHED;
            PG8_LDB(B1, 0, 1); PG8_STAGE(PG8_SB(0, 0), b2, voffB);
            PG8_BAR; PG8_WAIT_L(0); PG8_MMA(0, 1, At, B1); PG8_BAR;
            PG8_LDA(At, 0, 1); PG8_STAGE(PG8_SA(0, 0), a2, voffA);
            PG8_BAR; PG8_WAIT_L(0); PG8_MMA(1, 0, At, B0); PG8_BAR; PG8_SCHED;
            PG8_STAGE(PG8_SB(0, 1), b2 + hstep, voffB);
            PG8_WAIT_V(6); PG8_BAR; PG8_MMA(1, 1, At, B1); PG8_BAR;
            PG8_LDB(B0, 1, 0); PG8_SCHED; PG8_LDA(At, 1, 0); PG8_STAGE(PG8_SA(0, 1), a2 + hstep, voffA);
            PG8_WAIT_L(8); PG8_BAR; PG8_WAIT_L(0); PG8_MMA(0, 0, At, B0); PG8_BAR; PG8_SCHED;
            PG8_LDB(B1, 1, 1); PG8_STAGE(PG8_SB(1, 0), b3, voffB);
            PG8_BAR; PG8_WAIT_L(0); PG8_MMA(0, 1, At, B1); PG8_BAR;
            PG8_LDA(At, 1, 1); PG8_STAGE(PG8_SA(1, 0), a3, voffA);
            PG8_BAR; PG8_WAIT_L(0); PG8_MMA(1, 0, At, B0); PG8_BAR; PG8_SCHED;
            PG8_STAGE(PG8_SB(1, 1), b3 + hstep, voffB);
            PG8_WAIT_V(6); PG8_BAR; PG8_MMA(1, 1, At, B1); PG8_BAR;
            }
        }
        if constexpr (ALIGN_EPI) { if (wr == 0) PG8_BAR; }
        if constexpr (!Epi::AFTER_DRAIN) { E(acc, cur, wr, wc, fr, fq); S.done(cur); }
        if (!has_next) break;
#pragma unroll
        for (int a = 0; a < 2; ++a)
#pragma unroll
            for (int b = 0; b < 2; ++b)
#pragma unroll
                for (int m = 0; m < 4; ++m)
#pragma unroll
                    for (int n = 0; n < 2; ++n) acc[a][b][m][n] = (f32x4){0.f, 0.f, 0.f, 0.f};
        cur = nxt; cA = nA; cB = nB; ++ui;
        if constexpr (ALIGN_EPI) { if (wr == 1) PG8_BAR; }
    }
    PG8_WAIT_V(0);
    if constexpr (!ALIGN_EPI) { if (wr == 0) PG8_BAR; }
    PG8_BAR;
    if constexpr (Epi::AFTER_DRAIN) { E.fused(acc, cur, wr, wc, fr, fq, lds, wid, lane); S.done(cur); }
#undef PG8_SA
#undef PG8_SB
#undef PG8_STAGE
#undef PG8_LDA
#undef PG8_LDB
#undef PG8_MMA
#undef PG8_WAIT_V
#undef PG8_WAIT_L
#undef PG8_BAR
#undef PG8_SCHED
}
}
constexpr int NWAVES = 8;
constexpr int DM = 1024, M_CTX = 4096, M_LAT = 16384, M_ALL = 20480, EVEN_IN = 4608, ODD_IN = 2048;
constexpr size_t MiB = 1u << 20;
constexpr size_t WS_CTL = 0, CTL_ZERO_BYTES = 1 * MiB;
constexpr size_t WS_MODS = 1 * MiB;
constexpr size_t WS_WIE = 2 * MiB, WS_WOE = 11 * MiB, WS_WIO = 13 * MiB, WS_WOO = 17 * MiB, WS_GW = 19 * MiB;
constexpr size_t WS_AGG = 20 * MiB;
constexpr size_t WS_H = 26 * MiB;
constexpr size_t WS_PROJ = 66 * MiB;
constexpr size_t WS_KCB = 246 * MiB, WS_VCB = 248 * MiB;
constexpr size_t WS_END = 250 * MiB;
constexpr size_t OUT_Y = 0, OUT_HG = 20971520, OUT_K = 23068672, OUT_V = 25165824, OUT_RG = 27262976, OUT_TOTAL = 27295744;
constexpr int CW_TMO = 0, CW_CODE = 1, CW_BAR = 4096, CW_QUEUE = 16384;
constexpr int RING_BYTES = 131072;
constexpr int LDS_BYTES = 162816, MISC_OFF = LDS_BYTES - 512;
constexpr int NPHASE = 12;

#define GAS __attribute__((address_space(1)))
#define LAS __attribute__((address_space(3)))
typedef unsigned short bf16;
typedef unsigned v4u __attribute__((ext_vector_type(4)));
typedef unsigned v2u __attribute__((ext_vector_type(2)));
typedef float f32x4 __attribute__((ext_vector_type(4)));
typedef float f32x16 __attribute__((ext_vector_type(16)));
typedef short bf16x8 __attribute__((ext_vector_type(8)));
typedef short s16x4 __attribute__((ext_vector_type(4)));
typedef GAS unsigned gu32;
#define RLX_AGENT __ATOMIC_RELAXED, __HIP_MEMORY_SCOPE_AGENT
#define LDS_WAIT() asm volatile("s_waitcnt lgkmcnt(0)" ::: "memory")
#define VM_WAIT() asm volatile("s_waitcnt vmcnt(0)" ::: "memory")
__device__ __forceinline__ unsigned f2bf(float f) { unsigned u = __builtin_bit_cast(unsigned, f); return (u + 0x7fffu + ((u >> 16) & 1u)) >> 16; }
__device__ __forceinline__ unsigned pk2(float lo, float hi) { return f2bf(lo) | (f2bf(hi) << 16); }
__device__ __forceinline__ float bf2f(unsigned b) { return __builtin_bit_cast(float, b << 16); }
__device__ __forceinline__ float bflo(unsigned w) { return __builtin_bit_cast(float, w << 16); }
__device__ __forceinline__ float bfhi(unsigned w) { return __builtin_bit_cast(float, w & 0xffff0000u); }
__device__ __forceinline__ float fexp(float x) { return __builtin_amdgcn_exp2f(x * 1.4426950408889634f); }
__device__ __forceinline__ float flog(float x) { return __builtin_amdgcn_logf(x) * 0.6931471805599453f; }
__device__ __forceinline__ float rcpf_(float x) { return __builtin_amdgcn_rcpf(x); }
__device__ __forceinline__ float sigmoidf(float x) { return rcpf_(1.0f + fexp(-x)); }
__device__ __forceinline__ float siluf(float x) { return x * rcpf_(1.0f + fexp(-x)); }
#define XB_TMO      128
#define XB_XCNT(j)  (256  + 64 * (j))
#define XB_XSUB(j)  (1280 + 64 * (j))
#define XB_XGEN(j)  (2304 + 64 * (j))
#define XB_TOP      3328
#define XB_TOPGEN   3392
#define XCD_BAR_WORDS 3456
#define XB_SPIN_CAP (1u << 18)

__device__ __forceinline__ unsigned xb_ld(unsigned* p)              { return __hip_atomic_load(p, __ATOMIC_RELAXED, __HIP_MEMORY_SCOPE_AGENT); }
__device__ __forceinline__ unsigned xb_add(unsigned* p, unsigned v) { return __hip_atomic_fetch_add(p, v, __ATOMIC_RELAXED, __HIP_MEMORY_SCOPE_AGENT); }
__device__ __forceinline__ unsigned xb_xcc_id() { return (unsigned)__builtin_amdgcn_s_getreg((3 << 11) | 20) & 0xFu; }
#define XB_SPIN(cond, bar) do { unsigned _sp = 0; while (cond) { __builtin_amdgcn_s_sleep(1); \
    if ((++_sp & 255u) == 0u) { if (xb_ld(&(bar)[XB_TMO])) break; if (_sp > XB_SPIN_CAP) { atomicAdd(&(bar)[XB_TMO], 1u); break; } } } } while (0)

struct XcdBarrier {
    unsigned* bar; unsigned x;
    volatile LAS unsigned* st;
};

__device__ __forceinline__ XcdBarrier xcd_barrier_post(unsigned* bar, volatile LAS unsigned* st) {
    XcdBarrier b; b.bar = bar; b.x = xb_xcc_id(); b.st = st;
    if (threadIdx.x == 0) (void)xb_add(&bar[XB_XCNT(b.x)], 1u);
    return b;
}
__device__ __forceinline__ void xcd_barrier_complete(unsigned* bar, unsigned x, unsigned& nloc, unsigned& nx) {
    const unsigned G = gridDim.x * gridDim.y * gridDim.z;
    unsigned sum, cnt, mine, sp = 0u;
    for (;;) {
        sum = 0u; cnt = 0u; mine = 0u;
#pragma unroll
        for (unsigned j = 0; j < 16; ++j) { const unsigned c = xb_ld(&bar[XB_XCNT(j)]); sum += c; cnt += (c > 0u) ? 1u : 0u; mine = (j == x) ? c : mine; }
        if (sum == G) break;
        __builtin_amdgcn_s_sleep(1);
        if ((++sp & 255u) == 0u) { if (xb_ld(&bar[XB_TMO])) break; if (sp > XB_SPIN_CAP) { atomicAdd(&bar[XB_TMO], 1u); break; } }
    }
    nloc = mine > 0u ? mine : 1u; nx = cnt > 0u ? cnt : 1u;
}

__device__ __forceinline__ void xcd_barrier(const XcdBarrier& b) {
    asm volatile("s_waitcnt vmcnt(0)" ::: "memory");
    __syncthreads();
    if (threadIdx.x == 0) {
        unsigned* bar = b.bar;
        __builtin_amdgcn_s_waitcnt(0);
        unsigned nloc = b.st[0], nx = b.st[1];
        if (nloc == 0u) { xcd_barrier_complete(bar, b.x, nloc, nx); b.st[0] = nloc; b.st[1] = nx; }
        const unsigned old = xb_add(&bar[XB_XSUB(b.x)], 1u);
        const unsigned gen = old / nloc;
        if (old + 1u == (gen + 1u) * nloc) {
            __builtin_amdgcn_fence(__ATOMIC_RELEASE, "agent");
            asm volatile("s_waitcnt vmcnt(0)" ::: "memory");
            const unsigned og = xb_add(&bar[XB_TOP], 1u);
            const unsigned tg = og / nx;
            if (og + 1u == (tg + 1u) * nx) xb_add(&bar[XB_TOPGEN], 1u);
            else XB_SPIN(xb_ld(&bar[XB_TOPGEN]) == tg, bar);
            __builtin_amdgcn_fence(__ATOMIC_ACQUIRE, "agent");
            xb_add(&bar[XB_XGEN(b.x)], 1u);
            asm volatile("s_waitcnt vmcnt(0)" ::: "memory");
        } else {
            XB_SPIN(xb_ld(&bar[XB_XGEN(b.x)]) == gen, bar);
            __builtin_amdgcn_fence(__ATOMIC_ACQUIRE, "agent");
            asm volatile("s_waitcnt vmcnt(0)" ::: "memory");
        }
    }
    __syncthreads();
}
struct Frame {
    unsigned char* lds;
    volatile LAS unsigned* MISC;
    gu32* ctl;
    int tid, lane, wave, vcu, G;
    const float* in[24];
    float* out; unsigned char* ws;
};
__device__ __forceinline__ float wave_sum(float v) {
#pragma unroll
    for (int o = 1; o < 64; o <<= 1) v += __shfl_xor(v, o);
    return v;
}
__device__ __forceinline__ void p0_transpose_item(const float* W, int K, int N, bf16* WT, float* scr, int item, int lane) {
    const int nblk = N / 32, kb = item / nblk, nb = item % nblk, k0 = 64 * kb, n0 = 32 * nb;
#pragma unroll 8
    for (int i = 0; i < 32; ++i) { const int kk = 2 * i + (lane >> 5); scr[kk * 33 + (lane & 31)] = W[(size_t)(k0 + kk) * N + n0 + (lane & 31)]; }
    LDS_WAIT(); asm volatile("" ::: "memory");
    const int c = lane & 7;
#pragma unroll
    for (int j = 0; j < 4; ++j) { const int n = (lane >> 3) + 8 * j; const float* s = scr + (8 * c) * 33 + n;
        v4u o; o.x = pk2(s[0 * 33], s[1 * 33]); o.y = pk2(s[2 * 33], s[3 * 33]); o.z = pk2(s[4 * 33], s[5 * 33]); o.w = pk2(s[6 * 33], s[7 * 33]);
        *(v4u*)(WT + (size_t)(n0 + n) * K + k0 + 8 * c) = o; }
    LDS_WAIT(); asm volatile("" ::: "memory");
}
__device__ __forceinline__ void p0_prologue(Frame& F) {
    float* mods = (float*)(F.ws + WS_MODS);
    for (int it = blockIdx.x; it < 96; it += F.G) {
        const int l = it / 48, c0 = (it % 48) * 64;
        float* S = (float*)F.lds;
        for (int idx = F.tid; idx < 9216; idx += NWAVES * 64) { const int n = idx >> 10, k = idx & 1023; const float v = n == 0 ? F.in[7][k] : F.in[6][(n - 1) * 1024 + k]; S[idx] = siluf(v); }
        __syncthreads();
        const float* W = F.in[9] + (size_t)l * 1024 * 3072 + c0 + F.lane;
        float acc[9];
#pragma unroll
        for (int n = 0; n < 9; ++n) acc[n] = 0.f;
        const int k0 = F.wave * 128;
#pragma unroll 4
        for (int kk = 0; kk < 128; ++kk) { const float wv = W[(size_t)(k0 + kk) * 3072];
#pragma unroll
            for (int n = 0; n < 9; ++n) acc[n] += S[n * 1024 + k0 + kk] * wv; }
        float* red = S + 9216;
#pragma unroll
        for (int n = 0; n < 9; ++n) red[(F.wave * 9 + n) * 64 + F.lane] = acc[n];
        __syncthreads();
        for (int idx = F.tid; idx < 576; idx += NWAVES * 64) { const int n = idx >> 6, ln = idx & 63; float s = F.in[10][l * 3072 + c0 + ln];
#pragma unroll
            for (int w = 0; w < 8; ++w) s += red[(w * 9 + n) * 64 + ln];
            mods[(size_t)(l * 9 + n) * 3072 + c0 + ln] = s; }
        __syncthreads();
    }
    for (int c = F.vcu * NWAVES * 64 + F.tid; c < 2 * 131072; c += F.G * NWAVES * 64) { const int which = c >> 17, o = (c & 131071) * 8;
        const float* src = (which ? F.in[4] : F.in[3]) + o; const f32x4 a0 = *(const f32x4*)src, a1 = *(const f32x4*)(src + 4);
        *(v4u*)((bf16*)(F.ws + (which ? WS_VCB : WS_KCB)) + o) = (v4u){pk2(a0.x, a0.y), pk2(a0.z, a0.w), pk2(a1.x, a1.y), pk2(a1.z, a1.w)}; }
    float* scr = (float*)(F.lds + F.wave * 16384);
    const int gw = F.vcu * NWAVES + F.wave, NGW = F.G * NWAVES;
    constexpr int I0 = 16 * 144, I1 = 16 * 32, I2 = 16 * 64, I3 = 16 * 32;
    for (int it = gw; it < I0 + I1 + I2 + I3; it += NGW) {
        int r = it;
        if (r < I0) { p0_transpose_item(F.in[11], 1024, 4608, (bf16*)(F.ws + WS_WIE), scr, r, F.lane); continue; } r -= I0;
        if (r < I1) { p0_transpose_item(F.in[12], 1024, 1024, (bf16*)(F.ws + WS_WOE), scr, r, F.lane); continue; } r -= I1;
        if (r < I2) { p0_transpose_item(F.in[16], 1024, 2048, (bf16*)(F.ws + WS_WIO), scr, r, F.lane); continue; } r -= I2;
        p0_transpose_item(F.in[17], 1024, 1024, (bf16*)(F.ws + WS_WOO), scr, r, F.lane);
    }
    for (int idx = F.vcu * NWAVES * 64 + F.tid; idx < 32 * 2048; idx += F.G * NWAVES * 64) { const int mat = idx >> 11, rem = idx & 2047, jq = rem >> 9, st = (rem >> 6) & 7, ln = rem & 63;
        const float* src = F.in[20] + (size_t)mat * 16384 + (16 * st + 8 * (ln >> 5)) * 128 + 32 * jq + (ln & 31);
        *(v4u*)((bf16*)(F.ws + WS_GW) + (size_t)mat * 16384 + rem * 8) = (v4u){pk2(src[0], src[128]), pk2(src[256], src[384]), pk2(src[512], src[640]), pk2(src[768], src[896])}; }
}
__device__ __forceinline__ void modnorm_rows(Frame& F, int layer, const float* xa, const float* xb) {
    const float* mods = (const float*)(F.ws + WS_MODS) + (size_t)layer * 9 * 3072;
    const float* gain = F.in[8] + layer * 1024;
    bf16* H = (bf16*)(F.ws + WS_H);
    const int gw = F.vcu * NWAVES + F.wave, NGW = F.G * NWAVES;
    for (int m = gw; m < M_ALL; m += NGW) {
        const int n = m < M_CTX ? 0 : 1 + ((m - M_CTX) >> 11);
        const f32x4* xr = (const f32x4*)(m < M_CTX ? xa + (size_t)m * DM : xb + (size_t)(m - M_CTX) * DM) + F.lane;
        const f32x4* sh = (const f32x4*)(mods + (size_t)n * 3072) + F.lane; const f32x4* sc = (const f32x4*)(mods + (size_t)n * 3072 + 1024) + F.lane;
        const f32x4* gp = (const f32x4*)gain + F.lane;
        f32x4 v[4]; float s = 0.f;
#pragma unroll
        for (int j = 0; j < 4; ++j) { v[j] = xr[64 * j]; s += (v[j].x * v[j].x + v[j].y * v[j].y) + (v[j].z * v[j].z + v[j].w * v[j].w); }
        const float rstd = 1.0f / sqrtf(wave_sum(s) * (1.0f / DM) + 1e-6f);
        unsigned long long* o8 = (unsigned long long*)(H + (size_t)m * DM) + F.lane;
#pragma unroll
        for (int j = 0; j < 4; ++j) { const f32x4 g = gp[64 * j], a = sc[64 * j], b = sh[64 * j]; const f32x4 o = v[j] * rstd * g * (1.0f + a) + b;
            o8[64 * j] = (unsigned long long)pk2(o.x, o.y) | ((unsigned long long)pk2(o.z, o.w) << 32); }
    }
}
__device__ __forceinline__ void hgrn_naive_item(Frame& F, int item) {
    const int s = item >> 3, h = (item >> 1) & 3, d = item & 1;
    const bool lat = s >= 16; const int T = lat ? 2048 : 256; const int row0 = lat ? M_CTX + (s - 16) * 2048 : s * 256;
    bf16* P = (bf16*)(F.ws + WS_PROJ);
    float* Lq = (float*)F.lds; float* Lf = Lq + 128; float* Lk = Lf + 128; float* Lv = Lk + 128; float* Lp = Lv + 128;
    const int tid = F.tid, dv = tid & 127, kq = tid >> 7;
    const int zcol = (d == 0 ? 512 : 1024) + h * 128;
    float S[32];
    if (lat) { const float* s0 = F.in[2] + ((size_t)(((s - 16) * 2 + d) * 4 + h)) * 16384;
#pragma unroll
        for (int i = 0; i < 32; ++i) S[i] = s0[(32 * kq + i) * 128 + dv]; }
    else {
#pragma unroll
        for (int i = 0; i < 32; ++i) S[i] = 0.f; }
    float lbv = 0.f;
    if (tid < 128) { const float l0 = F.in[13][(d * 2 + 0) * 512 + h * 128 + tid], l1 = F.in[13][(d * 2 + 1) * 512 + h * 128 + tid]; lbv = 1.0f / (1.0f + __expf(l1 - l0)); }
    __syncthreads();
    for (int tt = 0; tt < T; ++tt) {
        const int tok = d == 0 ? tt : T - 1 - tt; const size_t rb = (size_t)(row0 + tok) * EVEN_IN;
        if (tid < 128) { const float z = bf2f(P[rb + zcol + tid]); const float sg = sigmoidf(z);
            Lf[tid] = lbv + (1.0f - lbv) * sg; Lk[tid] = (1.0f - lbv) * (1.0f - sg); Lq[tid] = bf2f(P[rb + h * 128 + tid]); }
        else if (tid < 256) Lv[tid - 128] = bf2f(P[rb + 1536 + h * 128 + (tid - 128)]);
        __syncthreads();
        const float v = Lv[dv]; float part = 0.f;
#pragma unroll
        for (int i = 0; i < 32; ++i) { const int dk = 32 * kq + i; S[i] = Lf[dk] * S[i] + Lk[dk] * v; part += S[i] * Lq[dk]; }
        Lp[kq * 128 + dv] = part;
        __syncthreads();
        if (tid < 128) { const float o = (Lp[tid] + Lp[128 + tid]) + (Lp[256 + tid] + Lp[384 + tid]); P[rb + zcol + tid] = (bf16)f2bf(o); }
    }
    if (!lat) { float* so = F.out + OUT_HG + ((size_t)((s * 2 + d) * 4 + h)) * 16384;
#pragma unroll
        for (int i = 0; i < 32; ++i) so[(32 * kq + i) * 128 + dv] = S[i]; }
    __syncthreads();
}
__device__ __forceinline__ float dot64_bf(const float* qs, const bf16* kp) {
    float dot = 0.f;
    for (int e = 0; e < 8; ++e) { const v4u w = ((const v4u*)kp)[e]; const float* q = qs + 8 * e;
        dot += (q[0] * bflo(w.x) + q[1] * bfhi(w.x)) + (q[2] * bflo(w.y) + q[3] * bfhi(w.y)) + (q[4] * bflo(w.z) + q[5] * bfhi(w.z)) + (q[6] * bflo(w.w) + q[7] * bfhi(w.w)); }
    return dot;
}
__device__ __forceinline__ void attn_naive_item(Frame& F, int it) {
    const int m = it >> 3, head = it & 7, lane = F.lane;
    bf16* P = (bf16*)(F.ws + WS_PROJ);
    float* qs = (float*)(F.lds + F.wave * 2048); float* ps = qs + 64;
    qs[lane] = bf2f(P[(size_t)m * EVEN_IN + 2560 + head * 64 + lane]);
    LDS_WAIT(); asm volatile("" ::: "memory");
    float sc[6]; int nk;
    const bool lat = m >= M_CTX;
    int b = 0, r = 0, c = 0, rs = 0, wsx = 0;
    if (lat) { b = (m - M_CTX) >> 11; const int t = (m - M_CTX) & 2047; r = t >> 6; c = t & 63; rs = min(max(r - 4, 0), 24); wsx = min(max(c - 8, 0), 48); nk = 6; } else { b = m >> 8; nk = 4; }
#pragma unroll
    for (int i = 0; i < 6; ++i) {
        sc[i] = -1e30f;
        if (i < nk) {
            const int j = lane + 64 * i; float dot = 0.f, bias = 0.f;
            if (lat && i < 2) { const int kr = j >> 4, kc = j & 15; const int tk = (rs + kr) * 64 + wsx + kc;
                dot = dot64_bf(qs, P + (size_t)(M_CTX + b * 2048 + tk) * EVEN_IN + 3072 + head * 64);
                bias = F.in[15][(head * 15 + (rs + kr - r + 7)) * 31 + (wsx + kc - c + 15)]; }
            else if (lat) { const float* kp = F.in[3] + ((size_t)(b * 8 + head) * 256 + (j - 128)) * 64;
                for (int e = 0; e < 16; ++e) { const f32x4 kv = ((const f32x4*)kp)[e]; dot += (qs[4 * e] * kv.x + qs[4 * e + 1] * kv.y) + (qs[4 * e + 2] * kv.z + qs[4 * e + 3] * kv.w); } }
            else dot = dot64_bf(qs, P + (size_t)(b * 256 + j) * EVEN_IN + 3072 + head * 64);
            sc[i] = dot * 0.125f + bias;
        }
    }
    float mx = sc[0];
#pragma unroll
    for (int i = 1; i < 6; ++i) mx = fmaxf(mx, sc[i]);
#pragma unroll
    for (int o = 1; o < 64; o <<= 1) mx = fmaxf(mx, __shfl_xor(mx, o));
    float sum = 0.f;
#pragma unroll
    for (int i = 0; i < 6; ++i) { sc[i] = (i < nk) ? __expf(sc[i] - mx) : 0.f; sum += sc[i]; }
    sum = wave_sum(sum); const float inv = 1.0f / sum;
#pragma unroll
    for (int i = 0; i < 6; ++i) if (i < nk) ps[lane + 64 * i] = sc[i] * inv;
    LDS_WAIT(); asm volatile("" ::: "memory");
    float o = 0.f;
    if (lat) {
        for (int j = 0; j < 128; ++j) { const int kr = j >> 4, kc = j & 15; const int tk = (rs + kr) * 64 + wsx + kc;
            o += ps[j] * bf2f(P[(size_t)(M_CTX + b * 2048 + tk) * EVEN_IN + 3584 + head * 64 + lane]); }
        const float* vp = F.in[4] + ((size_t)(b * 8 + head) * 256) * 64 + lane;
        for (int j = 0; j < 256; ++j) o += ps[128 + j] * vp[(size_t)j * 64];
    } else {
        for (int j = 0; j < 256; ++j) o += ps[j] * bf2f(P[(size_t)(b * 256 + j) * EVEN_IN + 3584 + head * 64 + lane]);
    }
    P[(size_t)m * EVEN_IN + 2560 + head * 64 + lane] = (bf16)f2bf(o);
    LDS_WAIT(); asm volatile("" ::: "memory");
}
constexpr size_t WS_RGF = WS_PROJ + 80 * MiB, WS_RGB = WS_PROJ + 120 * MiB;
__device__ __forceinline__ void rg_naive_item(Frame& F, int item) {
    const int s = item >> 4, hb = (item >> 1) & 7, d = item & 1;
    const bool lat = s >= 16; const int T = lat ? 2048 : 256; const int row0 = lat ? M_CTX + (s - 16) * 2048 : s * 256;
    const bf16* P2 = (const bf16*)(F.ws + WS_PROJ);
    bf16* O = (bf16*)(F.ws + (d == 0 ? WS_RGF : WS_RGB));
    float* XB = (float*)F.lds; float* XC = XB + 19 * 128; float* GG = XC + 16 * 128;
    const int tid = F.tid;
    float hst = 0.f, sp = 0.f;
    if (tid < 128) { if (lat) hst = F.in[5][((s - 16) * 2 + d) * 1024 + hb * 128 + tid]; const float lam = F.in[22][d * 1024 + hb * 128 + tid]; sp = log1pf(__expf(-lam)); }
    for (int k = 0; k < T / 16; ++k) {
        const int tb = d == 0 ? 16 * k : T - 16 * (k + 1);
        for (int idx = tid; idx < 19 * 128; idx += NWAVES * 64) { const int hr = idx >> 7, ch = idx & 127, tok = tb + hr - 2;
            XB[idx] = (tok >= 0 && tok < T) ? bf2f(P2[(size_t)(row0 + tok) * ODD_IN + hb * 128 + ch]) : 0.f; }
        __syncthreads();
        for (int idx = tid; idx < 16 * 128; idx += NWAVES * 64) { const int t = idx >> 7, ch = idx & 127; float a = F.in[19][hb * 128 + ch];
#pragma unroll
            for (int j = 0; j < 4; ++j) a += F.in[18][j * 1024 + hb * 128 + ch] * XB[(t + j) * 128 + ch];
            XC[idx] = a; }
        __syncthreads();
        { const int g = tid >> 8, th = (tid >> 7) & 1, j = tid & 127;
          const float* w = F.in[20] + ((size_t)((d * 2 + g) * 8 + hb) * 128) * 128 + j;
          float acc[8];
#pragma unroll
          for (int t = 0; t < 8; ++t) acc[t] = 0.f;
          for (int i = 0; i < 128; ++i) { const float wv = w[(size_t)i * 128];
#pragma unroll
              for (int t = 0; t < 8; ++t) acc[t] += XC[(th * 8 + t) * 128 + i] * wv; }
          const float gb = F.in[21][(d * 2 + g) * 1024 + hb * 128 + j];
#pragma unroll
          for (int t = 0; t < 8; ++t) GG[(g * 16 + th * 8 + t) * 128 + j] = sigmoidf(acc[t] + gb); }
        __syncthreads();
        if (tid < 128) {
            for (int tt = 0; tt < 16; ++tt) { const int t = d == 0 ? tt : 15 - tt;
                const float rr = GG[t * 128 + tid], ii = GG[(16 + t) * 128 + tid];
                const float la = -8.0f * rr * sp; const float a = __expf(la); const float u = sqrtf(-expm1f(2.0f * la)) * (ii * XC[t * 128 + tid]);
                hst = a * hst + u;
                O[(size_t)(row0 + tb + t) * DM + hb * 128 + tid] = (bf16)f2bf(hst); } }
        __syncthreads();
    }
    if (!lat && tid < 128) F.out[OUT_RG + (s * 2 + d) * 1024 + hb * 128 + tid] = hst;
}
__device__ __forceinline__ void gate_even_rows(Frame& F) {
    const bf16* P = (const bf16*)(F.ws + WS_PROJ); bf16* Y = (bf16*)(F.ws + WS_H);
    const int gw = F.vcu * NWAVES + F.wave, NGW = F.G * NWAVES, lane = F.lane;
    const f32x4 g0 = ((const f32x4*)F.in[14])[lane * 2], g1 = ((const f32x4*)F.in[14])[lane * 2 + 1];
    const float gain[8] = {g0.x, g0.y, g0.z, g0.w, g1.x, g1.y, g1.z, g1.w};
    for (int m = gw; m < M_ALL; m += NGW) {
        const bf16* pr = P + (size_t)m * EVEN_IN + lane * 8;
        const v4u wf = *(const v4u*)(pr + 512), wb = *(const v4u*)(pr + 1024), wga = *(const v4u*)(pr + 2048), wo = *(const v4u*)(pr + 2560), wgb = *(const v4u*)(pr + 4096);
        float o[8], ga[8], ob[8], gb[8];
#pragma unroll
        for (int e = 0; e < 4; ++e) { o[2 * e] = bflo(wf[e]) + bflo(wb[e]); o[2 * e + 1] = bfhi(wf[e]) + bfhi(wb[e]); ga[2 * e] = bflo(wga[e]); ga[2 * e + 1] = bfhi(wga[e]);
            ob[2 * e] = bflo(wo[e]); ob[2 * e + 1] = bfhi(wo[e]); gb[2 * e] = bflo(wgb[e]); gb[2 * e + 1] = bfhi(wgb[e]); }
        float ss = 0.f;
#pragma unroll
        for (int e = 0; e < 8; ++e) ss += o[e] * o[e];
        ss += __shfl_xor(ss, 1); ss += __shfl_xor(ss, 2); ss += __shfl_xor(ss, 4); ss += __shfl_xor(ss, 8);
        const float rstd = 1.0f / sqrtf(ss * (1.0f / 128.0f) + 1e-6f);
        float ya[8], yb[8];
#pragma unroll
        for (int e = 0; e < 8; ++e) { ya[e] = o[e] * rstd * gain[e] * siluf(ga[e]); yb[e] = ob[e] * siluf(gb[e]); }
        v4u wa, wbo;
#pragma unroll
        for (int e = 0; e < 4; ++e) { wa[e] = pk2(ya[2 * e], ya[2 * e + 1]); wbo[e] = pk2(yb[2 * e], yb[2 * e + 1]); }
        bf16* yr = Y + (size_t)m * DM + lane * 8;
        *(v4u*)yr = wa; *(v4u*)(yr + 512) = wbo;
    }
}
__device__ __forceinline__ void rg_combine_rows(Frame& F) {
    const bf16* P2 = (const bf16*)(F.ws + WS_PROJ); const bf16* OF = (const bf16*)(F.ws + WS_RGF); const bf16* OB = (const bf16*)(F.ws + WS_RGB); bf16* Y = (bf16*)(F.ws + WS_H);
    const int gw = F.vcu * NWAVES + F.wave, NGW = F.G * NWAVES, lane = F.lane;
    for (int m = gw; m < M_ALL; m += NGW) {
#pragma unroll
        for (int part = 0; part < 2; ++part) { const int c0 = part * 512 + lane * 8;
            const v4u a = *(const v4u*)(OF + (size_t)m * DM + c0), b = *(const v4u*)(OB + (size_t)m * DM + c0), g = *(const v4u*)(P2 + (size_t)m * ODD_IN + 1024 + c0);
            v4u w;
#pragma unroll
            for (int e = 0; e < 4; ++e) w[e] = pk2((bflo(a[e]) + bflo(b[e])) * siluf(bflo(g[e])), (bfhi(a[e]) + bfhi(b[e])) * siluf(bfhi(g[e])));
            *(v4u*)(Y + (size_t)m * DM + c0) = w; }
    }
}
__device__ __forceinline__ void final_norm_rows(Frame& F) {
    const int gw = F.vcu * NWAVES + F.wave, NGW = F.G * NWAVES;
    const f32x4* gp = (const f32x4*)F.in[23] + F.lane;
    for (int m = gw; m < M_ALL; m += NGW) {
        f32x4* xr = (f32x4*)(F.out + (size_t)m * DM) + F.lane;
        f32x4 v[4]; float s = 0.f;
#pragma unroll
        for (int j = 0; j < 4; ++j) { v[j] = xr[64 * j]; s += (v[j].x * v[j].x + v[j].y * v[j].y) + (v[j].z * v[j].z + v[j].w * v[j].w); }
        const float rstd = 1.0f / sqrtf(wave_sum(s) * (1.0f / DM) + 1e-6f);
#pragma unroll
        for (int j = 0; j < 4; ++j) xr[64 * j] = v[j] * rstd * gp[64 * j];
    }
}
typedef float f32x2_t __attribute__((ext_vector_type(2))); typedef __bf16 bf16x2_t __attribute__((ext_vector_type(2)));
__device__ __forceinline__ unsigned cvtpk(float lo, float hi) { f32x2_t v = {lo, hi}; bf16x2_t b = __builtin_convertvector(v, bf16x2_t); return __builtin_bit_cast(unsigned, b); }
#define MFMA32(a, b, c) __builtin_amdgcn_mfma_f32_32x32x16_bf16((a), (b), (c), 0, 0, 0)
template <int ST> __device__ __forceinline__ bf16x8 pack8(const f32x16& x) {
    v4u p; p.x = cvtpk(x[8 * ST], x[8 * ST + 1]); p.y = cvtpk(x[8 * ST + 2], x[8 * ST + 3]); p.z = cvtpk(x[8 * ST + 4], x[8 * ST + 5]); p.w = cvtpk(x[8 * ST + 6], x[8 * ST + 7]);
    return __builtin_bit_cast(bf16x8, p);
}
__device__ __forceinline__ bf16x8 cat4(s16x4 lo, s16x4 hi) { return __builtin_shufflevector(lo, hi, 0, 1, 2, 3, 4, 5, 6, 7); }
constexpr int HG_QD = 0, HG_KI = 8704, HG_KDT = 17408, HG_VT = 27648, HG_DEC = 37888, HG_BUF = 38400, HG_RAW = 76800;
__device__ __forceinline__ void hgrn_mfma_item(Frame& F, int item) {
    const int s = item >> 3, h = (item >> 1) & 3, d = item & 1;
    const bool lat = s >= 16; const int T = lat ? 2048 : 256; const int row0 = lat ? M_CTX + (s - 16) * 2048 : s * 256; const int nch = T / 32;
    bf16* P = (bf16*)(F.ws + WS_PROJ);
    LAS unsigned char* L = (LAS unsigned char*)F.lds;
    const int zcol = (d == 0 ? 512 : 1024) + h * 128;
    const int lane = F.lane, r = lane & 31, hh = lane >> 5;
    if (F.wave >= 4) {
        const int pw = F.wave - 4, dk = 32 * pw + r;
        const float l0 = F.in[13][(d * 2 + 0) * 512 + h * 128 + dk], l1 = F.in[13][(d * 2 + 1) * 512 + h * 128 + dk];
        const float lbv = 1.0f / (1.0f + __expf(l1 - l0)), omlb = 1.0f - lbv;
        const int pt = F.tid - 256;
        v4u az[2], aq[2], av[2], bz[2], bq[2], bv[2];
#define HG_ISSUE(Z, Q, V, n) do { _Pragma("unroll") for (int j = 0; j < 2; ++j) { const int piece = pt + 256 * j, i = piece >> 4, oct = piece & 15; const int tok = d == 0 ? 32 * (n) + i : T - 1 - (32 * (n) + i); \
            const bf16* pr = P + (size_t)(row0 + tok) * EVEN_IN + oct * 8; Z[j] = *(const v4u*)(pr + zcol); Q[j] = *(const v4u*)(pr + h * 128); V[j] = *(const v4u*)(pr + 1536 + h * 128); } } while (0)
#define HG_WRITE(Z, Q, V, n) do { LAS unsigned char* RB = L + HG_RAW + ((n) & 1) * 24576; _Pragma("unroll") for (int j = 0; j < 2; ++j) { const int piece = pt + 256 * j; \
            *(LAS v4u*)(RB + piece * 16) = Z[j]; *(LAS v4u*)(RB + 8192 + piece * 16) = Q[j]; *(LAS v4u*)(RB + 16384 + piece * 16) = V[j]; } } while (0)
#define HG_PREP(n) do { LAS unsigned char* B = L + ((n) & 1) * HG_BUF; const LAS unsigned char* RB = L + HG_RAW + ((n) & 1) * 24576 + dk * 2; \
            float lf[16], kk[16]; float tot = 0.f; \
            _Pragma("unroll") for (int ii = 0; ii < 16; ++ii) { const float z = bf2f(*(const LAS unsigned short*)(RB + (16 * hh + ii) * 256)); const float sg = rcpf_(1.0f + fexp(-z)); const float f = lbv + omlb * sg; lf[ii] = flog(f); kk[ii] = omlb * (1.0f - sg); tot += lf[ii]; } \
            const float other = __shfl_xor(tot, 32); const float bend = tot + other, ebend = fexp(bend); float b = hh ? other : 0.f; \
            unsigned kd[8], vv[8]; \
            _Pragma("unroll") for (int ii = 0; ii < 16; ++ii) { b += lf[ii]; const int i = 16 * hh + ii; const float eb = fexp(b), ki = kk[ii] * rcpf_(eb); \
                const float qd = bf2f(*(const LAS unsigned short*)(RB + 8192 + i * 256)) * eb, kdv = ki * ebend; const unsigned vraw = *(const LAS unsigned short*)(RB + 16384 + i * 256); \
                *(LAS unsigned short*)(B + HG_QD + i * 272 + dk * 2) = (unsigned short)f2bf(qd); \
                *(LAS unsigned short*)(B + HG_KI + i * 272 + dk * 2) = (unsigned short)f2bf(ki); \
                if (ii & 1) { kd[ii >> 1] |= f2bf(kdv) << 16; vv[ii >> 1] |= vraw << 16; } else { kd[ii >> 1] = f2bf(kdv); vv[ii >> 1] = vraw; } } \
            *(LAS v4u*)(B + HG_KDT + dk * 80 + hh * 32) = (v4u){kd[0], kd[1], kd[2], kd[3]}; *(LAS v4u*)(B + HG_KDT + dk * 80 + hh * 32 + 16) = (v4u){kd[4], kd[5], kd[6], kd[7]}; \
            *(LAS v4u*)(B + HG_VT + dk * 80 + hh * 32) = (v4u){vv[0], vv[1], vv[2], vv[3]}; *(LAS v4u*)(B + HG_VT + dk * 80 + hh * 32 + 16) = (v4u){vv[4], vv[5], vv[6], vv[7]}; \
            if (hh == 0) *(LAS float*)(B + HG_DEC + dk * 4) = ebend; } while (0)
        HG_ISSUE(az, aq, av, 0); HG_ISSUE(bz, bq, bv, 1);
        HG_WRITE(az, aq, av, 0); HG_ISSUE(az, aq, av, 2);
        __syncthreads();
        for (int n = 0; n < nch; n += 2) {
            HG_WRITE(bz, bq, bv, n + 1); if (n + 3 < nch) HG_ISSUE(bz, bq, bv, n + 3);
            HG_PREP(n);
            __syncthreads();
            if (n + 2 < nch) { HG_WRITE(az, aq, av, n + 2); if (n + 4 < nch) HG_ISSUE(az, aq, av, n + 4); }
            HG_PREP(n + 1);
            __syncthreads();
        }
        __syncthreads();
#undef HG_ISSUE
#undef HG_WRITE
#undef HG_PREP
    } else {
        const int w = F.wave, dvc = 32 * w + r; const long osgn = d == 0 ? 1 : -1;
        f32x16 S[4];
        if (lat) { const float* s0 = F.in[2] + ((size_t)(((s - 16) * 2 + d) * 4 + h)) * 16384;
#pragma unroll
            for (int i = 0; i < 4; ++i)
#pragma unroll
                for (int g = 0; g < 16; ++g) S[i][g] = s0[(32 * i + (g & 3) + 8 * (g >> 2) + 4 * hh) * 128 + dvc]; }
        else {
#pragma unroll
            for (int i = 0; i < 4; ++i)
#pragma unroll
                for (int g = 0; g < 16; ++g) S[i][g] = 0.f; }
        __syncthreads();
        __syncthreads();
        for (int n = 0; n < nch; ++n) {
            LAS unsigned char* B = L + (n & 1) * HG_BUF;
#define HG_FENCE() asm volatile("" ::: "memory")
            bf16x8 ka[8], qb[8];
#pragma unroll
            for (int st = 0; st < 8; ++st) { ka[st] = *(const LAS bf16x8*)(B + HG_KI + r * 272 + (16 * st + 8 * hh) * 2); qb[st] = *(const LAS bf16x8*)(B + HG_QD + r * 272 + (16 * st + 8 * hh) * 2); }
            HG_FENCE();
            f32x16 X;
#pragma unroll
            for (int g = 0; g < 16; ++g) X[g] = 0.f;
#pragma unroll
            for (int st = 0; st < 8; ++st) X = MFMA32(ka[st], qb[st], X);
            s16x4 ql[8], qh[8], vl[2], vh[2];
#pragma unroll
            for (int j = 0; j < 8; ++j) { const LAS unsigned char* qd = B + HG_QD + r * 272 + 32 * j + 8 * hh; ql[j] = *(const LAS s16x4*)(qd); qh[j] = *(const LAS s16x4*)(qd + 16); }
            { const LAS unsigned char* vt = B + HG_VT + dvc * 80 + 8 * hh;
              vl[0] = *(const LAS s16x4*)(vt); vh[0] = *(const LAS s16x4*)(vt + 16); vl[1] = *(const LAS s16x4*)(vt + 32); vh[1] = *(const LAS s16x4*)(vt + 48); }
            bf16x8 kd[8], vb[2];
#pragma unroll
            for (int i = 0; i < 4; ++i)
#pragma unroll
                for (int st = 0; st < 2; ++st) kd[2 * i + st] = *(const LAS bf16x8*)(B + HG_KDT + (32 * i + r) * 80 + (16 * st + 8 * hh) * 2);
#pragma unroll
            for (int st = 0; st < 2; ++st) vb[st] = *(const LAS bf16x8*)(B + HG_VT + dvc * 80 + (16 * st + 8 * hh) * 2);
            HG_FENCE();
#pragma unroll
            for (int g = 0; g < 16; ++g) { const int sr = (g & 3) + 8 * (g >> 2) + 4 * hh; X[g] = sr <= r ? X[g] : 0.f; }
            const bf16x8 xa0 = pack8<0>(X), xa1 = pack8<1>(X);
            f32x16 O;
#pragma unroll
            for (int g = 0; g < 16; ++g) O[g] = 0.f;
#pragma unroll
            for (int i = 0; i < 4; ++i) { O = MFMA32(cat4(ql[2 * i], qh[2 * i]), pack8<0>(S[i]), O); O = MFMA32(cat4(ql[2 * i + 1], qh[2 * i + 1]), pack8<1>(S[i]), O); }
            O = MFMA32(xa0, cat4(vl[0], vh[0]), O);
            O = MFMA32(xa1, cat4(vl[1], vh[1]), O);
            HG_FENCE();
            f32x4 dc[16];
#pragma unroll
            for (int i = 0; i < 4; ++i)
#pragma unroll
                for (int G = 0; G < 4; ++G) dc[4 * i + G] = *(const LAS f32x4*)(B + HG_DEC + (32 * i + 8 * G + 4 * hh) * 4);
            HG_FENCE();
#pragma unroll
            for (int i = 0; i < 4; ++i) {
#pragma unroll
                for (int g = 0; g < 16; ++g) S[i][g] *= dc[4 * i + (g >> 2)][g & 3];
                S[i] = MFMA32(kd[2 * i], vb[0], S[i]); S[i] = MFMA32(kd[2 * i + 1], vb[1], S[i]); }
            { bf16* ob = P + (size_t)(row0 + (d == 0 ? 32 * n + 4 * hh : T - 1 - 32 * n - 4 * hh)) * EVEN_IN + zcol + dvc;
#pragma unroll
              for (int g = 0; g < 16; ++g) ob[osgn * (long)(((g & 3) + 8 * (g >> 2)) * EVEN_IN)] = (bf16)f2bf(O[g]); }
#undef HG_FENCE
            __syncthreads();
        }
        if (!lat) { float* so = F.out + OUT_HG + ((size_t)((s * 2 + d) * 4 + h)) * 16384;
#pragma unroll
            for (int i = 0; i < 4; ++i)
#pragma unroll
                for (int g = 0; g < 16; ++g) so[(32 * i + (g & 3) + 8 * (g >> 2) + 4 * hh) * 128 + dvc] = S[i][g]; }
    }
}
#define MFMA16(a, b, c) __builtin_amdgcn_mfma_f32_16x16x32_bf16((a), (b), (c), 0, 0, 0)
typedef short v4i16_t __attribute__((ext_vector_type(4)));
__device__ __forceinline__ s16x4 vtr(const LAS unsigned char* p) { return __builtin_bit_cast(s16x4, __builtin_amdgcn_ds_read_tr16_b64_v4i16((LAS v4i16_t*)p)); }
__device__ __forceinline__ bf16x8 pack44(const f32x4& a, const f32x4& b) { v4u p; p.x = cvtpk(a[0], a[1]); p.y = cvtpk(a[2], a[3]); p.z = cvtpk(b[0], b[1]); p.w = cvtpk(b[2], b[3]); return __builtin_bit_cast(bf16x8, p); }
constexpr int AT_VL = 0, AT_KC = 73728, AT_VC = AT_KC + 36864, AT_BT = AT_VC + 32768, AT_END = AT_BT + 2048;
static_assert(AT_END <= MISC_OFF, "attention LDS map");
template <bool LOCAL> __device__ __forceinline__ void attn_mfma_item(Frame& F, int item) {
    LAS unsigned char* L = (LAS unsigned char*)F.lds;
    bf16* P = (bf16*)(F.ws + WS_PROJ);
    const int tid = F.tid, lane = F.lane, fr = lane & 15, fq = lane >> 4, w = F.wave;
    int b, head, half = 0, rp_lo = 0, rp_hi = 1;
    if (LOCAL) { b = item / 24; head = (item / 3) & 7; const int third = item % 3; rp_lo = third == 0 ? 0 : (third == 1 ? 6 : 11); rp_hi = third == 0 ? 6 : (third == 1 ? 11 : 16); }
    else { b = item >> 4; head = (item >> 1) & 7; half = item & 1; }
    int have_hi = 0;
    if (LOCAL) {
        const int rs0 = min(max(2 * rp_lo - 4, 0), 24), nrows = min(9, 32 - rs0); have_hi = rs0 + nrows;
        for (int c = tid; c < nrows * 512; c += NWAVES * 64) { const int g = rs0 + (c >> 9), key = (c >> 3) & 63, ch = c & 7;
            *(LAS v4u*)(L + AT_VL + (g % 9) * 8192 + key * 128 + ch * 16) = *(const v4u*)(P + (size_t)(M_CTX + b * 2048 + g * 64 + key) * EVEN_IN + 3584 + head * 64 + ch * 8); }
        const bf16* kc = (const bf16*)(F.ws + WS_KCB) + (size_t)(b * 8 + head) * 16384; const bf16* vc = (const bf16*)(F.ws + WS_VCB) + (size_t)(b * 8 + head) * 16384;
        for (int c = tid; c < 2048; c += NWAVES * 64) { const int key = c >> 3, ch = c & 7;
            *(LAS v4u*)(L + AT_KC + key * 144 + ch * 16) = *(const v4u*)(kc + key * 64 + ch * 8); *(LAS v4u*)(L + AT_VC + key * 128 + ch * 16) = *(const v4u*)(vc + key * 64 + ch * 8); }
        for (int i = tid; i < 465; i += NWAVES * 64) ((LAS float*)(L + AT_BT))[i] = F.in[15][head * 465 + i];
    } else {
        for (int c = tid; c < 2048; c += NWAVES * 64) { const int key = c >> 3, ch = c & 7; const bf16* pr = P + (size_t)(b * 256 + key) * EVEN_IN + head * 64 + ch * 8;
            *(LAS v4u*)(L + AT_KC + key * 144 + ch * 16) = *(const v4u*)(pr + 3072); *(LAS v4u*)(L + AT_VC + key * 128 + ch * 16) = *(const v4u*)(pr + 3584); }
    }
    const int ri = w >> 2, jb = w & 3;
    const unsigned lane_off = (unsigned)(fr * EVEN_IN + 8 * fq), lane_oo = (unsigned)(4 * fq * EVEN_IN + fr);
  for (int rp = rp_lo; rp < rp_hi; ++rp) {
    const int r = 2 * rp + ri;
    const int qbase = LOCAL ? M_CTX + b * 2048 + r * 64 + 16 * jb : b * 256 + half * 128 + 16 * w;
    const bf16* qp = P + (size_t)qbase * EVEN_IN + 2560 + head * 64 + lane_off;
    const bf16x8 qf0 = *(const bf16x8*)qp, qf1 = *(const bf16x8*)(qp + 32);
    v4u pf0 = {0u, 0u, 0u, 0u}, pf1 = {0u, 0u, 0u, 0u}; int nnew = 0;
    if (LOCAL && rp + 1 < rp_hi) { const int rs0n = min(max(2 * (rp + 1) - 4, 0), 24), need_hi = rs0n + min(9, 32 - rs0n); nnew = need_hi - have_hi;
        if (nnew > 0) pf0 = *(const v4u*)(P + (size_t)(M_CTX + b * 2048 + have_hi * 64 + (tid >> 3)) * EVEN_IN + 3584 + head * 64 + (tid & 7) * 8);
        if (nnew > 1) pf1 = *(const v4u*)(P + (size_t)(M_CTX + b * 2048 + (have_hi + 1) * 64 + (tid >> 3)) * EVEN_IN + 3584 + head * 64 + (tid & 7) * 8); }
    __syncthreads();
    const int trow = fr >> 2, tcol = (fr & 3) * 8;
    f32x4 O1[4];
#pragma unroll
    for (int dt = 0; dt < 4; ++dt) O1[dt] = (f32x4){0.f, 0.f, 0.f, 0.f};
    float mx1 = -1e30f, l1 = 0.f;
    {
        f32x4 sc[16];
#pragma unroll
        for (int kt = 0; kt < 16; ++kt) { const LAS unsigned char* kp = L + AT_KC + (16 * kt + fr) * 144 + 16 * fq;
            f32x4 acc = {0.f, 0.f, 0.f, 0.f}; acc = MFMA16(*(const LAS bf16x8*)kp, qf0, acc); acc = MFMA16(*(const LAS bf16x8*)(kp + 64), qf1, acc);
            acc = acc * 0.125f; sc[kt] = acc; mx1 = fmaxf(fmaxf(mx1, fmaxf(acc[0], acc[1])), fmaxf(acc[2], acc[3])); }
        mx1 = fmaxf(mx1, __shfl_xor(mx1, 16)); mx1 = fmaxf(mx1, __shfl_xor(mx1, 32));
#pragma unroll
        for (int kt = 0; kt < 16; ++kt)
#pragma unroll
            for (int e = 0; e < 4; ++e) { const float p = fexp(sc[kt][e] - mx1); sc[kt][e] = p; l1 += p; }
        l1 += __shfl_xor(l1, 16); l1 += __shfl_xor(l1, 32);
#pragma unroll
        for (int c = 0; c < 8; ++c) { const bf16x8 pa = pack44(sc[2 * c], sc[2 * c + 1]);
            const LAS unsigned char* v0 = L + AT_VC + (32 * c + 4 * fq + trow) * 128 + tcol;
#pragma unroll
            for (int dt = 0; dt < 4; ++dt) O1[dt] = MFMA16(pa, cat4(vtr(v0 + dt * 32), vtr(v0 + 16 * 128 + dt * 32)), O1[dt]); }
    }
    float f1 = 1.0f / l1, f2 = 0.f;
    f32x4 O2[4];
#pragma unroll
    for (int dt = 0; dt < 4; ++dt) O2[dt] = (f32x4){0.f, 0.f, 0.f, 0.f};
    if (LOCAL) {
        const int rs = min(max(r - 4, 0), 24), band = jb == 0 ? 0 : (jb == 1 ? 8 : (jb == 2 ? 24 : 32));
        const int qc = 16 * jb + fr, wsx = min(max(qc - 8, 0), 48);
        f32x4 sl[16]; float mx2 = -1e30f, l2 = 0.f;
#pragma unroll
        for (int kr = 0; kr < 8; ++kr)
#pragma unroll
            for (int hf = 0; hf < 2; ++hf) {
                const bf16* kp = P + (size_t)(M_CTX + b * 2048 + (rs + kr) * 64 + band + 16 * hf) * EVEN_IN + 3072 + head * 64 + lane_off;
                f32x4 acc = {0.f, 0.f, 0.f, 0.f}; acc = MFMA16(*(const bf16x8*)kp, qf0, acc); acc = MFMA16(*(const bf16x8*)(kp + 32), qf1, acc);
                const LAS float* bt = (const LAS float*)(L + AT_BT) + (rs + kr - r + 7) * 31;
#pragma unroll
                for (int e = 0; e < 4; ++e) { const int kc = band + 16 * hf + 4 * fq + e; const bool valid = kc >= wsx && kc < wsx + 16;
                    const float bias = bt[min(max(kc - qc + 15, 0), 30)];
                    acc[e] = valid ? acc[e] * 0.125f + bias : -1e30f; mx2 = fmaxf(mx2, acc[e]); }
                sl[kr * 2 + hf] = acc; }
        mx2 = fmaxf(mx2, __shfl_xor(mx2, 16)); mx2 = fmaxf(mx2, __shfl_xor(mx2, 32));
#pragma unroll
        for (int kt = 0; kt < 16; ++kt)
#pragma unroll
            for (int e = 0; e < 4; ++e) { const float p = fexp(sl[kt][e] - mx2); sl[kt][e] = p; l2 += p; }
        l2 += __shfl_xor(l2, 16); l2 += __shfl_xor(l2, 32);
#pragma unroll
        for (int kr = 0; kr < 8; ++kr) { const bf16x8 pa = pack44(sl[2 * kr], sl[2 * kr + 1]);
            const LAS unsigned char* v0 = L + AT_VL + ((rs + kr) % 9) * 8192 + (band + 4 * fq + trow) * 128 + tcol;
#pragma unroll
            for (int dt = 0; dt < 4; ++dt) O2[dt] = MFMA16(pa, cat4(vtr(v0 + dt * 32), vtr(v0 + 16 * 128 + dt * 32)), O2[dt]); }
        const float m = fmaxf(mx1, mx2), a1 = fexp(mx1 - m), a2 = fexp(mx2 - m), linv = 1.0f / (l1 * a1 + l2 * a2);
        f1 = a1 * linv; f2 = a2 * linv;
    }
#pragma unroll
    for (int e = 0; e < 4; ++e) { const float g1 = __shfl(f1, 4 * fq + e), g2 = __shfl(f2, 4 * fq + e);
        bf16* op = P + (size_t)(qbase + e) * EVEN_IN + 2560 + head * 64 + lane_oo;
#pragma unroll
        for (int dt = 0; dt < 4; ++dt) op[16 * dt] = (bf16)f2bf(O1[dt][e] * g1 + O2[dt][e] * g2); }
    if (LOCAL && rp + 1 < rp_hi) {
        __syncthreads();
        if (nnew > 0) *(LAS v4u*)(L + AT_VL + (have_hi % 9) * 8192 + (tid >> 3) * 128 + (tid & 7) * 16) = pf0;
        if (nnew > 1) *(LAS v4u*)(L + AT_VL + ((have_hi + 1) % 9) * 8192 + (tid >> 3) * 128 + (tid & 7) * 16) = pf1;
        have_hi += nnew;
    }
  }
    __syncthreads();
}
constexpr int CW_RGCNT = 32768;
constexpr int RP_XC = 0, RP_XCF = 17408, RP_HB = 50176, RP_XBR = 115712, RP_END = 133120;
template <int VAR> __device__ __forceinline__ void rg_phase_pipe(Frame& F) {
    LAS unsigned char* L = (LAS unsigned char*)F.lds;
    const bf16* P2 = (const bf16*)(F.ws + WS_PROJ);
    unsigned long long* AGG = (unsigned long long*)(F.ws + WS_AGG);
    const int bx = blockIdx.x, hb = bx & 7, t0i = bx >> 3;
    if (F.G != 256) return;
    const int tid = F.tid, lane = F.lane, r = lane & 31, hh = lane >> 5, w = F.wave, d = w >> 2, jq = w & 3;
    const int chl = 32 * jq + r, ch = hb * 128 + chl;
    const float gb0 = F.in[21][(d * 2 + 0) * 1024 + ch], gb1 = F.in[21][(d * 2 + 1) * 1024 + ch];
    const float sp8 = -8.0f * log1pf(__expf(-F.in[22][d * 1024 + ch]));
    const int cc = tid & 127, tq = tid >> 7;
    const float cw0 = F.in[18][0 * 1024 + hb * 128 + cc], cw1 = F.in[18][1 * 1024 + hb * 128 + cc], cw2 = F.in[18][2 * 1024 + hb * 128 + cc], cw3 = F.in[18][3 * 1024 + hb * 128 + cc], cbv = F.in[19][hb * 128 + cc];
#define RP_XLOAD(kk, X0, X1, X2) do { const int ti_ = t0i + 32 * (kk); const bool lat_ = ti_ >= 64; const int pos_ = lat_ ? ((ti_ - 64) & 31) : (ti_ & 3), nts_ = lat_ ? 32 : 4; \
        const int lo_ = pos_ == 0 ? 2 : 0, hi_ = pos_ == nts_ - 1 ? 66 : 67; const bf16* xb_ = P2 + (size_t)(ti_ * 64 - 2) * ODD_IN + hb * 128;     \
        X0 = ((tid >> 4) >= lo_) ? *(const v4u*)(xb_ + xo0) : (v4u){0u, 0u, 0u, 0u}; \
        X1 = ((tid >> 4) + 32 < hi_) ? *(const v4u*)(xb_ + xo0 + 32 * ODD_IN) : (v4u){0u, 0u, 0u, 0u}; \
        X2 = (tid < 48 && (tid >> 4) + 64 < hi_) ? *(const v4u*)(xb_ + xo0 + 64 * ODD_IN) : (v4u){0u, 0u, 0u, 0u}; } while (0)
#define RP_XWRITE(X0, X1, X2) do { *(LAS v4u*)(L + RP_XBR + tid * 16) = X0; *(LAS v4u*)(L + RP_XBR + (tid + 512) * 16) = X1; if (tid < 48) *(LAS v4u*)(L + RP_XBR + (tid + 1024) * 16) = X2; } while (0)
#define RP_COMBINE(kk, G0, G1) do { bf16* yb_ = (bf16*)(F.ws + ((VAR & 1) ? WS_PROJ + 100 * MiB : WS_H)) + (size_t)((t0i + 32 * (kk)) * 64) * DM + hb * 128; _Pragma("unroll") for (int it = 0; it < 2; ++it) { const int cidx = tid + it * 512, t = cidx >> 4, c8 = (cidx & 15) * 8; const v4u gw = it ? G1 : G0; \
            const LAS f32x4* hf = (const LAS f32x4*)(L + RP_HB + (t * 128 + c8) * 4); const LAS f32x4* hk = (const LAS f32x4*)(L + RP_HB + ((64 + t) * 128 + c8) * 4); const f32x4 s0 = hf[0] + hk[0], s1 = hf[1] + hk[1]; v4u o; \
            o[0] = cvtpk(s0[0] * siluf(bflo(gw[0])), s0[1] * siluf(bfhi(gw[0]))); o[1] = cvtpk(s0[2] * siluf(bflo(gw[1])), s0[3] * siluf(bfhi(gw[1]))); \
            o[2] = cvtpk(s1[0] * siluf(bflo(gw[2])), s1[1] * siluf(bfhi(gw[2]))); o[3] = cvtpk(s1[2] * siluf(bflo(gw[3])), s1[3] * siluf(bfhi(gw[3]))); \
            *(v4u*)(yb_ + yo0 + it * 32 * DM) = o; __builtin_amdgcn_sched_barrier(0); } } while (0)
    const unsigned xo0 = (unsigned)((tid >> 4) * ODD_IN + (tid & 15) * 8), yo0 = (unsigned)((tid >> 4) * DM + (tid & 15) * 8);
    { v4u x0, x1, x2; RP_XLOAD(0, x0, x1, x2); RP_XWRITE(x0, x1, x2); }
    __syncthreads();
#pragma unroll 1
    for (int k = 0; k < 10; ++k) {
        const int ti = t0i + 32 * k;
        const bool lat = ti >= 64; const int pos = lat ? ((ti - 64) & 31) : (ti & 3), nts = lat ? 32 : 4, first = ti - pos, seq = lat ? 16 + ((ti - 64) >> 5) : (ti >> 2);
        bf16x8 Bw[2][8];
#pragma unroll
        for (int g = 0; g < 2; ++g)
#pragma unroll
            for (int st = 0; st < 8; ++st) Bw[g][st] = (VAR & 16) ? (bf16x8){(short)st, (short)g, 0, 0, 0, 0, 0, 0} : *(const bf16x8*)((const bf16*)(F.ws + WS_GW) + (size_t)((d * 2 + g) * 8 + hb) * 16384 + ((jq * 8 + st) * 64 + lane) * 8);
        v4u x0 = {0u, 0u, 0u, 0u}, x1 = x0, x2 = x0, g0 = x0, g1 = x0;
        if (!(VAR & 32)) { const LAS unsigned char* xr = L + RP_XBR + (16 * tq) * 256 + cc * 2;
          float xm2 = bf2f(*(const LAS unsigned short*)(xr)), xm1 = bf2f(*(const LAS unsigned short*)(xr + 256)), xc0 = bf2f(*(const LAS unsigned short*)(xr + 512));
#pragma unroll
          for (int t = 0; t < 16; ++t) { const float xn = bf2f(*(const LAS unsigned short*)(xr + (t + 3) * 256));
              const float xc = cbv + cw0 * xm2 + cw1 * xm1 + cw2 * xc0 + cw3 * xn;
              *(LAS unsigned short*)(L + RP_XC + (16 * tq + t) * 272 + cc * 2) = (unsigned short)f2bf(xc);
              *(LAS float*)(L + RP_XCF + ((16 * tq + t) * 128 + cc) * 4) = xc;
              xm2 = xm1; xm1 = xc0; xc0 = xn; } }
        __syncthreads();
        f32x16 acc[2][2];
#pragma unroll
        for (int g = 0; g < 2; ++g)
#pragma unroll
            for (int mt = 0; mt < 2; ++mt)
#pragma unroll
                for (int q = 0; q < 16; ++q) acc[g][mt][q] = 0.f;
#pragma unroll
        for (int st = 0; st < 8; ++st)
#pragma unroll
            for (int mt = 0; mt < 2; ++mt) { const bf16x8 a = *(const LAS bf16x8*)(L + RP_XC + (32 * mt + r) * 272 + (16 * st + 8 * hh) * 2);
                if (!(VAR & 8)) { acc[0][mt] = MFMA32(a, Bw[0][st], acc[0][mt]); acc[1][mt] = MFMA32(a, Bw[1][st], acc[1][mt]); } else { acc[0][mt][st] += (float)a[0]; acc[1][mt][st] += (float)Bw[0][st][0] + (float)Bw[1][st][1]; } }
#pragma unroll
        for (int mt = 0; mt < 2; ++mt)
#pragma unroll
            for (int q = 0; q < 16; ++q) { const int t = 32 * mt + (q & 3) + 8 * (q >> 2) + 4 * hh;
                if (VAR & 4) { acc[0][mt][q] = 0.5f + 1e-3f * acc[0][mt][q]; continue; }
                const float rr = rcpf_(1.0f + fexp(-(acc[0][mt][q] + gb0))), ii = rcpf_(1.0f + fexp(-(acc[1][mt][q] + gb1)));
                const float la = sp8 * rr, a = fexp(la), x2_ = 2.0f * la;
                const float em_s = -x2_ * (1.0f + x2_ * (0.5f + x2_ * (0.16666667f + x2_ * (0.041666668f + x2_ * 0.008333334f)))), em = x2_ > -0.2f ? em_s : 1.0f - a * a;
                acc[0][mt][q] = a; acc[1][mt][q] = __builtin_amdgcn_sqrtf(em) * (ii * *(const LAS float*)(L + RP_XCF + (t * 128 + chl) * 4));
                if ((q & 7) == 7) __builtin_amdgcn_sched_barrier(0); }
        float pp = 1.f, ss = 0.f, Pk[8], Sk[8];
#define RG_AGG(DIR) do { float Ag[8], Ug[8]; \
            _Pragma("unroll") for (int mt = 0; mt < 2; ++mt) _Pragma("unroll") for (int G = 0; G < 4; ++G) { float pa = 1.f, hs = 0.f; \
                _Pragma("unroll") for (int e0 = 0; e0 < 4; ++e0) { const int e = (DIR) == 0 ? e0 : 3 - e0; const float a = acc[0][mt][4 * G + e], u = acc[1][mt][4 * G + e]; hs = a * hs + u; pa *= a; } \
                Ag[4 * mt + G] = pa; Ug[4 * mt + G] = hs; } \
            _Pragma("unroll") for (int k0 = 0; k0 < 8; ++k0) { const int kk = (DIR) == 0 ? k0 : 7 - k0; \
                const float pA = __shfl_xor(Ag[kk], 32), pU = __shfl_xor(Ug[kk], 32); const bool ownfirst = ((DIR) == 0) ? (hh == 0) : (hh == 1); \
                const float A1 = ownfirst ? Ag[kk] : pA, U1 = ownfirst ? Ug[kk] : pU, A2 = ownfirst ? pA : Ag[kk], U2 = ownfirst ? pU : Ug[kk]; \
                const float pp1 = A1 * pp, ss1 = A1 * ss + U1; Pk[kk] = ownfirst ? pp : pp1; Sk[kk] = ownfirst ? ss : ss1; pp = A2 * pp1; ss = A2 * ss1 + U2; } } while (0)
        if (d == 0) RG_AGG(0); else RG_AGG(1);
#undef RG_AGG
        if (k > 0) { const bf16* gp_ = P2 + (size_t)((ti - 32) * 64) * ODD_IN + 1024 + hb * 128; g0 = *(const v4u*)(gp_ + xo0); g1 = *(const v4u*)(gp_ + xo0 + 32 * ODD_IN); }
        if (k < 9) RP_XLOAD(k + 1, x0, x1, x2);
        if (!(VAR & 2) && hh == 0) __hip_atomic_store(AGG + (size_t)(ti * 2 + d) * 1024 + ch, ((unsigned long long)__float_as_uint(ss) << 32) | __float_as_uint(pp), __ATOMIC_RELAXED, __HIP_MEMORY_SCOPE_AGENT);
        if (k > 0 && !(VAR & 64)) RP_COMBINE(k - 1, g0, g1);
        asm volatile("s_waitcnt vmcnt(0)" ::: "memory");
        __syncthreads();
        unsigned* cntw = (unsigned*)(F.ctl + CW_RGCNT + (seq * 8 + hb) * 64);
        if (!(VAR & 2) && tid == 0) __hip_atomic_fetch_add(cntw, 1u, __ATOMIC_RELAXED, __HIP_MEMORY_SCOPE_AGENT);
        if (k < 9) RP_XWRITE(x0, x1, x2);
        if (!(VAR & 2) && tid == 0) { unsigned sp = 0; while (__hip_atomic_load(cntw, __ATOMIC_RELAXED, __HIP_MEMORY_SCOPE_AGENT) < (unsigned)nts) { __builtin_amdgcn_s_sleep(2); if (++sp > (1u << 20)) break; } }
        __syncthreads();
        float cin = lat ? F.in[5][((seq - 16) * 2 + d) * 1024 + ch] : 0.f;
        if (!(VAR & 2)) { const int cnt = d == 0 ? pos : nts - 1 - pos;
#pragma unroll
          for (int bt = 0; bt < 4; ++bt) {
              if (8 * bt < cnt) {
                  unsigned long long v[8];
#pragma unroll
                  for (int j = 0; j < 8; ++j) { const int jj = 8 * bt + j; const bool ok = jj < cnt; const int tj = ok ? (d == 0 ? first + jj : first + nts - 1 - jj) : ti;
                      v[j] = __hip_atomic_load(AGG + (size_t)(tj * 2 + d) * 1024 + ch, __ATOMIC_RELAXED, __HIP_MEMORY_SCOPE_AGENT); }
#pragma unroll
                  for (int j = 0; j < 8; ++j) { const bool ok = 8 * bt + j < cnt; const float A = ok ? __uint_as_float((unsigned)v[j]) : 1.0f, U = ok ? __uint_as_float((unsigned)(v[j] >> 32)) : 0.0f; cin = A * cin + U; }
              } } }
#define RG_APPLY(DIR) do { _Pragma("unroll") for (int mt = 0; mt < 2; ++mt) _Pragma("unroll") for (int G = 0; G < 4; ++G) { float hs = Pk[4 * mt + G] * cin + Sk[4 * mt + G]; \
                _Pragma("unroll") for (int e0 = 0; e0 < 4; ++e0) { const int e = (DIR) == 0 ? e0 : 3 - e0; hs = acc[0][mt][4 * G + e] * hs + acc[1][mt][4 * G + e]; \
                    const int t = 32 * mt + 8 * G + 4 * hh + e; *(LAS float*)(L + RP_HB + (((DIR) * 64 + t) * 128 + chl) * 4) = hs; } } } while (0)
        if (VAR & 64) { if (cin + Pk[3] + Sk[5] == 123.f) *(LAS float*)(L + RP_HB) = cin; }
        else if (d == 0) RG_APPLY(0); else RG_APPLY(1);
#undef RG_APPLY
        if (!(VAR & 1) && !lat && hh == 0 && ((d == 0 && pos == nts - 1) || (d == 1 && pos == 0))) F.out[OUT_RG + ((ti >> 2) * 2 + d) * 1024 + ch] = pp * cin + ss;
    }
    __syncthreads();
    { const bf16* gp_ = P2 + (size_t)((t0i + 32 * 9) * 64) * ODD_IN + 1024 + hb * 128;
      const v4u g0 = *(const v4u*)(gp_ + xo0), g1 = *(const v4u*)(gp_ + xo0 + 32 * ODD_IN);
      RP_COMBINE(9, g0, g1); }
    __syncthreads();
#undef RP_XLOAD
#undef RP_XWRITE
#undef RP_COMBINE
}
struct Args { const float* in[24]; float* out; unsigned char* ws; int ph_lo, ph_hi; };
__global__ void __launch_bounds__(NWAVES * 64, 2) mega_fwd(Args args) {
    extern __shared__ __attribute__((aligned(16))) unsigned char lds[];
    Frame F;
    F.lds = lds;
    F.MISC = (volatile LAS unsigned*)((LAS unsigned char*)lds + MISC_OFF);
    F.tid = threadIdx.x; F.lane = F.tid & 63; F.wave = __builtin_amdgcn_readfirstlane(F.tid >> 6);
    F.G = gridDim.x; { const int bx = blockIdx.x; F.vcu = (F.G % 8 == 0) ? (bx % 8) * (F.G / 8) + bx / 8 : bx; }
    F.ws = args.ws; F.out = args.out; F.ctl = (gu32*)(args.ws + WS_CTL);
#pragma unroll
    for (int i = 0; i < 24; ++i) F.in[i] = args.in[i];
    for (int u = F.tid; u < (LDS_BYTES - MISC_OFF) / 4; u += NWAVES * 64) ((LAS unsigned*)((LAS unsigned char*)lds + MISC_OFF))[u] = 0u;
    __syncthreads();
    const int lo = args.ph_lo, hi = args.ph_hi;
    const bool one = (lo == 0 && hi == NPHASE);
    XcdBarrier bar; bar.bar = (unsigned*)(F.ctl + CW_BAR); bar.x = 0; bar.st = nullptr;
    if (one) bar = xcd_barrier_post((unsigned*)(F.ctl + CW_BAR), F.MISC + 8);
#define IN(k) (lo <= (k) && (k) < hi)
#define QSLOT 0
#define GRID_BAR(k) do { if (IN(k) && IN((k) + 1)) xcd_barrier(bar); } while (0)
    LAS unsigned char* ring = (LAS unsigned char*)lds;

    if (IN(0)) { p0_prologue(F); GRID_BAR(0); }
    if (IN(1)) { modnorm_rows(F, 0, F.in[0], F.in[1]); GRID_BAR(1); }
    if (IN(2)) {
        pg8::Gemm g{(const bf16*)(F.ws + WS_H), (const bf16*)(F.ws + WS_WIE), M_ALL, EVEN_IN, DM}; pg8::StaticOrder S; S.init(M_ALL, EVEN_IN, F.G, (int)blockIdx.x);
        pg8::EpiProj E{(bf16*)(F.ws + WS_PROJ), EVEN_IN, F.out + OUT_K};
        pg8::gemm_phase<pg8::EpiProj, pg8::StaticOrder, true, true>(ring, g, S, E);
        GRID_BAR(2);
    }
    if (IN(3)) {
#define QUEUE_LOOP(slot, count, call) for (;;) { \
            if (F.tid == 0) F.MISC[16] = __hip_atomic_fetch_add((unsigned*)(F.ctl + CW_QUEUE + 64 * (slot) + 256 * QSLOT), 1u, __ATOMIC_RELAXED, __HIP_MEMORY_SCOPE_AGENT); \
            __syncthreads(); const int qi = (int)F.MISC[16]; __syncthreads(); \
            if (qi >= (count)) break; call; }
        QUEUE_LOOP(0, 192, hgrn_mfma_item(F, qi < 64 ? 128 + qi : qi - 64))
        QUEUE_LOOP(1, 192, attn_mfma_item<true>(F, qi))
        QUEUE_LOOP(2, 256, attn_mfma_item<false>(F, qi))
#undef QUEUE_LOOP
        GRID_BAR(3);
    }
    if (IN(4)) { gate_even_rows(F); GRID_BAR(4); }
    if (IN(5)) {
        pg8::Gemm g{(const bf16*)(F.ws + WS_H), (const bf16*)(F.ws + WS_WOE), M_ALL, DM, DM}; pg8::StaticOrder S; S.init(M_ALL, DM, F.G, (int)blockIdx.x);
        pg8::EpiRes E{F.in[0], F.in[1], F.out, (const float*)(F.ws + WS_MODS) + 2048};
        pg8::gemm_phase<pg8::EpiRes, pg8::StaticOrder, true, true>(ring, g, S, E);
        GRID_BAR(5);
    }
    if (IN(6)) { modnorm_rows(F, 1, F.out, F.out + (size_t)M_CTX * DM); GRID_BAR(6); }
    if (IN(7)) {
        pg8::Gemm g{(const bf16*)(F.ws + WS_H), (const bf16*)(F.ws + WS_WIO), M_ALL, ODD_IN, DM}; pg8::StaticOrder S; S.init(M_ALL, ODD_IN, F.G, (int)blockIdx.x);
        pg8::EpiProj E{(bf16*)(F.ws + WS_PROJ), ODD_IN, nullptr};
        pg8::gemm_phase<pg8::EpiProj, pg8::StaticOrder, true, true>(ring, g, S, E);
        GRID_BAR(7);
    }
    if (IN(8)) { rg_phase_pipe<0>(F); GRID_BAR(8); }
#if defined(PROBE_RG)
    rg_phase_pipe<PROBE_RG>(F); xcd_barrier(bar);
#endif
    if (IN(9)) { }
    if (IN(10)) {
        pg8::Gemm g{(const bf16*)(F.ws + WS_H), (const bf16*)(F.ws + WS_WOO), M_ALL, DM, DM}; pg8::StaticOrder S; S.init(M_ALL, DM, F.G, (int)blockIdx.x);
        pg8::EpiRes E{F.out, F.out + (size_t)M_CTX * DM, F.out, (const float*)(F.ws + WS_MODS) + 9 * 3072 + 2048};
        pg8::gemm_phase<pg8::EpiRes, pg8::StaticOrder, true, true>(ring, g, S, E);
        GRID_BAR(10);
    }
    if (IN(11)) { final_norm_rows(F); }

#undef IN
#undef GRID_BAR
}

extern "C" void kernel_launch(void* const* d_in, const int* in_sizes, int n_in, void* d_out, int out_size, void* d_ws, size_t ws_size, hipStream_t stream) {
    static int grid = 0;
    if (grid == 0) {
        if (n_in != 24 || out_size != (int)OUT_TOTAL || ws_size < WS_END) { fprintf(stderr, "kernel_launch: unexpected shapes (n_in %d out %d ws %zu)\n", n_in, out_size, ws_size); grid = -1; return; }
        int dev = 0, cus = 0, per_cu = 0;
        if (hipGetDevice(&dev) != hipSuccess || hipDeviceGetAttribute(&cus, hipDeviceAttributeMultiprocessorCount, dev) != hipSuccess) { grid = -1; return; }
        if (hipFuncSetAttribute((const void*)mega_fwd, hipFuncAttributeMaxDynamicSharedMemorySize, LDS_BYTES) != hipSuccess) { fprintf(stderr, "kernel_launch: hipFuncSetAttribute failed\n"); grid = -1; return; }
        if (hipOccupancyMaxActiveBlocksPerMultiprocessor(&per_cu, (const void*)mega_fwd, NWAVES * 64, LDS_BYTES) != hipSuccess || per_cu < 1) { fprintf(stderr, "kernel_launch: occupancy query says %d\n", per_cu); }
        (void)hipGetLastError();
        grid = cus;
    }
    if (grid < 0) return;
    (void)hipMemsetAsync((char*)d_ws + WS_CTL, 0, CTL_ZERO_BYTES, stream);
    Args a{};
    for (int i = 0; i < 24; ++i) a.in[i] = (const float*)d_in[i];
    a.out = (float*)d_out; a.ws = (unsigned char*)d_ws;
#if defined(MK_PER_PHASE)
    for (int p = 0; p < NPHASE; ++p) { a.ph_lo = p; a.ph_hi = p + 1; hipLaunchKernelGGL(mega_fwd, dim3(grid), dim3(NWAVES * 64), LDS_BYTES, stream, a); }
#else
    a.ph_lo = 0; a.ph_hi = NPHASE;
    hipLaunchKernelGGL(mega_fwd, dim3(grid), dim3(NWAVES * 64), LDS_BYTES, stream, a);
#endif
}
```
